# Optimizing an MI355X kernel written in HIP

```python
import math
import jax, jax.numpy as jnp
from jax import lax
import numpy as np

D_MODEL = 1024
BATCH = 2
SEQ = 8192
DEPTH = 4

N_MIXERS = 2
N_RET_LAYERS = (DEPTH + 1) // 2
N_DIFF_LAYERS = DEPTH // 2
RMS_EPS = 1e-6

RET_HEADS = 4
RET_DK = D_MODEL // RET_HEADS
RET_DV = 2 * RET_DK
RET_CHUNK = 128
ROPE_BASE = 10000.0
RET_IN = 2 * RET_HEADS * RET_DK + 2 * RET_HEADS * RET_DV

DIFF_HEADS = 8
DIFF_DH = D_MODEL // (2 * DIFF_HEADS)
DIFF_DV = 2 * DIFF_DH
DIFF_IN = 4 * DIFF_HEADS * DIFF_DH + DIFF_HEADS * DIFF_DV
Q_BLOCK = 128
NEG_BIG = -1e30

REL_BUCKETS = 32
REL_MAX_EXACT = REL_BUCKETS // 2
REL_MAX_DIST = 128

D_FF = -(-8 * D_MODEL // (3 * 256)) * 256

kernel_name = "hybrid_retention_diffattn_sandwich"


def rmsnorm(x, g):
    xf = x.astype(jnp.float32)
    y = xf * lax.rsqrt(jnp.mean(xf * xf, axis=-1, keepdims=True) + RMS_EPS)
    return (y * g.astype(jnp.float32)).astype(x.dtype)


def rms_unit(xf):
    return xf * lax.rsqrt(jnp.mean(xf * xf, axis=-1, keepdims=True) + RMS_EPS)


def rotary(x, pos):
    half = x.shape[-1] // 2
    inv = ROPE_BASE ** (-jnp.arange(half, dtype=jnp.float32) / half)
    ang = pos[:, None] * inv[None, :]
    cos, sin = jnp.cos(ang), jnp.sin(ang)
    x1, x2 = x[..., :half], x[..., half:]
    return jnp.concatenate([x1 * cos - x2 * sin, x1 * sin + x2 * cos], axis=-1)


def retention_mixer(h, w_in, w_out):
    B, S, _ = h.shape
    H, C = RET_HEADS, RET_CHUNK
    n_chunks = S // C
    proj = h @ w_in
    q, k, v, gate = jnp.split(
        proj, [H * RET_DK, 2 * H * RET_DK, 2 * H * RET_DK + H * RET_DV], axis=-1)
    pos = jnp.arange(S, dtype=jnp.float32)
    q = q.astype(jnp.float32).reshape(B, S, H, RET_DK).transpose(0, 2, 1, 3)
    k = k.astype(jnp.float32).reshape(B, S, H, RET_DK).transpose(0, 2, 1, 3)
    v = v.astype(jnp.float32).reshape(B, S, H, RET_DV).transpose(0, 2, 1, 3)
    q = rotary(q, pos)
    k = rotary(k, pos) * (RET_DK ** -0.5)

    log_gamma = jnp.log1p(-(2.0 ** (-5.0 - jnp.arange(H, dtype=jnp.float32))))
    idx = jnp.arange(C, dtype=jnp.float32)
    diff = idx[:, None] - idx[None, :]
    decay_mask = jnp.where(diff[None] >= 0,
                           jnp.exp(jnp.maximum(diff, 0.0)[None] * log_gamma[:, None, None]),
                           0.0)
    q_decay = jnp.exp((idx[None, :] + 1.0) * log_gamma[:, None])[None, :, :, None]
    k_decay = jnp.exp((C - 1.0 - idx[None, :]) * log_gamma[:, None])[None, :, :, None]
    chunk_decay = jnp.exp(C * log_gamma)[None, :, None, None]

    def to_chunks(t):
        return t.reshape(B, H, n_chunks, C, t.shape[-1]).transpose(2, 0, 1, 3, 4)

    def step(state, inp):
        qc, kc, vc = inp
        inner = jnp.einsum('bhnd,bhmd->bhnm', qc, kc) * decay_mask[None]
        out = jnp.einsum('bhnm,bhme->bhne', inner, vc)
        out = out + jnp.einsum('bhnd,bhde->bhne', qc, state) * q_decay
        state = state * chunk_decay + jnp.einsum('bhmd,bhme->bhde', kc * k_decay, vc)
        return state, out

    state0 = jnp.zeros((B, H, RET_DK, RET_DV), jnp.float32)
    _, ys = lax.scan(step, state0, (to_chunks(q), to_chunks(k), to_chunks(v)))
    y = ys.transpose(1, 0, 3, 2, 4).reshape(B, S, H, RET_DV)
    y = rms_unit(y).reshape(B, S, H * RET_DV)
    y = y * jax.nn.silu(gate.astype(jnp.float32))
    return y.astype(h.dtype) @ w_out


def t5_causal_bucket(rel):
    n = jnp.maximum(rel, 0)
    nf = jnp.maximum(n, 1).astype(jnp.float32)
    large = REL_MAX_EXACT + (jnp.log(nf / REL_MAX_EXACT)
                             / math.log(REL_MAX_DIST / REL_MAX_EXACT)
                             * (REL_BUCKETS - REL_MAX_EXACT)).astype(jnp.int32)
    large = jnp.minimum(large, REL_BUCKETS - 1)
    return jnp.where(n < REL_MAX_EXACT, n, large)


def diff_attention_mixer(h, w_in, w_out, lam, subln_g, rel_table, lambda_init):
    B, S, _ = h.shape
    H, d = DIFF_HEADS, DIFF_DH
    nb = S // Q_BLOCK
    proj = h @ w_in
    q, k, v = jnp.split(proj, [2 * H * d, 4 * H * d], axis=-1)
    q = q.reshape(B, S, H, 2, d).transpose(0, 2, 3, 1, 4) * (d ** -0.5)
    k = k.reshape(B, S, H, 2, d).transpose(0, 2, 3, 1, 4)
    v = v.reshape(B, S, H, DIFF_DV).transpose(0, 2, 1, 3)
    lamf = lam.astype(jnp.float32)
    lam_full = (jnp.exp(jnp.sum(lamf[0] * lamf[1])) - jnp.exp(jnp.sum(lamf[2] * lamf[3]))
                + lambda_init)
    q_blocks = q.reshape(B, H, 2, nb, Q_BLOCK, d).transpose(3, 0, 1, 2, 4, 5)
    k_pos = jnp.arange(S, dtype=jnp.int32)

    def block(args):
        qb, bi = args
        q_pos = bi * Q_BLOCK + jnp.arange(Q_BLOCK, dtype=jnp.int32)
        rel = q_pos[:, None] - k_pos[None, :]
        bias = rel_table[t5_causal_bucket(rel)].astype(jnp.float32).transpose(2, 0, 1)
        logits = jnp.einsum('bhiqd,bhikd->bhiqk', qb, k).astype(jnp.float32)
        logits = logits + bias[None, :, None]
        logits = jnp.where(rel[None, None, None] >= 0, logits, NEG_BIG)
        p = jax.nn.softmax(logits, axis=-1)
        attn = p[:, :, 0] - lam_full * p[:, :, 1]
        return jnp.einsum('bhqk,bhkd->bhqd', attn.astype(v.dtype), v)

    o = lax.map(block, (q_blocks, jnp.arange(nb, dtype=jnp.int32)))
    o = o.transpose(1, 2, 0, 3, 4).reshape(B, H, S, DIFF_DV)
    o = rmsnorm(o, subln_g) * (1.0 - lambda_init)
    o = o.transpose(0, 2, 1, 3).reshape(B, S, H * DIFF_DV)
    return o @ w_out


def swiglu(h, w_gate, w_up, w_down):
    return (jax.nn.silu(h @ w_gate) * (h @ w_up)) @ w_down


def setup_inputs(seed: int = 0) -> dict:
    key = jax.random.key(seed)
    ks = jax.random.split(key, 12)
    f32 = jnp.float32
    nrm = jax.random.normal
    return {
        "x": nrm(ks[0], (BATCH, SEQ, D_MODEL), f32),
        "norm_gains": 1.0 + 0.05 * nrm(ks[1], (DEPTH, 4, D_MODEL), f32),
        "ret_w_in": nrm(ks[2], (N_RET_LAYERS, D_MODEL, RET_IN), f32) * D_MODEL ** -0.5,
        "ret_w_out": nrm(ks[3], (N_RET_LAYERS, RET_HEADS * RET_DV, D_MODEL), f32)
                     * (RET_HEADS * RET_DV) ** -0.5,
        "diff_w_in": nrm(ks[4], (N_DIFF_LAYERS, D_MODEL, DIFF_IN), f32) * D_MODEL ** -0.5,
        "diff_w_out": nrm(ks[5], (N_DIFF_LAYERS, DIFF_HEADS * DIFF_DV, D_MODEL), f32)
                      * (DIFF_HEADS * DIFF_DV) ** -0.5,
        "diff_lambda": 0.1 * nrm(ks[6], (N_DIFF_LAYERS, 4, DIFF_DH), f32),
        "diff_subln": 1.0 + 0.05 * nrm(ks[7], (N_DIFF_LAYERS, DIFF_DV), f32),
        "rel_bias_table": 0.5 * nrm(ks[8], (REL_BUCKETS, DIFF_HEADS), f32),
        "ffn_w_gate": nrm(ks[9], (DEPTH, D_MODEL, D_FF), f32) * D_MODEL ** -0.5,
        "ffn_w_up": nrm(ks[10], (DEPTH, D_MODEL, D_FF), f32) * D_MODEL ** -0.5,
        "ffn_w_down": nrm(ks[11], (DEPTH, D_FF, D_MODEL), f32) * D_FF ** -0.5,
    }


def reference(x, norm_gains, ret_w_in, ret_w_out, diff_w_in, diff_w_out, diff_lambda,
              diff_subln, rel_bias_table, ffn_w_gate, ffn_w_up, ffn_w_down):
    for i in range(DEPTH):
        g = norm_gains[i]
        h = rmsnorm(x, g[0])
        j = i // N_MIXERS
        if i % N_MIXERS == 0:
            m = retention_mixer(h, ret_w_in[j], ret_w_out[j])
        else:
            lambda_init = 0.8 - 0.6 * math.exp(-0.3 * i)
            m = diff_attention_mixer(h, diff_w_in[j], diff_w_out[j], diff_lambda[j],
                                     diff_subln[j], rel_bias_table, lambda_init)
        x = x + rmsnorm(m, g[1])
        h = rmsnorm(x, g[2])
        x = x + rmsnorm(swiglu(h, ffn_w_gate[i], ffn_w_up[i], ffn_w_down[i]), g[3])
    return x
```

```cpp
#include <hip/hip_runtime.h>
#include <hip/hip_cooperative_groups.h>
#include <cstdio>
#include <cstdint>
namespace cg = cooperative_groups;
namespace pg8 {
#define PG8_LAS __attribute__((address_space(3)))
typedef unsigned short bf16_t;
typedef short bf16x8 __attribute__((ext_vector_type(8)));
typedef float f32x4 __attribute__((ext_vector_type(4)));
typedef unsigned u32x4 __attribute__((ext_vector_type(4)));
constexpr int BM = 256, BK = 64, HALF = 128, HTB = HALF * BK * 2  , STAGE_BYTES = 8 * HTB, NXCD = 8, WGM = 8;

__host__ __device__ __forceinline__ int lds_byte(int r, int c) { const int st = (r >> 4) * 2 + (c >> 5), rr = r & 15, cc = c & 31, ob = rr * 64 + cc * 2; return st * 1024 + (ob ^ (((ob >> 9) & 1) << 5)); }
__host__ __device__ __forceinline__ void stage_rc(int b, int& R, int& C) { const int st = b / 1024, sb = b % 1024, swz = sb ^ (((sb >> 9) & 1) << 5); R = (st >> 1) * 16 + swz / 64; C = (st & 1) * 32 + (swz % 64) / 2; }
__host__ __device__ __forceinline__ int perm32(int rho) { const int n = rho >> 4, i = rho & 15; return 8 * (i >> 2) + 4 * n + (i & 3); }

struct Unit { int pm, pn; };
struct Gemm { const bf16_t* A; const bf16_t* Bt; int M, N, K; };

struct StaticOrder {
    int nM, nN, nwg, G, c;
    __host__ __device__ void init(int M, int N, int G_, int c_) { nM = M / BM; nN = N / BM; nwg = nM * nN; G = G_; c = c_; }
    __host__ __device__ bool next(int i, Unit& u) const {
        const long L = (long)i * G + c; if (L >= nwg) return false;
        int wgid = (int)L; { const int q = nwg / NXCD, r = nwg % NXCD, xcd = wgid % NXCD, off = wgid / NXCD; wgid = (xcd < r ? xcd * (q + 1) : r * (q + 1) + (xcd - r) * q) + off; }
        const int nig = WGM * nN, gid = wgid / nig, fm = gid * WGM, gsz = (nM - fm) < WGM ? (nM - fm) : WGM;
        u.pm = fm + ((wgid % nig) % gsz); u.pn = (wgid % nig) / gsz; return true;
    }
    __device__ __forceinline__ void a_ready(const Unit&) const {}
    __device__ __forceinline__ void done(const Unit&) const {}
};

__device__ __forceinline__ unsigned cvt_pk_bf16(float lo, float hi) { unsigned r; asm volatile("v_cvt_pk_bf16_f32 %0, %1, %2" : "=v"(r) : "v"(lo), "v"(hi)); return r; }
typedef unsigned u32x2 __attribute__((ext_vector_type(2)));
__device__ __forceinline__ float bf2f(unsigned short v) { return __uint_as_float(((unsigned)v) << 16); }
__device__ __forceinline__ unsigned short f2bf1(float f) { unsigned u = __float_as_uint(f); return (unsigned short)((u + 0x7fffu + ((u >> 16) & 1u)) >> 16); }
__device__ __forceinline__ u32x4 pack8(f32x4 a, f32x4 b) { u32x4 w; w.x = cvt_pk_bf16(a[0], a[1]); w.y = cvt_pk_bf16(a[2], a[3]); w.z = cvt_pk_bf16(b[0], b[1]); w.w = cvt_pk_bf16(b[2], b[3]); return w; }
__device__ __forceinline__ float silu_f(float x) { return x * __builtin_amdgcn_rcpf(1.0f + __builtin_amdgcn_exp2f(-1.4426950408889634f * x)); }
__device__ __forceinline__ f32x4 silu4(f32x4 v) { f32x4 o; o[0] = silu_f(v[0]); o[1] = silu_f(v[1]); o[2] = silu_f(v[2]); o[3] = silu_f(v[3]); return o; }
__device__ __forceinline__ void sincos_rad(float ang, float& s, float& c) {
    constexpr double INV2PI = 0.15915494309189533577; constexpr float C_HI = (float)INV2PI; constexpr float C_LO = (float)(INV2PI - (double)C_HI);
    const float hi = ang * C_HI; const float lo = __builtin_fmaf(ang, C_HI, -hi) + ang * C_LO;
    const float fr = (hi - __builtin_rintf(hi)) + lo;
    s = __builtin_amdgcn_sinf(fr); c = __builtin_amdgcn_cosf(fr);
}
constexpr int SEQ_ = 8192;
__device__ __forceinline__ void store_tr16x32(PG8_LAS unsigned char* patch, const f32x4& v0, const f32x4& v1, bf16_t* dst, size_t colstride, int fr, int fq, int lane) {
    PG8_LAS bf16_t* w = (PG8_LAS bf16_t*)(patch + (8 * fq) * 48) + fr;
#pragma unroll
    for (int i = 0; i < 4; ++i) { w[(i) * 24] = f2bf1(v0[i]); w[(4 + i) * 24] = f2bf1(v1[i]); }
    asm volatile("s_waitcnt lgkmcnt(0)" ::: "memory");
    const u32x4 t = *(const PG8_LAS u32x4*)(patch + (lane >> 1) * 48 + (lane & 1) * 16);
    *(u32x4*)(dst + (size_t)(lane >> 1) * colstride + (lane & 1) * 8) = t;
    asm volatile("s_waitcnt lgkmcnt(0)" ::: "memory");
}
struct EpiRetIn {
    static constexpr bool PERM = true, AFTER_DRAIN = false;
    bf16_t *Q, *K, *VT, *G; PG8_LAS unsigned char* patch;
    __device__ __forceinline__ void operator()(const f32x4 (&acc)[2][2][4][2], const Unit& u, int wr, int wc, int fr, int fq) const {
        const int pn = u.pn, jb = wc * 32 + 8 * fq, rowb = u.pm * BM + wr * 64 + fr;
        if (pn < 8) {
            const int h = pn & 3; const bool isK = pn >= 4; bf16_t* dst = isK ? K : Q; const float sc = isK ? 0.0625f : 1.0f;
            float inv[8];
#pragma unroll
            for (int e = 0; e < 8; ++e) inv[e] = __builtin_amdgcn_exp2f(-(float)(jb + e) * (13.287712379549449f / 128.0f));
#pragma unroll
            for (int ai = 0; ai < 2; ++ai)
#pragma unroll
                for (int m = 0; m < 4; ++m) {
                    const int row = rowb + ai * HALF + m * 16, b = row >> 13, s = row & (SEQ_ - 1); const float pos = (float)s;
                    f32x4 o1[2], o2[2];
#pragma unroll
                    for (int n = 0; n < 2; ++n)
#pragma unroll
                        for (int i = 0; i < 4; ++i) { float sn, cs; sincos_rad(pos * inv[4 * n + i], sn, cs); const float x1 = acc[ai][0][m][n][i], x2 = acc[ai][1][m][n][i];
                            o1[n][i] = (x1 * cs - x2 * sn) * sc; o2[n][i] = (x1 * sn + x2 * cs) * sc; }
                    bf16_t* p = dst + ((size_t)((b * 4 + h) * SEQ_ + s)) * 256 + jb;
                    *(u32x4*)p = pack8(o1[0], o1[1]); *(u32x4*)(p + 128) = pack8(o2[0], o2[1]);
                }
        } else if (pn < 16) {
            const int h = (pn - 8) >> 1, eb0 = ((pn - 8) & 1) * 256 + wc * 32, lane = fr + 16 * fq;
#pragma unroll
            for (int ai = 0; ai < 2; ++ai)
#pragma unroll
                for (int m = 0; m < 4; ++m) {
                    int row0 = u.pm * BM + wr * 64 + ai * HALF + m * 16; asm volatile("" : "+s"(row0)); const int b = row0 >> 13, s0 = row0 & (SEQ_ - 1);
#pragma unroll
                    for (int bj = 0; bj < 2; ++bj) store_tr16x32(patch, acc[ai][bj][m][0], acc[ai][bj][m][1], VT + ((size_t)((b * 4 + h) * 512 + eb0 + 128 * bj)) * SEQ_ + s0, SEQ_, fr, fq, lane);
                }
        } else {
            const int cb = (pn - 16) * 256 + jb;
#pragma unroll
            for (int ai = 0; ai < 2; ++ai)
#pragma unroll
                for (int m = 0; m < 4; ++m) {
                    const int row = rowb + ai * HALF + m * 16;
#pragma unroll
                    for (int bj = 0; bj < 2; ++bj) *(u32x4*)(G + (size_t)row * 2048 + cb + 128 * bj) = pack8(silu4(acc[ai][bj][m][0]), silu4(acc[ai][bj][m][1]));
                }
        }
    }
};
struct EpiDiffIn {
    static constexpr bool PERM = true, AFTER_DRAIN = false;
    bf16_t *Q, *K, *VT; float qscale; PG8_LAS unsigned char* patch;
    __device__ __forceinline__ void operator()(const f32x4 (&acc)[2][2][4][2], const Unit& u, int wr, int wc, int fr, int fq) const {
        const int pn = u.pn, jb = wc * 32 + 8 * fq, rowb = u.pm * BM + wr * 64 + fr;
        if (pn < 8) {
            bf16_t* dst = pn < 4 ? Q : K; const float sc = pn < 4 ? qscale : 1.0f; const int cb = (pn & 3) * 256 + jb;
#pragma unroll
            for (int ai = 0; ai < 2; ++ai)
#pragma unroll
                for (int m = 0; m < 4; ++m) {
                    const int row = rowb + ai * HALF + m * 16;
#pragma unroll
                    for (int bj = 0; bj < 2; ++bj) *(u32x4*)(dst + (size_t)row * 1024 + cb + 128 * bj) = pack8(acc[ai][bj][m][0] * sc, acc[ai][bj][m][1] * sc);
                }
        } else {
            const int lane = fr + 16 * fq;
#pragma unroll
            for (int ai = 0; ai < 2; ++ai)
#pragma unroll
                for (int m = 0; m < 4; ++m) {
                    int row0 = u.pm * BM + wr * 64 + ai * HALF + m * 16; asm volatile("" : "+s"(row0)); const int b = row0 >> 13, s0 = row0 & (SEQ_ - 1);
#pragma unroll
                    for (int bj = 0; bj < 2; ++bj) { const int h = (pn - 8) * 2 + bj;
                        store_tr16x32(patch, acc[ai][bj][m][0], acc[ai][bj][m][1], VT + ((size_t)((b * 8 + h) * 128 + wc * 32)) * SEQ_ + s0, SEQ_, fr, fq, lane); }
                }
        }
    }
};
struct EpiSwiGLU {
    static constexpr bool PERM = true, AFTER_DRAIN = false;
    bf16_t* ACT;
    __device__ __forceinline__ void operator()(const f32x4 (&acc)[2][2][4][2], const Unit& u, int wr, int wc, int fr, int fq) const {
        const int cb = u.pn * 128 + wc * 32 + 8 * fq, rowb = u.pm * BM + wr * 64 + fr;
#pragma unroll
        for (int ai = 0; ai < 2; ++ai)
#pragma unroll
            for (int m = 0; m < 4; ++m) {
                const int row = rowb + ai * HALF + m * 16;
                *(u32x4*)(ACT + (size_t)row * 2816 + cb) = pack8(silu4(acc[ai][0][m][0]) * acc[ai][1][m][0], silu4(acc[ai][0][m][1]) * acc[ai][1][m][1]);
            }
    }
};
struct EpiNormResNorm {
    static constexpr bool PERM = false, AFTER_DRAIN = true;
    const float* base; float* out; bf16_t* xn; const float* g1; const float* g2;
    float* xbuf;
    unsigned* cnt;
    float eps; int dry;
    __device__ __forceinline__ void fused(f32x4 (&acc)[2][2][4][2], const Unit& u, int wr, int wc, int fr, int fq, PG8_LAS unsigned char* lds, int wid, int lane) const {
        typedef float f32x2v __attribute__((ext_vector_type(2)));
        PG8_LAS f32x4* P = (PG8_LAS f32x4*)lds;
        PG8_LAS f32x2v* S = (PG8_LAS f32x2v*)(lds + 16384);
        const int col0 = u.pn * BM + wc * 32 + 4 * fq;
        f32x4 gv[2][2];
#pragma unroll
        for (int bj = 0; bj < 2; ++bj)
#pragma unroll
            for (int n = 0; n < 2; ++n) gv[bj][n] = *(const f32x4*)(g1 + col0 + bj * HALF + n * 16);
#pragma unroll
        for (int ai = 0; ai < 2; ++ai)
#pragma unroll
            for (int m = 0; m < 4; ++m) { const int r = ai * HALF + wr * 64 + m * 16 + fr; const size_t off = (size_t)(u.pm * BM + r) * 1024 + col0;
                float s0 = 0.f, s1 = 0.f, s2 = 0.f, s3 = 0.f;
#pragma unroll
                for (int bj = 0; bj < 2; ++bj)
#pragma unroll
                    for (int n = 0; n < 2; ++n) { const f32x4 bs = *(const f32x4*)(base + off + bj * HALF + n * 16), a = acc[ai][bj][m][n], ag = a * gv[bj][n];
                        s0 += (a[0] * a[0] + a[1] * a[1]) + (a[2] * a[2] + a[3] * a[3]); s1 += (bs[0] * bs[0] + bs[1] * bs[1]) + (bs[2] * bs[2] + bs[3] * bs[3]);
                        s2 += (bs[0] * ag[0] + bs[1] * ag[1]) + (bs[2] * ag[2] + bs[3] * ag[3]); s3 += (ag[0] * ag[0] + ag[1] * ag[1]) + (ag[2] * ag[2] + ag[3] * ag[3]); }
                s0 += __shfl_xor(s0, 16); s0 += __shfl_xor(s0, 32); s1 += __shfl_xor(s1, 16); s1 += __shfl_xor(s1, 32);
                s2 += __shfl_xor(s2, 16); s2 += __shfl_xor(s2, 32); s3 += __shfl_xor(s3, 16); s3 += __shfl_xor(s3, 32);
                if (fq == 0) P[r * 4 + wc] = (f32x4){s0, s1, s2, s3};
                if (m & 1) asm volatile("" ::: "memory"); }
        asm volatile("s_waitcnt lgkmcnt(0)" ::: "memory"); __builtin_amdgcn_s_barrier(); asm volatile("" ::: "memory");
        const int row = wid * 32 + (lane & 31);
        if (lane < 32) {
            const f32x4 t = (P[row * 4 + 0] + P[row * 4 + 1]) + (P[row * 4 + 2] + P[row * 4 + 3]);
            float* slot = xbuf + ((size_t)(u.pm * BM + row) * 4 + u.pn);
#pragma unroll
            for (int c = 0; c < 4; ++c) __hip_atomic_store(slot + (size_t)c * 16384 * 4, t[c], __ATOMIC_RELAXED, __HIP_MEMORY_SCOPE_AGENT);
        }
        asm volatile("s_waitcnt vmcnt(0)" ::: "memory");
        if (lane == 0) __hip_atomic_fetch_add(cnt + 64 * u.pm, 1u, __ATOMIC_RELAXED, __HIP_MEMORY_SCOPE_AGENT);
        if (wid == 0) {
            unsigned spins = 0;
            for (;;) {
                if ((unsigned)__builtin_amdgcn_readfirstlane(__hip_atomic_load(cnt + 64 * u.pm, __ATOMIC_RELAXED, __HIP_MEMORY_SCOPE_AGENT)) >= 32u) break;
                if (++spins > (1u << 24)) break;
                __builtin_amdgcn_s_sleep(1);
            }
            __builtin_amdgcn_fence(__ATOMIC_ACQUIRE, "agent");
        }
        asm volatile("s_waitcnt vmcnt(0) lgkmcnt(0)" ::: "memory"); __builtin_amdgcn_s_barrier(); asm volatile("" ::: "memory");
        if (lane < 32) {
            const float* slot = xbuf + (size_t)(u.pm * BM + row) * 4; float q[4];
#pragma unroll
            for (int c = 0; c < 4; ++c) { float v = 0.f;
#pragma unroll
                for (int t = 0; t < 4; ++t) v += __hip_atomic_load(slot + (size_t)c * 16384 * 4 + t, __ATOMIC_RELAXED, __HIP_MEMORY_SCOPE_AGENT);
                q[c] = v; }
            const float r1 = 1.0f / sqrtf(q[0] * (1.0f / 1024.0f) + eps);
            const float ss2 = q[1] + (r1 + r1) * q[2] + r1 * r1 * q[3];
            S[row] = (f32x2v){r1, 1.0f / sqrtf(fmaxf(ss2, 0.f) * (1.0f / 1024.0f) + eps)};
        }
        asm volatile("s_waitcnt lgkmcnt(0)" ::: "memory"); __builtin_amdgcn_s_barrier(); asm volatile("" ::: "memory");
#pragma unroll
        for (int ai = 0; ai < 2; ++ai)
#pragma unroll
            for (int m = 0; m < 4; ++m) { const int r = ai * HALF + wr * 64 + m * 16 + fr; const f32x2v sr = S[r]; const size_t off = (size_t)(u.pm * BM + r) * 1024 + col0;
#pragma unroll
                for (int bj = 0; bj < 2; ++bj)
#pragma unroll
                    for (int n = 0; n < 2; ++n) { const f32x4 bs = *(const f32x4*)(base + off + bj * HALF + n * 16); const f32x4 x1 = bs + acc[ai][bj][m][n] * sr.x * gv[bj][n];
                        const f32x4 o = x1 * sr.y * *(const f32x4*)(g2 + col0 + bj * HALF + n * 16); u32x2 w; w.x = cvt_pk_bf16(o[0], o[1]); w.y = cvt_pk_bf16(o[2], o[3]);
                        if (!dry || x1[0] == 1.2345e38f) { *(f32x4*)(out + off + bj * HALF + n * 16) = x1; *(u32x2*)(xn + off + bj * HALF + n * 16) = w; } }
                if (m & 1) asm volatile("" ::: "memory"); }
    }
};

struct EpiNull {
    static constexpr bool PERM = false, AFTER_DRAIN = true;
    float* sink;
    __device__ __forceinline__ void fused(f32x4 (&acc)[2][2][4][2], const Unit& u, int wr, int wc, int fr, int fq, PG8_LAS unsigned char* lds, int wid, int lane) const {
        float t = 0.f;
#pragma unroll
        for (int ai = 0; ai < 2; ++ai)
#pragma unroll
            for (int bj = 0; bj < 2; ++bj)
#pragma unroll
                for (int m = 0; m < 4; ++m)
#pragma unroll
                    for (int n = 0; n < 2; ++n) t += (acc[ai][bj][m][n][0] + acc[ai][bj][m][n][1]) + (acc[ai][bj][m][n][2] + acc[ai][bj][m][n][3]);
        if (t == 1.2345e38f) sink[0] = t;
    }
};
template <class Epi, class Sched, bool ALIGN_EPI = false, bool SP2 = false>
__device__ __forceinline__ void gemm_phase(PG8_LAS unsigned char* lds, const Gemm g, const Sched& S, const Epi& E) {
    int tid_ = threadIdx.x; asm volatile("" : "+v"(tid_)); const int tid = tid_, wid = __builtin_amdgcn_readfirstlane(tid >> 6), lane = tid & 63, wr = wid >> 2, wc = wid & 3, fr = lane & 15, fq = lane >> 4;
    const int K = g.K, nt = K / BK;
    unsigned voffA[2], voffB[2];
#pragma unroll
    for (int i = 0; i < 2; ++i) { int R, C; stage_rc(tid * 16 + i * 8192, R, C); const int Rb = Epi::PERM ? ((R & ~31) + perm32(R & 31)) : R;
        voffA[i] = (unsigned)(R * K + C) * 2u; voffB[i] = (unsigned)(Rb * K + C) * 2u; }
    const size_t kstep = (size_t)(BK * 2);
    const size_t hstep = (size_t)HALF * K * 2;
    const size_t tstep = 2 * hstep;
    const unsigned ldsw = (unsigned)wid * 1024u;
    const int aoff = lds_byte(wr * 64 + fr, fq * 8), boff = lds_byte(wc * 32 + fr, fq * 8);
#define PG8_SA(b, h) (((b) * 2 + (h)) * HTB)
#define PG8_SB(b, h) ((4 + (b) * 2 + (h)) * HTB)
#define PG8_STAGE(bufoff, gbase, voff) do { _Pragma("unroll") for (int _i = 0; _i < 2; ++_i) \
        __builtin_amdgcn_global_load_lds((const unsigned*)((const char*)(gbase) + (voff)[_i]), (PG8_LAS unsigned*)(lds + (bufoff) + ldsw + _i * 8192), 16, 0, 0); } while (0)
#define PG8_LDA(dst, b, h) do { _Pragma("unroll") for (int m = 0; m < 4; ++m) _Pragma("unroll") for (int k = 0; k < 2; ++k) dst[m][k] = *(const PG8_LAS bf16x8*)(lds + PG8_SA(b, h) + aoff + m * 2048 + k * 1024); } while (0)
#define PG8_LDB(dst, b, h) do { _Pragma("unroll") for (int n = 0; n < 2; ++n) _Pragma("unroll") for (int k = 0; k < 2; ++k) dst[n][k] = *(const PG8_LAS bf16x8*)(lds + PG8_SB(b, h) + boff + n * 2048 + k * 1024); } while (0)
#define PG8_MMA(ai, bj, At, Bt) do { __builtin_amdgcn_s_setprio(1); _Pragma("unroll") for (int m = 0; m < 4; ++m) _Pragma("unroll") for (int n = 0; n < 2; ++n) _Pragma("unroll") for (int k = 0; k < 2; ++k) \
        acc[ai][bj][m][n] = __builtin_amdgcn_mfma_f32_16x16x32_bf16(Bt[n][k], At[m][k], acc[ai][bj][m][n], 0, 0, 0); __builtin_amdgcn_s_setprio(0); } while (0)
#define PG8_WAIT_V(n) asm volatile("s_waitcnt vmcnt(" #n ")" ::: "memory")
#define PG8_WAIT_L(n) asm volatile("s_waitcnt lgkmcnt(" #n ")" ::: "memory")
#define PG8_BAR __builtin_amdgcn_s_barrier()
#define PG8_SCHED __builtin_amdgcn_sched_barrier(0)
    Unit cur, nxt; int ui = 0;
    if (!S.next(0, cur)) return;
    f32x4 acc[2][2][4][2];
#pragma unroll
    for (int a = 0; a < 2; ++a)
#pragma unroll
        for (int b = 0; b < 2; ++b)
#pragma unroll
            for (int m = 0; m < 4; ++m)
#pragma unroll
                for (int n = 0; n < 2; ++n) acc[a][b][m][n] = (f32x4){0.f, 0.f, 0.f, 0.f};
    bf16x8 At[4][2], B0[2][2], B1[2][2];
    const char* cA = (const char*)g.A + (size_t)cur.pm * tstep; const char* cB = (const char*)g.Bt + (size_t)cur.pn * tstep;
    S.a_ready(cur);
    if constexpr (SP2) {
        PG8_STAGE(PG8_SB(0, 0), cB, voffB); PG8_STAGE(PG8_SB(0, 1), cB + hstep, voffB); PG8_STAGE(PG8_SA(0, 0), cA, voffA); PG8_STAGE(PG8_SA(0, 1), cA + hstep, voffA);
        if (wr == 1) PG8_BAR;
        PG8_WAIT_V(2); PG8_BAR;
        PG8_STAGE(PG8_SB(1, 0), cB + kstep, voffB); PG8_STAGE(PG8_SA(1, 0), cA + kstep, voffA); PG8_STAGE(PG8_SB(1, 1), cB + hstep + kstep, voffB);
        PG8_WAIT_V(6); PG8_BAR;
    } else {
        PG8_STAGE(PG8_SB(0, 0), cB, voffB); PG8_STAGE(PG8_SA(0, 0), cA, voffA); PG8_STAGE(PG8_SB(0, 1), cB + hstep, voffB); PG8_STAGE(PG8_SA(0, 1), cA + hstep, voffA);
        if (wr == 1) PG8_BAR;
        PG8_WAIT_V(4); PG8_BAR;
        PG8_STAGE(PG8_SB(1, 0), cB + kstep, voffB); PG8_STAGE(PG8_SA(1, 0), cA + kstep, voffA); PG8_STAGE(PG8_SB(1, 1), cB + hstep + kstep, voffB);
        PG8_WAIT_V(6); PG8_BAR;
    }
    for (;;) {
        const bool has_next = S.next(ui + 1, nxt);
        const char* nA = has_next ? (const char*)g.A + (size_t)nxt.pm * tstep : cA; const char* nB = has_next ? (const char*)g.Bt + (size_t)nxt.pn * tstep : cB;
        for (int t = 0; t < nt; t += 2) {
            const bool last = (t == nt - 2);
            const char* a1 = cA + (size_t)(t + 1) * kstep;
            const char* a2 = last ? nA : cA + (size_t)(t + 2) * kstep; const char* b2 = last ? nB : cB + (size_t)(t + 2) * kstep;
            const char* a3 = a2 + kstep; const char* b3 = b2 + kstep;
            if (last && has_next) S.a_ready(nxt);
            if constexpr (SP2) {
            PG8_LDB(B0, 0, 0); PG8_LDB(B1, 0, 1); PG8_SCHED; PG8_LDA(At, 0, 0); PG8_STAGE(PG8_SA(1, 1), a1 + hstep, voffA);
            PG8_WAIT_V(8); PG8_WAIT_L(0); PG8_BAR; PG8_MMA(0, 0, At, B0); PG8_MMA(0, 1, At, B1); PG8_BAR; PG8_SCHED;
            PG8_LDA(At, 0, 1); PG8_STAGE(PG8_SB(0, 0), b2, voffB); PG8_STAGE(PG8_SB(0, 1), b2 + hstep, voffB); PG8_STAGE(PG8_SA(0, 0), a2, voffA);
            PG8_WAIT_V(8); PG8_WAIT_L(0); PG8_BAR; PG8_MMA(1, 0, At, B0); PG8_MMA(1, 1, At, B1); PG8_BAR; PG8_SCHED;
            PG8_LDB(B0, 1, 0); PG8_LDB(B1, 1, 1); PG8_SCHED; PG8_LDA(At, 1, 0); PG8_STAGE(PG8_SA(0, 1), a2 + hstep, voffA);
            PG8_WAIT_V(8); PG8_WAIT_L(0); PG8_BAR; PG8_MMA(0, 0, At, B0); PG8_MMA(0, 1, At, B1); PG8_BAR; PG8_SCHED;
            PG8_LDA(At, 1, 1); PG8_STAGE(PG8_SB(1, 0), b3, voffB); PG8_STAGE(PG8_SB(1, 1), b3 + hstep, voffB); PG8_STAGE(PG8_SA(1, 0), a3, voffA);
            PG8_WAIT_V(8); PG8_WAIT_L(0); PG8_BAR; PG8_MMA(1, 0, At, B0); PG8_MMA(1, 1, At, B1); PG8_BAR; PG8_SCHED;
            } else {
            PG8_LDB(B0, 0, 0); PG8_SCHED; PG8_LDA(At, 0, 0); PG8_STAGE(PG8_SA(1, 1), a1 + hstep, voffA);
            PG8_WAIT_L(8); PG8_BAR; PG8_WAIT_L(0); PG8_MMA(0, 0, At, B0); PG8_BAR; PG8_SCHED;
            PG8_LDB(B1, 0, 1); PG8_STAGE(PG8_SB(0, 0), b2, voffB);
            PG8_BAR; PG8_WAIT_L(0); PG8_MMA(0, 1, At, B1); PG8_BAR;
            PG8_LDA(At, 0, 1); PG8_STAGE(PG8_SA(0, 0), a2, voffA);
            PG8_BAR; PG8_WAIT_L(0); PG8_MMA(1, 0, At, B0); PG8_BAR; PG8_SCHED;
            PG8_STAGE(PG8_SB(0, 1), b2 + hstep, voffB);
            PG8_WAIT_V(6); PG8_BAR; PG8_MMA(1, 1, At, B1); PG8_BAR;
            PG8_LDB(B0, 1, 0); PG8_SCHED; PG8_LDA(At, 1, 0); PG8_STAGE(PG8_SA(0, 1), a2 + hstep, voffA);
            PG8_WAIT_L(8); PG8_BAR; PG8_WAIT_L(0); PG8_MMA(0, 0, At, B0); PG8_BAR; PG8_SCHED;
            PG8_LDB(B1, 1, 1); PG8_STAGE(PG8_SB(1, 0), b3, voffB);
            PG8_BAR; PG8_WAIT_L(0); PG8_MMA(0, 1, At, B1); PG8_BAR;
            PG8_LDA(At, 1, 1); PG8_STAGE(PG8_SA(1, 0), a3, voffA);
            PG8_BAR; PG8_WAIT_L(0); PG8_MMA(1, 0, At, B0); PG8_BAR; PG8_SCHED;
            PG8_STAGE(PG8_SB(1, 1), b3 + hstep, voffB);
            PG8_WAIT_V(6); PG8_BAR; PG8_MMA(1, 1, At, B1); PG8_BAR;
            }
        }
        if constexpr (ALIGN_EPI) { if (wr == 0) PG8_BAR; }
        if constexpr (!Epi::AFTER_DRAIN) { E(acc, cur, wr, wc, fr, fq); S.done(cur); }
        if (!has_next) break;
#pragma unroll
        for (int a = 0; a < 2; ++a)
#pragma unroll
            for (int b = 0; b < 2; ++b)
#pragma unroll
                for (int m = 0; m < 4; ++m)
#pragma unroll
                    for (int n = 0; n < 2; ++n) acc[a][b][m][n] = (f32x4){0.f, 0.f, 0.f, 0.f};
        cur = nxt; cA = nA; cB = nB; ++ui;
        if constexpr (ALIGN_EPI) { if (wr == 1) PG8_BAR; }
    }
    PG8_WAIT_V(0);
    if constexpr (!ALIGN_EPI) { if (wr == 0) PG8_BAR; }
    PG8_BAR;
    if constexpr (Epi::AFTER_DRAIN) { E.fused(acc, cur, wr, wc, fr, fq, lds, wid, lane); S.done(cur); }
#undef PG8_SA
#undef PG8_SB
#undef PG8_STAGE
#undef PG8_LDA
#undef PG8_LDB
#undef PG8_MMA
#undef PG8_WAIT_V
#undef PG8_WAIT_L
#undef PG8_BAR
#undef PG8_SCHED
}
}
#ifndef ATT_LOCKSTEP
#define ATT_LOCKSTEP 0
#endif
#ifndef PROBE_DUP
#define PROBE_DUP 0
#endif

#define LAS __attribute__((address_space(3)))
typedef unsigned short bf16;
typedef unsigned v4u __attribute__((ext_vector_type(4)));
typedef float f32x4 __attribute__((ext_vector_type(4)));
using pg8::bf2f; using pg8::f2bf1;
constexpr int NWAVES = 8, NTHR = 512, GRID = 256;
constexpr int SEQ = 8192, D = 1024, M = 2 * SEQ, FF = 2816, DEPTH = 4;
constexpr int RET_IN = 6144, DIFF_IN = 3072;
constexpr float RMS_EPS = 1e-6f;
constexpr float LOG2E = 1.4426950408889634f;
constexpr size_t MiB = 1u << 20;
constexpr size_t WS_CTL = 0, CTL_ZERO_BYTES = 1 * MiB;
constexpr size_t WS_TAB = 640 * 1024;
constexpr size_t WS_X = 1 * MiB;
constexpr size_t WS_WIN = 2 * MiB, WS_WOUT = 14 * MiB, WS_WGU = 18 * MiB, WS_WDN = 29 * MiB;
constexpr size_t WS_Q = 35 * MiB, WS_K = 67 * MiB, WS_VT = 99 * MiB, WS_G = 163 * MiB, WS_ST = 227 * MiB, WS_END = 291 * MiB;
constexpr size_t WS_XN = WS_ST, WS_ACT = WS_K;
constexpr int CW_BAR = 131072;
constexpr int CW_CNT = 1024;
constexpr int LDS_BYTES = 147456;
#ifndef MFMA_SCAN
#define MFMA_SCAN 1
#endif
#ifndef MFMA_ROUT
#define MFMA_ROUT 1
#endif
#ifndef MFMA_ATTN
#define MFMA_ATTN 1
#endif
#ifndef PER_PHASE_LAUNCH
#define PER_PHASE_LAUNCH 1
#endif
#ifndef NAIVE_MIXERS
#define NAIVE_MIXERS 0
#endif

struct Args { const float* in[12]; float* out; unsigned char* ws; };

__device__ __forceinline__ unsigned pk2(float lo, float hi) { return (unsigned)f2bf1(lo) | ((unsigned)f2bf1(hi) << 16); }
__device__ __forceinline__ float wave_sum(float v) {
#pragma unroll
    for (int o = 1; o < 64; o <<= 1) v += __shfl_xor(v, o);
    return v;
}
__device__ __forceinline__ float dot8(v4u a, v4u b) {
    float s = 0.f;
#pragma unroll
    for (int i = 0; i < 4; ++i) { s += __uint_as_float(a[i] << 16) * __uint_as_float(b[i] << 16); s += __uint_as_float(a[i] & 0xffff0000u) * __uint_as_float(b[i] & 0xffff0000u); }
    return s;
}
struct TrItem { const float* W; int Nsrc, K, k0, c0, r0; };
__device__ __forceinline__ void tr_load(float (&v)[32], const TrItem& t, int lane) {
#pragma unroll
    for (int i = 0; i < 32; ++i) { const int kk = 2 * i + (lane >> 5); v[i] = t.W[(size_t)(t.k0 + kk) * t.Nsrc + t.c0 + (lane & 31)]; }
}
__device__ __forceinline__ void tr_finish(const float (&v)[32], const TrItem& t, bf16* WT, LAS float* scr, int lane) {
#pragma unroll
    for (int i = 0; i < 32; ++i) { const int kk = 2 * i + (lane >> 5); scr[kk * 33 + (lane & 31)] = v[i]; }
    asm volatile("s_waitcnt lgkmcnt(0)" ::: "memory");
    const int c = lane & 7;
#pragma unroll
    for (int j = 0; j < 4; ++j) { const int n = (lane >> 3) + 8 * j; const LAS float* s = scr + (8 * c) * 33 + n;
        v4u o; o.x = pk2(s[0 * 33], s[1 * 33]); o.y = pk2(s[2 * 33], s[3 * 33]); o.z = pk2(s[4 * 33], s[5 * 33]); o.w = pk2(s[6 * 33], s[7 * 33]);
        *(v4u*)(WT + (size_t)(t.r0 + n) * t.K + t.k0 + 8 * c) = o; }
    asm volatile("s_waitcnt lgkmcnt(0)" ::: "memory");
}
__device__ __forceinline__ TrItem item_plain(const float* W, int K, int N, int it) { const int nblk = N / 32, kb = it / nblk, nb = it % nblk; return TrItem{W, N, K, 64 * kb, 32 * nb, 32 * nb}; }
__device__ __forceinline__ TrItem item_gu(const float* Wg, const float* Wu, int it) { const int nblk = FF / 32, nit = (D / 64) * nblk, which = it >= nit, r = which ? it - nit : it, kb = r / nblk, nb = r % nblk, c0 = 32 * nb;
    return TrItem{which ? Wu : Wg, FF, D, 64 * kb, c0, 256 * (c0 >> 7) + 128 * which + (c0 & 127)}; }
#define CONV_LOOP(NIT, ITEM, WT) do { const int nit_ = (NIT); float va_[32], vb_[32]; int it_ = gw; \
        if (it_ < nit_) { const TrItem ta_ = ITEM(it_); tr_load(va_, ta_, lane); } \
        while (it_ < nit_) { \
            { const TrItem ta_ = ITEM(it_); const int nx_ = it_ + ngw; if (nx_ < nit_) { const TrItem tb_ = ITEM(nx_); tr_load(vb_, tb_, lane); } tr_finish(va_, ta_, (WT), scr, lane); it_ = nx_; } \
            if (it_ >= nit_) break; \
            { const TrItem tb_ = ITEM(it_); const int nx_ = it_ + ngw; if (nx_ < nit_) { const TrItem ta_ = ITEM(nx_); tr_load(va_, ta_, lane); } tr_finish(vb_, tb_, (WT), scr, lane); it_ = nx_; } \
        } } while (0)
__device__ __forceinline__ void conv_plain(const float* W, int K, int N, bf16* WT, LAS float* scr, int gw, int ngw, int lane) {
#define ITEM_(i) item_plain(W, K, N, (i))
    for (int rep_ = 0; rep_ < ((PROBE_DUP & 256) ? 2 : 1); ++rep_) CONV_LOOP((K / 64) * (N / 32), ITEM_, WT);
#undef ITEM_
}
__device__ __forceinline__ void conv_gu(const float* Wg, const float* Wu, bf16* WT, LAS float* scr, int gw, int ngw, int lane) {
#define ITEM_(i) item_gu(Wg, Wu, (i))
    for (int rep_ = 0; rep_ < ((PROBE_DUP & 256) ? 2 : 1); ++rep_) CONV_LOOP(2 * (D / 64) * (FF / 32), ITEM_, WT);
#undef ITEM_
}
__device__ __forceinline__ void rms_row_to_bf16(const float* xrow, const float* g, bf16* orow, int lane) {
    const f32x4* xr = (const f32x4*)xrow + lane; const f32x4* gr = (const f32x4*)g + lane;
    f32x4 v[4]; float s2 = 0.f;
#pragma unroll
    for (int j = 0; j < 4; ++j) { v[j] = xr[64 * j]; s2 += (v[j].x * v[j].x + v[j].y * v[j].y) + (v[j].z * v[j].z + v[j].w * v[j].w); }
    const float rstd = 1.f / sqrtf(wave_sum(s2) * (1.f / D) + RMS_EPS);
    unsigned long long* o8 = (unsigned long long*)orow + lane;
#pragma unroll
    for (int j = 0; j < 4; ++j) { const f32x4 gg = gr[64 * j]; o8[64 * j] = (unsigned long long)pk2(v[j].x * rstd * gg.x, v[j].y * rstd * gg.y) | ((unsigned long long)pk2(v[j].z * rstd * gg.z, v[j].w * rstd * gg.w) << 32); }
}

__device__ __forceinline__ float head_log2_gamma(int h) { return __builtin_log2f(1.0f - __builtin_exp2f(-5.0f - (float)h)); }
__device__ __forceinline__ void ret_scan_naive(const bf16* K, const bf16* VT, bf16* ST) {
    const int gid = blockIdx.x * NTHR + threadIdx.x;
    const int bh = gid >> 14, rem = gid & 16383, e = rem >> 5, d0 = (rem & 31) * 8;
    const float lg2 = head_log2_gamma(bh & 3), cd = __builtin_exp2f(256.f * lg2);
    float st[8];
#pragma unroll
    for (int j = 0; j < 8; ++j) st[j] = 0.f;
    const bf16* vt = VT + ((size_t)(bh * 512 + e)) * SEQ; const bf16* kp = K + (size_t)bh * SEQ * 256 + d0;
    for (int c2 = 0; c2 < 32; ++c2) {
        v4u o; o.x = pk2(st[0], st[1]); o.y = pk2(st[2], st[3]); o.z = pk2(st[4], st[5]); o.w = pk2(st[6], st[7]);
        *(v4u*)(ST + (((size_t)(bh * 32 + c2)) * 512 + e) * 256 + d0) = o;
#pragma unroll
        for (int j = 0; j < 8; ++j) st[j] *= cd;
        for (int m = 0; m < 256; ++m) { const int t = c2 * 256 + m; const float v = bf2f(vt[t]) * __builtin_exp2f((float)(255 - m) * lg2);
            const v4u kk = *(const v4u*)(kp + (size_t)t * 256);
#pragma unroll
            for (int i = 0; i < 4; ++i) { st[2 * i] += v * __uint_as_float(kk[i] << 16); st[2 * i + 1] += v * __uint_as_float(kk[i] & 0xffff0000u); } }
    }
}
__device__ __forceinline__ void ret_out_naive(LAS unsigned char* lds, const bf16* Q, const bf16* K, const bf16* VT, bf16* GY, const bf16* ST) {
    LAS bf16* Qs = (LAS bf16*)lds; LAS bf16* In = (LAS bf16*)(lds + 128 * 264 * 2); LAS float* ss = (LAS float*)(lds + 2 * 128 * 264 * 2);
    const int tid = threadIdx.x;
    for (int task = blockIdx.x; task < 512; task += gridDim.x) {
        const int bh = task >> 6, c = task & 63, h = bh & 3, odd = c & 1, nk = odd ? 256 : 128, sh = odd ? 8 : 7, tk0 = (c & ~1) * 128, tq0 = c * 128;
        const float lg2 = head_log2_gamma(h);
        __syncthreads();
#pragma unroll
        for (int i = 0; i < 8; ++i) { const int ch = tid + NTHR * i, r = ch >> 5, cc = ch & 31; *(LAS v4u*)(Qs + r * 264 + cc * 8) = *(const v4u*)(Q + ((size_t)(bh * SEQ + tq0 + r)) * 256 + cc * 8); }
        __syncthreads();
        for (int idx = tid; idx < 128 * nk; idx += NTHR) { const int n = idx >> sh, m = idx & (nk - 1), dist = (tq0 + n) - (tk0 + m); float val = 0.f;
            if (dist >= 0) { const bf16* kp = K + ((size_t)(bh * SEQ + tk0 + m)) * 256; float dot = 0.f;
                for (int d8 = 0; d8 < 32; ++d8) dot += dot8(*(const v4u*)(kp + d8 * 8), *(const LAS v4u*)(Qs + n * 264 + d8 * 8));
                val = dot * __builtin_exp2f((float)dist * lg2); }
            In[n * 264 + m] = f2bf1(val); }
        __syncthreads();
        const int n = tid & 127, eq = tid >> 7; const float qdec = __builtin_exp2f((float)(n + 1 + odd * 128) * lg2); float ssq = 0.f;
        const size_t grow = ((size_t)((bh >> 2) * SEQ + tq0 + n)) * 2048 + h * 512;
        for (int ee = 0; ee < 128; ++ee) { const int e = eq * 128 + ee;
            const bf16* vt = VT + ((size_t)(bh * 512 + e)) * SEQ + tk0; float a = 0.f;
            for (int m8 = 0; m8 < nk / 8; ++m8) a += dot8(*(const v4u*)(vt + m8 * 8), *(const LAS v4u*)(In + n * 264 + m8 * 8));
            const bf16* sp = ST + (((size_t)(bh * 32 + (c >> 1))) * 512 + e) * 256; float cr = 0.f;
            for (int d8 = 0; d8 < 32; ++d8) cr += dot8(*(const v4u*)(sp + d8 * 8), *(const LAS v4u*)(Qs + n * 264 + d8 * 8));
            a += qdec * cr; ssq += a * a;
            GY[grow + e] = f2bf1(a * bf2f(GY[grow + e])); }
        ss[eq * 128 + n] = ssq;
        __syncthreads();
        const float rstd = 1.0f / sqrtf(((ss[n] + ss[128 + n]) + (ss[256 + n] + ss[384 + n])) * (1.0f / 512.0f) + RMS_EPS);
        for (int ee = 0; ee < 128; ++ee) { const int e = eq * 128 + ee; GY[grow + e] = f2bf1(bf2f(GY[grow + e]) * rstd); }
    }
}
__device__ __forceinline__ void attn_naive(LAS unsigned char* lds, const bf16* Qd, const bf16* Kd, const bf16* VTd, bf16* Od, const float* lut, float lam, const float* subln, float outscale) {
    LAS float* ss = (LAS float*)lds; LAS bf16* Qs = (LAS bf16*)(lds + 2048);
    const int tid = threadIdx.x, lane = tid & 63, eg = tid >> 6;
    const int w = blockIdx.x, bh = w & 15, g = w >> 4, b = bh >> 3, h = bh & 7;
    for (int ui = 0; ui < 8; ++ui) {
        const int pr = ui >> 1, qb = (ui & 1) ? (32 * pr + 31 - g) : (32 * pr + g);
        const int q = qb * 64 + lane; const size_t qrow = (size_t)(b * SEQ + q);
        __syncthreads();
        if (eg == 0) {
#pragma unroll
            for (int i = 0; i < 16; ++i) *(LAS v4u*)(Qs + lane * 136 + i * 8) = *(const v4u*)(Qd + qrow * 1024 + h * 128 + i * 8);
        }
        __syncthreads();
        const LAS bf16* qv = Qs + lane * 136;
        float o1[16], o2[16], m1 = -1e30f, m2 = -1e30f, l1 = 0.f, l2 = 0.f;
#pragma unroll
        for (int j = 0; j < 16; ++j) { o1[j] = 0.f; o2[j] = 0.f; }
        const int kend = qb * 64 + 64;
        for (int k0 = 0; k0 < kend; k0 += 8) {
            float s1[8], s2[8];
#pragma unroll
            for (int kk = 0; kk < 8; ++kk) { const int key = k0 + kk; const bf16* kp = Kd + ((size_t)(b * SEQ + key)) * 1024 + h * 128; float d1 = 0.f, d2 = 0.f;
#pragma unroll
                for (int i = 0; i < 8; ++i) { d1 += dot8(*(const LAS v4u*)(qv + i * 8), *(const v4u*)(kp + i * 8)); d2 += dot8(*(const LAS v4u*)(qv + 64 + i * 8), *(const v4u*)(kp + 64 + i * 8)); }
                const int rel = q - key; const int idx = rel < 0 ? 0 : (rel > 127 ? 127 : rel); const float bias = lut[h * 128 + idx];
                s1[kk] = rel >= 0 ? d1 + bias : -1e30f; s2[kk] = rel >= 0 ? d2 + bias : -1e30f; asm volatile("" ::: "memory"); }
            float mx1 = m1, mx2 = m2;
#pragma unroll
            for (int kk = 0; kk < 8; ++kk) { mx1 = fmaxf(mx1, s1[kk]); mx2 = fmaxf(mx2, s2[kk]); }
            const float f1 = __builtin_amdgcn_exp2f(m1 - mx1), f2 = __builtin_amdgcn_exp2f(m2 - mx2); m1 = mx1; m2 = mx2; l1 *= f1; l2 *= f2;
#pragma unroll
            for (int j = 0; j < 16; ++j) { o1[j] *= f1; o2[j] *= f2; }
#pragma unroll
            for (int kk = 0; kk < 8; ++kk) { s1[kk] = __builtin_amdgcn_exp2f(s1[kk] - mx1); s2[kk] = __builtin_amdgcn_exp2f(s2[kk] - mx2); l1 += s1[kk]; l2 += s2[kk]; }
#pragma unroll
            for (int j = 0; j < 16; ++j) { const v4u vv = *(const v4u*)(VTd + ((size_t)(bh * 128 + eg * 16 + j)) * SEQ + k0);
#pragma unroll
                for (int i = 0; i < 4; ++i) { const float vl = __uint_as_float(vv[i] << 16), vh = __uint_as_float(vv[i] & 0xffff0000u);
                    o1[j] += s1[2 * i] * vl + s1[2 * i + 1] * vh; o2[j] += s2[2 * i] * vl + s2[2 * i + 1] * vh; } }
        }
        float ssq = 0.f; const float r1 = 1.0f / l1, r2 = lam / l2;
#pragma unroll
        for (int j = 0; j < 16; ++j) { o1[j] = o1[j] * r1 - o2[j] * r2; ssq += o1[j] * o1[j]; }
        __syncthreads();
        ss[eg * 64 + lane] = ssq;
        __syncthreads();
        float sst = 0.f;
#pragma unroll
        for (int i = 0; i < 8; ++i) sst += ss[i * 64 + lane];
        const float rstd = outscale / sqrtf(sst * (1.0f / 128.0f) + RMS_EPS);
#pragma unroll
        for (int j = 0; j < 16; ++j) Od[qrow * 1024 + h * 128 + eg * 16 + j] = f2bf1(o1[j] * rstd * subln[eg * 16 + j]);
    }
}

typedef short bf16x8_t __attribute__((ext_vector_type(8)));
typedef float f32x16 __attribute__((ext_vector_type(16)));
typedef unsigned v2u __attribute__((ext_vector_type(2)));
typedef float f32x2 __attribute__((ext_vector_type(2)));
#define MFMA32(a, b, c) __builtin_amdgcn_mfma_f32_32x32x16_bf16((a), (b), (c), 0, 0, 0)
__device__ __forceinline__ int crow(int i, int hh) { return (i & 3) + 8 * (i >> 2) + 4 * hh; }
__device__ __forceinline__ float xhalf_max(float v) { const auto rr = __builtin_amdgcn_permlane32_swap(__float_as_uint(v), __float_as_uint(v), false, false); return fmaxf(__uint_as_float(rr[0]), __uint_as_float(rr[1])); }
__device__ __forceinline__ float xhalf_sum(float v) { const auto rr = __builtin_amdgcn_permlane32_swap(__float_as_uint(v), __float_as_uint(v), false, false); return __uint_as_float(rr[0]) + __uint_as_float(rr[1]); }
__device__ __forceinline__ float max3f(float a, float b, float c) { float r; asm("v_max3_f32 %0, %1, %2, %3" : "=v"(r) : "v"(a), "v"(b), "v"(c)); return r; }
__device__ __forceinline__ unsigned cvtpk(float lo, float hi) { return pg8::cvt_pk_bf16(lo, hi); }
__device__ __forceinline__ bf16x8_t pack_frag(const f32x16& p, int s) {
    v4u w; w.x = cvtpk(p[8 * s + 0], p[8 * s + 1]); w.y = cvtpk(p[8 * s + 2], p[8 * s + 3]); w.z = cvtpk(p[8 * s + 4], p[8 * s + 5]); w.w = cvtpk(p[8 * s + 6], p[8 * s + 7]);
    return __builtin_bit_cast(bf16x8_t, w);
}
constexpr int AT_KSTR = 136, AT_VSTR = 68, AT_KBUF = 64 * AT_KSTR * 2, AT_VBUF = 128 * AT_VSTR * 2;
constexpr int AT_VOFF = 2 * AT_KBUF, AT_LUT = AT_VOFF + 2 * AT_VBUF;
template <int AMODE = 0> __device__ __forceinline__ void attn_mfma(const int tid, const int bid, LAS unsigned char* lds, const bf16* Qd, const bf16* Kd, const bf16* VTd, bf16* Od, const float* lutg, const float* rel_tab, float lam, const float* subln, float outscale) {
    const int lane = tid & 63, r = lane & 31, hh = lane >> 5;
    const int wave = __builtin_amdgcn_readfirstlane(tid >> 6), mi = wave & 1, g = wave >> 1;
    const int w = bid, bh = w & 15, g16 = w >> 4, b = bh >> 3, h = bh & 7;
    LAS float* lut = (LAS float*)(lds + AT_LUT); LAS float* ex = (LAS float*)lds;
    const float NEG = -1e30f;
    __syncthreads();
    if (tid < 128) lut[tid] = lutg[h * 128 + tid] - rel_tab[31 * 8 + h] * LOG2E;
    const bf16* kg = Kd + ((size_t)(b * SEQ)) * 1024 + h * 128 + (size_t)(tid >> 4) * 1024 + (tid & 15) * 8;
    const bf16* vg = VTd + ((size_t)(bh * 128 + (tid >> 3))) * SEQ + (tid & 7) * 8;
    const int kso = ((tid >> 4) * AT_KSTR + (tid & 15) * 8) * 2, vso = AT_VOFF + ((tid >> 3) * AT_VSTR + (tid & 7) * 8) * 2;
    for (int ui = 0; ui < 4; ++ui) {
        const int qb = ui == 0 ? g16 : (ui == 1 ? 31 - g16 : (ui == 2 ? 32 + g16 : 63 - g16));
        const int qw = qb * 128 + 32 * g, NT = 2 * qb + 2, qabs = qw + r;
        const bf16* qp = Qd + ((size_t)(b * SEQ + qabs)) * 1024 + h * 128 + 64 * mi + 8 * hh;
        bf16x8_t qf[4];
#pragma unroll
        for (int ds = 0; ds < 4; ++ds) qf[ds] = *(const bf16x8_t*)(qp + 16 * ds);
        f32x16 o[4];
#pragma unroll
        for (int dt = 0; dt < 4; ++dt)
#pragma unroll
            for (int i = 0; i < 16; ++i) o[dt][i] = 0.f;
        float mref = 0.f, l = 0.f; bool first = true;
        v4u kr0, kr1, vr0, vr1;
        const int NTw = (qw + 31) / 64 + 1 < NT ? (qw + 31) / 64 + 1 : NT;
        const bool isY = wave >= 4;
#define AT_LOADK(t) do { kr0 = *(const v4u*)(kg + (size_t)(t) * 64 * 1024); kr1 = *(const v4u*)(kg + (size_t)(t) * 64 * 1024 + 32 * 1024); } while (0)
#define AT_LOADV(t) do { vr0 = *(const v4u*)(vg + (t) * 64); vr1 = *(const v4u*)(vg + (size_t)64 * SEQ + (t) * 64); } while (0)
#define AT_STOREK(bf) do { *(LAS v4u*)(lds + (bf) * AT_KBUF + kso) = kr0; *(LAS v4u*)(lds + (bf) * AT_KBUF + kso + 32 * AT_KSTR * 2) = kr1; } while (0)
#define AT_STOREV(bf) do { *(LAS v2u*)(lds + (bf) * AT_VBUF + vso) = (v2u){vr0.x, vr0.y}; *(LAS v2u*)(lds + (bf) * AT_VBUF + vso + 8) = (v2u){vr0.z, vr0.w}; \
        *(LAS v2u*)(lds + (bf) * AT_VBUF + vso + 64 * AT_VSTR * 2) = (v2u){vr1.x, vr1.y}; *(LAS v2u*)(lds + (bf) * AT_VBUF + vso + 64 * AT_VSTR * 2 + 8) = (v2u){vr1.z, vr1.w}; } while (0)
#define AT_SB __builtin_amdgcn_sched_barrier(0)
#define AT_PVB(bv) do { const LAS unsigned char* vb_ = lds + AT_VOFF + (bv) * AT_VBUF + (r * AT_VSTR + 4 * hh) * 2; v4u fa0, fb0, fa1, fb1, fa2, fb2; { const LAS unsigned char* a_ = vb_ + 0 * 32 * AT_VSTR * 2 + 0 * 32; const v2u l0 = *(const LAS v2u*)a_, h0 = *(const LAS v2u*)(a_ + 16), l1 = *(const LAS v2u*)(a_ + 32 * AT_VSTR * 2), h1 = *(const LAS v2u*)(a_ + 32 * AT_VSTR * 2 + 16); fa0 = (v4u){l0.x, l0.y, h0.x, h0.y}; fb0 = (v4u){l1.x, l1.y, h1.x, h1.y}; } AT_SB; { const LAS unsigned char* a_ = vb_ + 2 * 32 * AT_VSTR * 2 + 0 * 32; const v2u l0 = *(const LAS v2u*)a_, h0 = *(const LAS v2u*)(a_ + 16), l1 = *(const LAS v2u*)(a_ + 32 * AT_VSTR * 2), h1 = *(const LAS v2u*)(a_ + 32 * AT_VSTR * 2 + 16); fa1 = (v4u){l0.x, l0.y, h0.x, h0.y}; fb1 = (v4u){l1.x, l1.y, h1.x, h1.y}; } AT_SB; { const LAS unsigned char* a_ = vb_ + 0 * 32 * AT_VSTR * 2 + 1 * 32; const v2u l0 = *(const LAS v2u*)a_, h0 = *(const LAS v2u*)(a_ + 16), l1 = *(const LAS v2u*)(a_ + 32 * AT_VSTR * 2), h1 = *(const LAS v2u*)(a_ + 32 * AT_VSTR * 2 + 16); fa2 = (v4u){l0.x, l0.y, h0.x, h0.y}; fb2 = (v4u){l1.x, l1.y, h1.x, h1.y}; } AT_SB; { __builtin_amdgcn_s_setprio(1); o[0] = MFMA32(__builtin_bit_cast(bf16x8_t, fa0), pb0, o[0]); o[1] = MFMA32(__builtin_bit_cast(bf16x8_t, fb0), pb0, o[1]); __builtin_amdgcn_s_setprio(0); } AT_SB; { const LAS unsigned char* a_ = vb_ + 2 * 32 * AT_VSTR * 2 + 1 * 32; const v2u l0 = *(const LAS v2u*)a_, h0 = *(const LAS v2u*)(a_ + 16), l1 = *(const LAS v2u*)(a_ + 32 * AT_VSTR * 2), h1 = *(const LAS v2u*)(a_ + 32 * AT_VSTR * 2 + 16); fa0 = (v4u){l0.x, l0.y, h0.x, h0.y}; fb0 = (v4u){l1.x, l1.y, h1.x, h1.y}; } AT_SB; { __builtin_amdgcn_s_setprio(1); o[2] = MFMA32(__builtin_bit_cast(bf16x8_t, fa1), pb0, o[2]); o[3] = MFMA32(__builtin_bit_cast(bf16x8_t, fb1), pb0, o[3]); __builtin_amdgcn_s_setprio(0); } AT_SB; { const LAS unsigned char* a_ = vb_ + 0 * 32 * AT_VSTR * 2 + 2 * 32; const v2u l0 = *(const LAS v2u*)a_, h0 = *(const LAS v2u*)(a_ + 16), l1 = *(const LAS v2u*)(a_ + 32 * AT_VSTR * 2), h1 = *(const LAS v2u*)(a_ + 32 * AT_VSTR * 2 + 16); fa1 = (v4u){l0.x, l0.y, h0.x, h0.y}; fb1 = (v4u){l1.x, l1.y, h1.x, h1.y}; } AT_SB; { __builtin_amdgcn_s_setprio(1); o[0] = MFMA32(__builtin_bit_cast(bf16x8_t, fa2), pb1, o[0]); o[1] = MFMA32(__builtin_bit_cast(bf16x8_t, fb2), pb1, o[1]); __builtin_amdgcn_s_setprio(0); } AT_SB; { const LAS unsigned char* a_ = vb_ + 2 * 32 * AT_VSTR * 2 + 2 * 32; const v2u l0 = *(const LAS v2u*)a_, h0 = *(const LAS v2u*)(a_ + 16), l1 = *(const LAS v2u*)(a_ + 32 * AT_VSTR * 2), h1 = *(const LAS v2u*)(a_ + 32 * AT_VSTR * 2 + 16); fa2 = (v4u){l0.x, l0.y, h0.x, h0.y}; fb2 = (v4u){l1.x, l1.y, h1.x, h1.y}; } AT_SB; { __builtin_amdgcn_s_setprio(1); o[2] = MFMA32(__builtin_bit_cast(bf16x8_t, fa0), pb1, o[2]); o[3] = MFMA32(__builtin_bit_cast(bf16x8_t, fb0), pb1, o[3]); __builtin_amdgcn_s_setprio(0); } AT_SB; { const LAS unsigned char* a_ = vb_ + 0 * 32 * AT_VSTR * 2 + 3 * 32; const v2u l0 = *(const LAS v2u*)a_, h0 = *(const LAS v2u*)(a_ + 16), l1 = *(const LAS v2u*)(a_ + 32 * AT_VSTR * 2), h1 = *(const LAS v2u*)(a_ + 32 * AT_VSTR * 2 + 16); fa0 = (v4u){l0.x, l0.y, h0.x, h0.y}; fb0 = (v4u){l1.x, l1.y, h1.x, h1.y}; } AT_SB; { __builtin_amdgcn_s_setprio(1); o[0] = MFMA32(__builtin_bit_cast(bf16x8_t, fa1), pb2, o[0]); o[1] = MFMA32(__builtin_bit_cast(bf16x8_t, fb1), pb2, o[1]); __builtin_amdgcn_s_setprio(0); } AT_SB; { const LAS unsigned char* a_ = vb_ + 2 * 32 * AT_VSTR * 2 + 3 * 32; const v2u l0 = *(const LAS v2u*)a_, h0 = *(const LAS v2u*)(a_ + 16), l1 = *(const LAS v2u*)(a_ + 32 * AT_VSTR * 2), h1 = *(const LAS v2u*)(a_ + 32 * AT_VSTR * 2 + 16); fa1 = (v4u){l0.x, l0.y, h0.x, h0.y}; fb1 = (v4u){l1.x, l1.y, h1.x, h1.y}; } AT_SB; { __builtin_amdgcn_s_setprio(1); o[2] = MFMA32(__builtin_bit_cast(bf16x8_t, fa2), pb2, o[2]); o[3] = MFMA32(__builtin_bit_cast(bf16x8_t, fb2), pb2, o[3]); __builtin_amdgcn_s_setprio(0); } AT_SB; { __builtin_amdgcn_s_setprio(1); o[0] = MFMA32(__builtin_bit_cast(bf16x8_t, fa0), pb3, o[0]); o[1] = MFMA32(__builtin_bit_cast(bf16x8_t, fb0), pb3, o[1]); __builtin_amdgcn_s_setprio(0); } AT_SB; { __builtin_amdgcn_s_setprio(1); o[2] = MFMA32(__builtin_bit_cast(bf16x8_t, fa1), pb3, o[2]); o[3] = MFMA32(__builtin_bit_cast(bf16x8_t, fb1), pb3, o[3]); __builtin_amdgcn_s_setprio(0); } AT_SB; } while (0)
#define AT_QKB(bk) do { const LAS unsigned char* kb_ = lds + (bk) * AT_KBUF + (r * AT_KSTR + 64 * mi + 8 * hh) * 2; v4u fa0, fb0, fa1, fb1, fa2, fb2; { fa0 = *(const LAS v4u*)(kb_ + 0 * 32); fb0 = *(const LAS v4u*)(kb_ + 32 * AT_KSTR * 2 + 0 * 32); } AT_SB; { fa1 = *(const LAS v4u*)(kb_ + 1 * 32); fb1 = *(const LAS v4u*)(kb_ + 32 * AT_KSTR * 2 + 1 * 32); } AT_SB; { fa2 = *(const LAS v4u*)(kb_ + 2 * 32); fb2 = *(const LAS v4u*)(kb_ + 32 * AT_KSTR * 2 + 2 * 32); } AT_SB; { __builtin_amdgcn_s_setprio(1); p0 = MFMA32(__builtin_bit_cast(bf16x8_t, fa0), qf[0], p0); p1 = MFMA32(__builtin_bit_cast(bf16x8_t, fb0), qf[0], p1); __builtin_amdgcn_s_setprio(0); } AT_SB; { fa0 = *(const LAS v4u*)(kb_ + 3 * 32); fb0 = *(const LAS v4u*)(kb_ + 32 * AT_KSTR * 2 + 3 * 32); } AT_SB; { __builtin_amdgcn_s_setprio(1); p0 = MFMA32(__builtin_bit_cast(bf16x8_t, fa1), qf[1], p0); p1 = MFMA32(__builtin_bit_cast(bf16x8_t, fb1), qf[1], p1); __builtin_amdgcn_s_setprio(0); } AT_SB; { __builtin_amdgcn_s_setprio(1); p0 = MFMA32(__builtin_bit_cast(bf16x8_t, fa2), qf[2], p0); p1 = MFMA32(__builtin_bit_cast(bf16x8_t, fb2), qf[2], p1); __builtin_amdgcn_s_setprio(0); } AT_SB; { __builtin_amdgcn_s_setprio(1); p0 = MFMA32(__builtin_bit_cast(bf16x8_t, fa0), qf[3], p0); p1 = MFMA32(__builtin_bit_cast(bf16x8_t, fb0), qf[3], p1); __builtin_amdgcn_s_setprio(0); } AT_SB; } while (0)
#define AT_SOFTMAX(t) do { const int k0 = (t) * 64; \
        if (qw - k0 - 63 < 113) { \
            _Pragma("unroll") for (int i = 0; i < 16; ++i) { const int rel0 = qabs - (k0 + crow(i, hh)), rel1 = rel0 - 32; \
                p0[i] = rel0 < 0 ? NEG : p0[i] + lut[rel0 > 127 ? 127 : rel0]; p1[i] = rel1 < 0 ? NEG : p1[i] + lut[rel1 > 127 ? 127 : rel1]; } } \
        float mt = max3f(p0[0], p0[1], p1[0]), mu = max3f(p0[2], p0[3], p1[1]); mt = max3f(mt, p1[2], p1[3]); \
        _Pragma("unroll") for (int i = 4; i < 16; i += 4) { mt = max3f(mt, p0[i], p0[i + 1]); mu = max3f(mu, p0[i + 2], p0[i + 3]); mt = max3f(mt, p1[i], p1[i + 1]); mu = max3f(mu, p1[i + 2], p1[i + 3]); } \
        mt = xhalf_max(fmaxf(mt, mu)) - mref; \
        if (__any(first ? 1 : (mt > 6.0f))) { \
            const float dl = first ? mt : fmaxf(mt, 0.f), alpha = first ? 1.0f : __builtin_amdgcn_exp2f(-dl); mref += dl; l *= alpha; \
            _Pragma("unroll") for (int dt = 0; dt < 4; ++dt) _Pragma("unroll") for (int i = 0; i < 16; ++i) o[dt][i] *= alpha; \
            first = false; } \
        { f32x2 ls2 = {0.f, 0.f}; const f32x2 nm = {-mref, -mref}; \
          _Pragma("unroll") for (int i = 0; i < 16; i += 2) { f32x2 a = (f32x2){p0[i], p0[i + 1]} + nm, b = (f32x2){p1[i], p1[i + 1]} + nm; \
              a.x = __builtin_amdgcn_exp2f(a.x); a.y = __builtin_amdgcn_exp2f(a.y); b.x = __builtin_amdgcn_exp2f(b.x); b.y = __builtin_amdgcn_exp2f(b.y); \
              p0[i] = a.x; p0[i + 1] = a.y; p1[i] = b.x; p1[i + 1] = b.y; ls2 += a; ls2 += b; } \
          l += ls2.x + ls2.y; } \
        pb0 = pack_frag(p0, 0); pb1 = pack_frag(p0, 1); pb2 = pack_frag(p1, 0); pb3 = pack_frag(p1, 1); } while (0)
#if ATT_LOCKSTEP
        __syncthreads();
        AT_LOADK(0); AT_LOADV(0); AT_STOREK(0); AT_STOREV(0);
        __syncthreads();
        for (int t = 0; t < NT; ++t) {
            f32x16 p0, p1; bf16x8_t pb0, pb1, pb2, pb3;
#pragma unroll
            for (int i = 0; i < 16; ++i) { p0[i] = 0.f; p1[i] = 0.f; }
            if (t + 1 < NT) { AT_LOADK(t + 1); AT_LOADV(t + 1); }
            if (t < NTw) { AT_QKB(t & 1); AT_SOFTMAX(t); AT_PVB(t & 1); }
            if (t + 1 < NT) { AT_STOREK((t + 1) & 1); AT_STOREV((t + 1) & 1); }
            __syncthreads();
        }
        (void)isY;
#else
        __syncthreads();
        AT_LOADK(0); AT_LOADV(0); AT_STOREK(0); AT_STOREV(0); AT_LOADK(1); AT_STOREK(1);
        __syncthreads();
        if (isY) __syncthreads();
        for (int t = 0; t < NT; ++t) {
            f32x16 p0, p1; bf16x8_t pb0, pb1, pb2, pb3;
#pragma unroll
            for (int i = 0; i < 16; ++i) { p0[i] = 0.f; p1[i] = 0.f; }
            if (t < NTw) AT_QKB(t & 1);
            if (!(AMODE & 4) && t >= 1) { if (t + 1 < NT) AT_STOREK((t + 1) & 1); if (t < NT) AT_STOREV(t & 1); }
            __syncthreads();
            if (!(AMODE & 4)) { if (t + 2 < NT) AT_LOADK(t + 2); if (t + 1 < NT) AT_LOADV(t + 1); }
            if (t < NTw) {
                AT_SOFTMAX(t);
                __syncthreads();
                AT_PVB(t & 1);
            } else __syncthreads();
        }
        __syncthreads();
        if (!isY) __syncthreads();
#endif
#undef AT_LOADK
#undef AT_LOADV
#undef AT_STOREK
#undef AT_STOREV
#undef AT_SB
#undef AT_PVB
#undef AT_QKB
#undef AT_SOFTMAX
        l = xhalf_sum(l);
        const float linv = 1.0f / l;
        if (mi == 1) { const float sc = lam * linv;
#pragma unroll
            for (int dt = 0; dt < 4; ++dt)
#pragma unroll
                for (int i = 0; i < 16; ++i) ex[g * 4096 + (32 * dt + crow(i, hh)) * 32 + r] = o[dt][i] * sc; }
        __syncthreads();
        if (mi == 0) { float ssq = 0.f;
#pragma unroll
            for (int dt = 0; dt < 4; ++dt)
#pragma unroll
                for (int i = 0; i < 16; ++i) { const float v = o[dt][i] * linv - ex[g * 4096 + (32 * dt + crow(i, hh)) * 32 + r]; o[dt][i] = v; ssq += v * v; }
            ssq += __shfl_xor(ssq, 32);
            const float rstd = outscale / sqrtf(ssq * (1.0f / 128.0f) + RMS_EPS);
            bf16* op = Od + ((size_t)(b * SEQ + qabs)) * 1024 + h * 128 + 4 * hh;
#pragma unroll
            for (int dt = 0; dt < 4; ++dt)
#pragma unroll
                for (int i4 = 0; i4 < 4; ++i4) { const int dv = 32 * dt + 8 * i4; const f32x4 sg = *(const f32x4*)(subln + dv + 4 * hh);
                    v2u wv; wv.x = cvtpk(o[dt][4 * i4] * rstd * sg[0], o[dt][4 * i4 + 1] * rstd * sg[1]); wv.y = cvtpk(o[dt][4 * i4 + 2] * rstd * sg[2], o[dt][4 * i4 + 3] * rstd * sg[3]);
                    *(v2u*)(op + dv) = wv; }
        }
    }
}

constexpr int R1_STR = 264;
constexpr int R1_TILE = 64 * R1_STR * 2;
__device__ __forceinline__ void ret_scan_mfma(const int tid, const int bid, LAS unsigned char* lds, const bf16* K, const bf16* VT, bf16* ST) {
    const int lane = tid & 63, r = lane & 31, hh = lane >> 5, wave = __builtin_amdgcn_readfirstlane(tid >> 6);
    const int w = bid, bh = w & 7, eb = w >> 5, db = (w >> 3) & 3, h = bh & 3;
    const float lg2 = head_log2_gamma(h), cd = __builtin_exp2f(256.f * lg2);
    const bf16* vg = VT + ((size_t)(bh * 512 + eb * 64 + (tid >> 5))) * SEQ + (tid & 31) * 8;
    const bf16* kg = K + ((size_t)(bh * SEQ + lane)) * 256 + db * 64 + wave * 8;
    v4u vrA[4], krA[4], vrB[4], krB[4];
#define R1_LOAD(vr, kr, c2) do { _Pragma("unroll") for (int i = 0; i < 4; ++i) { vr[i] = *(const v4u*)(vg + (size_t)(16 * i) * SEQ + (c2) * 256); kr[i] = *(const v4u*)(kg + (size_t)((c2) * 256 + 64 * i) * 256); } } while (0)
#define R1_STORE(vr, kr, bf) do { _Pragma("unroll") for (int i = 0; i < 4; ++i) { \
        *(LAS v4u*)(lds + (bf) * R1_TILE + (((tid >> 5) + 16 * i) * R1_STR + (tid & 31) * 8) * 2) = vr[i]; \
        const int m_ = lane + 64 * i; const float kd_ = __builtin_amdgcn_exp2f((float)(255 - m_) * lg2); \
        LAS bf16* kt_ = (LAS bf16*)(lds + (2 + (bf)) * R1_TILE) + (wave * 8) * R1_STR + m_; \
        _Pragma("unroll") for (int q_ = 0; q_ < 4; ++q_) { kt_[(2 * q_) * R1_STR] = f2bf1(__uint_as_float(kr[i][q_] << 16) * kd_); kt_[(2 * q_ + 1) * R1_STR] = f2bf1(__uint_as_float(kr[i][q_] & 0xffff0000u) * kd_); } } } while (0)
    f32x16 acc;
#pragma unroll
    for (int i = 0; i < 16; ++i) acc[i] = 0.f;
    const int et2 = wave & 1, dt2 = (wave >> 1) & 1;
#define R1_COMPUTE(c2) do { if (wave < 4) { \
            bf16* sp = ST + (((size_t)(bh * 32 + (c2))) * 512 + eb * 64 + 32 * et2) * 256 + db * 64 + 32 * dt2 + r; \
            _Pragma("unroll") for (int i = 0; i < 16; ++i) { sp[(size_t)crow(i, hh) * 256] = f2bf1(acc[i]); acc[i] *= cd; } \
            const LAS unsigned char* ab = lds + ((c2) & 1) * R1_TILE + ((32 * et2 + r) * R1_STR + 8 * hh) * 2; \
            const LAS unsigned char* bb = lds + (2 + ((c2) & 1)) * R1_TILE + ((32 * dt2 + r) * R1_STR + 8 * hh) * 2; \
            bf16x8_t fa[16], fb[16]; \
            _Pragma("unroll") for (int ks = 0; ks < 16; ++ks) { fa[ks] = *(const LAS bf16x8_t*)(ab + ks * 32); fb[ks] = *(const LAS bf16x8_t*)(bb + ks * 32); } \
            _Pragma("unroll") for (int ks = 0; ks < 16; ++ks) acc = MFMA32(fa[ks], fb[ks], acc); } } while (0)
    __syncthreads();
    R1_LOAD(vrA, krA, 0); R1_LOAD(vrB, krB, 1); R1_STORE(vrA, krA, 0);
    __syncthreads();
    for (int c2 = 0; c2 < 32; c2 += 2) {
        if (c2 + 2 < 32) R1_LOAD(vrA, krA, c2 + 2);
        R1_COMPUTE(c2);
        R1_STORE(vrB, krB, 1);
        __syncthreads();
        if (c2 + 3 < 32) R1_LOAD(vrB, krB, c2 + 3);
        R1_COMPUTE(c2 + 1);
        if (c2 + 2 < 32) R1_STORE(vrA, krA, 0);
        __syncthreads();
    }
#undef R1_COMPUTE
#undef R1_LOAD
#undef R1_STORE
}
constexpr int R2_STR = 264, R2_PB = 128 * R2_STR * 2, R2_SOFF = R2_PB, R2_SBUF = 512 * 64, R2_SS = R2_SOFF + 2 * R2_SBUF;
__device__ __forceinline__ void ret_out_mfma(const int tid, const int bid, LAS unsigned char* lds, const bf16* Q, const bf16* K, const bf16* VT, bf16* GY, const bf16* ST, const int dry = 0) {
    const int wave = __builtin_amdgcn_readfirstlane(tid >> 6), nt = wave & 3, eh = wave >> 2;
    LAS float* ssp = (LAS float*)(lds + R2_SS);
#define R2_IDS int t_ = tid; asm volatile("" : "+v"(t_)); const int lane = t_ & 63, r = lane & 31, hh = lane >> 5; \
    const int srow = t_ >> 2, sc4 = t_ & 3, sso = R2_SOFF + srow * 64 + ((sc4 ^ ((srow >> 2) & 3)) * 16), fsw = (r >> 2) & 3, fro = R2_SOFF + (256 * eh + r) * 64; \
    (void)lane; (void)srow; (void)sc4; (void)sso; (void)fsw; (void)fro; (void)hh;
    for (int task = bid; task < 512; task += gridDim.x) {
        const int bh = task >> 6, c = (task & 63) ^ (task >> 8), h = bh & 3, odd = c & 1, tk0 = (c & ~1) * 128, tq0 = c * 128;
        const float lg2 = head_log2_gamma(h);
        f32x16 acc[8];
#pragma unroll
        for (int et = 0; et < 8; ++et)
#pragma unroll
            for (int i = 0; i < 16; ++i) acc[et][i] = 0.f;
        v4u srA[4], srB[4];
#define R2_QG (Q + ((size_t)(bh * SEQ + tq0 + 32 * nt + r)) * 256 + 8 * hh)
#define R2_LOADS(sr, src, rstride, sl) do { _Pragma("unroll") for (int i = 0; i < 4; ++i) sr[i] = *(const v4u*)((src) + (size_t)(srow + 128 * i) * (rstride) + 32 * (sl) + 8 * sc4); } while (0)
#define R2_STORES(sr, bf) do { _Pragma("unroll") for (int i = 0; i < 4; ++i) *(LAS v4u*)(lds + (bf) * R2_SBUF + sso + 128 * i * 64) = sr[i]; } while (0)
#define R2_AFRAG(bf, et, ksl) (*(const LAS bf16x8_t*)(lds + (bf) * R2_SBUF + fro + (et) * 32 * 64 + (((2 * (ksl) + hh) ^ fsw) * 16)))
#define R2_SB __builtin_amdgcn_sched_barrier(0)
#define R2_SLICE(bf, b0, b1) do { const int bf_ = (bf); const bf16x8_t b0_ = (b0), b1_ = (b1); bf16x8_t fa0, fb0, fa1, fb1, fa2, fb2; { fa0 = R2_AFRAG(bf_, 0, 0); fb0 = R2_AFRAG(bf_, 0, 1); } R2_SB; { fa1 = R2_AFRAG(bf_, 1, 0); fb1 = R2_AFRAG(bf_, 1, 1); } R2_SB; { fa2 = R2_AFRAG(bf_, 2, 0); fb2 = R2_AFRAG(bf_, 2, 1); } R2_SB; { acc[0] = MFMA32(fa0, b0_, acc[0]); acc[0] = MFMA32(fb0, b1_, acc[0]); } R2_SB; { fa0 = R2_AFRAG(bf_, 3, 0); fb0 = R2_AFRAG(bf_, 3, 1); } R2_SB; { acc[1] = MFMA32(fa1, b0_, acc[1]); acc[1] = MFMA32(fb1, b1_, acc[1]); } R2_SB; { fa1 = R2_AFRAG(bf_, 4, 0); fb1 = R2_AFRAG(bf_, 4, 1); } R2_SB; { acc[2] = MFMA32(fa2, b0_, acc[2]); acc[2] = MFMA32(fb2, b1_, acc[2]); } R2_SB; { fa2 = R2_AFRAG(bf_, 5, 0); fb2 = R2_AFRAG(bf_, 5, 1); } R2_SB; { acc[3] = MFMA32(fa0, b0_, acc[3]); acc[3] = MFMA32(fb0, b1_, acc[3]); } R2_SB; { fa0 = R2_AFRAG(bf_, 6, 0); fb0 = R2_AFRAG(bf_, 6, 1); } R2_SB; { acc[4] = MFMA32(fa1, b0_, acc[4]); acc[4] = MFMA32(fb1, b1_, acc[4]); } R2_SB; { fa1 = R2_AFRAG(bf_, 7, 0); fb1 = R2_AFRAG(bf_, 7, 1); } R2_SB; { acc[5] = MFMA32(fa2, b0_, acc[5]); acc[5] = MFMA32(fb2, b1_, acc[5]); } R2_SB; { acc[6] = MFMA32(fa0, b0_, acc[6]); acc[6] = MFMA32(fb0, b1_, acc[6]); } R2_SB; { acc[7] = MFMA32(fa1, b0_, acc[7]); acc[7] = MFMA32(fb1, b1_, acc[7]); } R2_SB; } while (0)
        { R2_IDS const bf16* qg = R2_QG; const bf16* src = ST + (((size_t)(bh * 32 + (c >> 1))) * 512) * 256;
          __syncthreads();
          bf16x8_t qA0, qA1, qB0, qB1;
          R2_LOADS(srA, src, 256, 0); qA0 = *(const bf16x8_t*)(qg); qA1 = *(const bf16x8_t*)(qg + 16);
          R2_LOADS(srB, src, 256, 1); qB0 = *(const bf16x8_t*)(qg + 32); qB1 = *(const bf16x8_t*)(qg + 48);
          R2_STORES(srA, 0);
          __syncthreads();
          for (int sl = 0; sl < 8; sl += 2) {
              const bf16x8_t c0 = qA0, c1 = qA1;
              if (sl + 2 < 8) { R2_LOADS(srA, src, 256, sl + 2); qA0 = *(const bf16x8_t*)(qg + 32 * (sl + 2)); qA1 = *(const bf16x8_t*)(qg + 32 * (sl + 2) + 16); }
              R2_SLICE(0, c0, c1);
              R2_STORES(srB, 1);
              __syncthreads();
              const bf16x8_t e0 = qB0, e1 = qB1;
              if (sl + 3 < 8) { R2_LOADS(srB, src, 256, sl + 3); qB0 = *(const bf16x8_t*)(qg + 32 * (sl + 3)); qB1 = *(const bf16x8_t*)(qg + 32 * (sl + 3) + 16); }
              R2_SLICE(1, e0, e1);
              if (sl + 2 < 8) R2_STORES(srA, 0);
              __syncthreads();
          } }
        { R2_IDS const float qdec = __builtin_amdgcn_exp2f((float)(32 * nt + r + 1 + odd * 128) * lg2);
#pragma unroll
          for (int et = 0; et < 8; ++et)
#pragma unroll
              for (int i = 0; i < 16; ++i) acc[et][i] *= qdec; }
        const int nmt = odd ? 4 + nt + 1 : nt + 1;
        for (int mt = eh; mt < nmt; mt += 2) {
            R2_IDS const bf16* qg = R2_QG;
            f32x16 p;
#pragma unroll
            for (int i = 0; i < 16; ++i) p[i] = 0.f;
            const bf16* kb = K + ((size_t)(bh * SEQ + tk0 + 32 * mt + r)) * 256 + 8 * hh;
#pragma unroll 8
            for (int ks = 0; ks < 16; ++ks) p = MFMA32(*(const bf16x8_t*)(kb + ks * 16), *(const bf16x8_t*)(qg + ks * 16), p);
            const int nq = tq0 + 32 * nt + r, mk = tk0 + 32 * mt + 4 * hh;
#pragma unroll
            for (int i4 = 0; i4 < 4; ++i4) { float v[4];
#pragma unroll
                for (int k = 0; k < 4; ++k) { const int dist = nq - (mk + 8 * i4 + k); v[k] = dist < 0 ? 0.f : p[4 * i4 + k] * __builtin_amdgcn_exp2f((float)dist * lg2); }
                v2u wv; wv.x = cvtpk(v[0], v[1]); wv.y = cvtpk(v[2], v[3]);
                *(LAS v2u*)(lds + ((32 * nt + r) * R2_STR + 32 * mt + 8 * i4 + 4 * hh) * 2) = wv; }
        }
        { R2_IDS const bf16* src = VT + ((size_t)(bh * 512)) * SEQ + tk0; const LAS unsigned char* pb = lds + ((32 * nt + r) * R2_STR + 8 * hh) * 2;
          const int nsl = odd ? 8 : 4;
          R2_LOADS(srA, src, SEQ, 0); R2_LOADS(srB, src, SEQ, 1); R2_STORES(srA, 0);
          __syncthreads();
          for (int sl = 0; sl < nsl; sl += 2) {
              if (sl + 2 < nsl) R2_LOADS(srA, src, SEQ, sl + 2);
              if (sl < nmt) { const bf16x8_t bp0 = *(const LAS bf16x8_t*)(pb + sl * 64), bp1 = *(const LAS bf16x8_t*)(pb + sl * 64 + 32); R2_SLICE(0, bp0, bp1); }
              R2_STORES(srB, 1);
              __syncthreads();
              if (sl + 3 < nsl) R2_LOADS(srB, src, SEQ, sl + 3);
              if (sl + 1 < nmt) { const bf16x8_t bp0 = *(const LAS bf16x8_t*)(pb + (sl + 1) * 64), bp1 = *(const LAS bf16x8_t*)(pb + (sl + 1) * 64 + 32); R2_SLICE(1, bp0, bp1); }
              if (sl + 2 < nsl) R2_STORES(srA, 0);
              __syncthreads();
          } }
#undef R2_LOADS
#undef R2_STORES
#undef R2_AFRAG
#undef R2_SLICE
#undef R2_SB
#undef R2_QG
        { R2_IDS float ssq = 0.f;
#pragma unroll
          for (int et = 0; et < 8; ++et)
#pragma unroll
              for (int i = 0; i < 16; ++i) ssq += acc[et][i] * acc[et][i];
          ssq += __shfl_xor(ssq, 32);
          if (hh == 0) ssp[eh * 128 + 32 * nt + r] = ssq; }
        __syncthreads();
        { R2_IDS const float rstd = 1.0f / sqrtf((ssp[32 * nt + r] + ssp[128 + 32 * nt + r]) * (1.0f / 512.0f) + RMS_EPS);
          bf16* gp = GY + ((size_t)((bh >> 2) * SEQ + tq0 + 32 * nt + r)) * 2048 + h * 512 + 256 * eh + 4 * hh;
#pragma unroll
          for (int et = 0; et < 8; ++et)
#pragma unroll
              for (int i4 = 0; i4 < 4; ++i4) { bf16* p4 = gp + 32 * et + 8 * i4; const v2u gg = *(const v2u*)p4;
                  v2u wv; wv.x = cvtpk(acc[et][4 * i4] * rstd * __uint_as_float(gg.x << 16), acc[et][4 * i4 + 1] * rstd * __uint_as_float(gg.x & 0xffff0000u));
                  wv.y = cvtpk(acc[et][4 * i4 + 2] * rstd * __uint_as_float(gg.y << 16), acc[et][4 * i4 + 3] * rstd * __uint_as_float(gg.y & 0xffff0000u));
                  if (!dry || rstd == 1.2345e38f) *(v2u*)p4 = wv; if (i4 == 3 && (et & 1)) asm volatile("" ::: "memory"); } }
    }
}

__device__ __forceinline__ void ret_out_mfma_d(const int dry, const int tid, const int bid, LAS unsigned char* lds, const bf16* Q, const bf16* K, const bf16* VT, bf16* GY, const bf16* ST) { ret_out_mfma(tid, bid, lds, Q, K, VT, GY, ST, dry); }
#define XB_TMO      128
#define XB_XCNT(j)  (256  + 64 * (j))
#define XB_XSUB(j)  (1280 + 64 * (j))
#define XB_XGEN(j)  (2304 + 64 * (j))
#define XB_TOP      3328
#define XB_TOPGEN   3392
#define XCD_BAR_WORDS 3456
#define XB_SPIN_CAP (1u << 18)

__device__ __forceinline__ unsigned xb_ld(unsigned* p)              { return __hip_atomic_load(p, __ATOMIC_RELAXED, __HIP_MEMORY_SCOPE_AGENT); }
__device__ __forceinline__ unsigned xb_add(unsigned* p, unsigned v) { return __hip_atomic_fetch_add(p, v, __ATOMIC_RELAXED, __HIP_MEMORY_SCOPE_AGENT); }
__device__ __forceinline__ unsigned xb_xcc_id() { return (unsigned)__builtin_amdgcn_s_getreg((3 << 11) | 20) & 0xFu; }
#define XB_SPIN(cond, bar) do { unsigned _sp = 0; while (cond) { __builtin_amdgcn_s_sleep(1); \
    if ((++_sp & 255u) == 0u) { if (xb_ld(&(bar)[XB_TMO])) break; if (_sp > XB_SPIN_CAP) { atomicAdd(&(bar)[XB_TMO], 1u); break; } } } } while (0)

struct XcdBarrier {
    unsigned* bar; unsigned x;
    volatile LAS unsigned* st;
};

__device__ __forceinline__ XcdBarrier xcd_barrier_post(unsigned* bar, volatile LAS unsigned* st) {
    XcdBarrier b; b.bar = bar; b.x = xb_xcc_id(); b.st = st;
    if (threadIdx.x == 0) (void)xb_add(&bar[XB_XCNT(b.x)], 1u);
    return b;
}
__device__ __forceinline__ void xcd_barrier_complete(unsigned* bar, unsigned x, unsigned& nloc, unsigned& nx) {
    const unsigned G = gridDim.x * gridDim.y * gridDim.z;
    unsigned sum, cnt, mine, sp = 0u;
    for (;;) {
        sum = 0u; cnt = 0u; mine = 0u;
#pragma unroll
        for (unsigned j = 0; j < 16; ++j) { const unsigned c = xb_ld(&bar[XB_XCNT(j)]); sum += c; cnt += (c > 0u) ? 1u : 0u; mine = (j == x) ? c : mine; }
        if (sum == G) break;
        __builtin_amdgcn_s_sleep(1);
        if ((++sp & 255u) == 0u) { if (xb_ld(&bar[XB_TMO])) break; if (sp > XB_SPIN_CAP) { atomicAdd(&bar[XB_TMO], 1u); break; } }
    }
    nloc = mine > 0u ? mine : 1u; nx = cnt > 0u ? cnt : 1u;
}

__device__ __forceinline__ void xcd_barrier(const XcdBarrier& b) {
    asm volatile("s_waitcnt vmcnt(0)" ::: "memory");
    __syncthreads();
    if (threadIdx.x == 0) {
        unsigned* bar = b.bar;
        __builtin_amdgcn_s_waitcnt(0);
        unsigned nloc = b.st[0], nx = b.st[1];
        if (nloc == 0u) { xcd_barrier_complete(bar, b.x, nloc, nx); b.st[0] = nloc; b.st[1] = nx; }
        const unsigned old = xb_add(&bar[XB_XSUB(b.x)], 1u);
        const unsigned gen = old / nloc;
        if (old + 1u == (gen + 1u) * nloc) {
            __builtin_amdgcn_fence(__ATOMIC_RELEASE, "agent");
            asm volatile("s_waitcnt vmcnt(0)" ::: "memory");
            const unsigned og = xb_add(&bar[XB_TOP], 1u);
            const unsigned tg = og / nx;
            if (og + 1u == (tg + 1u) * nx) xb_add(&bar[XB_TOPGEN], 1u);
            else XB_SPIN(xb_ld(&bar[XB_TOPGEN]) == tg, bar);
            __builtin_amdgcn_fence(__ATOMIC_ACQUIRE, "agent");
            xb_add(&bar[XB_XGEN(b.x)], 1u);
            asm volatile("s_waitcnt vmcnt(0)" ::: "memory");
        } else {
            XB_SPIN(xb_ld(&bar[XB_XGEN(b.x)]) == gen, bar);
            __builtin_amdgcn_fence(__ATOMIC_ACQUIRE, "agent");
            asm volatile("s_waitcnt vmcnt(0)" ::: "memory");
        }
    }
    __syncthreads();
}


#if NAIVE_MIXERS
#define MIXER_RET_A
#define MIXER_RET_B
#define MIXER_DIFF
#else
#define MIXER_RET_A for (int rep_ = 0; rep_ < ((PROBE_DUP & 2) ? 2 : 1); ++rep_) if (IN(pb + 1)) { PH_BEGIN ret_scan_mfma(tid, bid, lds, (const bf16*)(ws + WS_K), (const bf16*)(ws + WS_VT), (bf16*)(ws + WS_ST)); }
#define MIXER_RET_B for (int rep_ = ((PROBE_DUP & 128) ? 1 : 0); rep_ >= 0; --rep_) if (IN(pb + 2)) { PH_BEGIN ret_out_mfma_d(rep_, tid, bid, lds, (const bf16*)(ws + WS_Q), (const bf16*)(ws + WS_K), (const bf16*)(ws + WS_VT), (bf16*)(ws + WS_G), (const bf16*)(ws + WS_ST)); }
#ifndef PROBE_AMODE
#define PROBE_AMODE 0
#endif
#define MIXER_DIFF for (int rep_ = 0; rep_ < ((PROBE_DUP & 1) ? 2 : 1); ++rep_) if (IN(pb + 2)) { PH_BEGIN const float* tab_ = (const float*)(ws + WS_TAB); \
    if (PROBE_AMODE != 0 && rep_ == 0) attn_mfma<PROBE_AMODE>(tid, bid, lds, (const bf16*)(ws + WS_Q), (const bf16*)(ws + WS_K), (const bf16*)(ws + WS_VT), (bf16*)(ws + WS_G), tab_, ka_in(ka, 8), tab_[1024 + j], ka_in(ka, 7) + j * 128, tab_[1024 + 2 + j]); else \
    attn_mfma(tid, bid, lds, (const bf16*)(ws + WS_Q), (const bf16*)(ws + WS_K), (const bf16*)(ws + WS_VT), (bf16*)(ws + WS_G), tab_, ka_in(ka, 8), tab_[1024 + j], ka_in(ka, 7) + j * 128, tab_[1024 + 2 + j]); }
#endif
#if NAIVE_MIXERS
__global__ void __launch_bounds__(NTHR) k_scan_naive(const bf16* K, const bf16* VT, bf16* ST) { ret_scan_naive(K, VT, ST); }
__global__ void __launch_bounds__(NTHR) k_rout_naive(const bf16* Q, const bf16* K, const bf16* VT, bf16* GY, const bf16* ST) {
    extern __shared__ __attribute__((aligned(16))) unsigned char lds_raw[]; ret_out_naive((LAS unsigned char*)lds_raw, Q, K, VT, GY, ST); }
__global__ void __launch_bounds__(NTHR, 2) k_scan_mfma(const bf16* K, const bf16* VT, bf16* ST) {
    extern __shared__ __attribute__((aligned(16))) unsigned char lds_raw[]; ret_scan_mfma(threadIdx.x, blockIdx.x, (LAS unsigned char*)lds_raw, K, VT, ST); }
__global__ void __launch_bounds__(NTHR, 2) k_rout_mfma(const bf16* Q, const bf16* K, const bf16* VT, bf16* GY, const bf16* ST) {
    extern __shared__ __attribute__((aligned(16))) unsigned char lds_raw[]; ret_out_mfma(threadIdx.x, blockIdx.x, (LAS unsigned char*)lds_raw, Q, K, VT, GY, ST); }
__global__ void __launch_bounds__(NTHR, 2) k_attn_mfma(const bf16* Qd, const bf16* Kd, const bf16* VTd, bf16* Od, const float* tab, int j, const float* subln, const float* rel_tab) {
    extern __shared__ __attribute__((aligned(16))) unsigned char lds_raw[]; attn_mfma(threadIdx.x, blockIdx.x, (LAS unsigned char*)lds_raw, Qd, Kd, VTd, Od, tab, rel_tab, tab[1024 + j], subln + j * 128, tab[1024 + 2 + j]); }
__global__ void __launch_bounds__(NTHR) k_attn_naive(const bf16* Qd, const bf16* Kd, const bf16* VTd, bf16* Od, const float* tab, int j, const float* subln) {
    extern __shared__ __attribute__((aligned(16))) unsigned char lds_raw[]; attn_naive((LAS unsigned char*)lds_raw, Qd, Kd, VTd, Od, tab, tab[1024 + j], subln + j * 128, tab[1024 + 2 + j]); }

#endif
typedef const unsigned char __attribute__((address_space(4)))* kaptr;
__device__ __forceinline__ kaptr ka_get() { kaptr p = (kaptr)__builtin_amdgcn_kernarg_segment_ptr(); asm volatile("" : "+s"(p)); return p; }
__device__ __forceinline__ const float* ka_in(kaptr p, int i) { return *(const float* const __attribute__((address_space(4)))*)(p + 8 * i); }
__device__ __forceinline__ float* ka_out(kaptr p) { return *(float* const __attribute__((address_space(4)))*)(p + 96); }
__device__ __forceinline__ unsigned char* ka_ws(kaptr p) { return *(unsigned char* const __attribute__((address_space(4)))*)(p + 104); }
__device__ __forceinline__ int tid_get() { int t = threadIdx.x; asm volatile("" : "+v"(t)); return t; }
__device__ __forceinline__ int bid_get() { int t = blockIdx.x; asm volatile("" : "+s"(t)); return t; }
#define PH_BEGIN const kaptr ka = ka_get(); unsigned char* const ws = ka_ws(ka); const int tid = tid_get(), lane = tid & 63, wave = __builtin_amdgcn_readfirstlane(tid >> 6); \
    const int bid = bid_get(); const int G = gridDim.x, gw = bid * NWAVES + wave, ngw = G * NWAVES; (void)bid; LAS float* const scr = (LAS float*)(lds + wave * 16384); (void)lane; (void)gw; (void)ngw; (void)scr; (void)ws;

__global__ void __launch_bounds__(NTHR, 2) fwd_mega(Args args_unused, int ph_lo, int ph_hi) {
    extern __shared__ __attribute__((aligned(16))) unsigned char lds_raw[];
    cg::grid_group grid = cg::this_grid();
    LAS unsigned char* lds = (LAS unsigned char*)lds_raw;
    volatile LAS unsigned* xst = (volatile LAS unsigned*)(lds + LDS_BYTES - 64);
    if (threadIdx.x < 2) xst[threadIdx.x] = 0u;
    __syncthreads();
    const XcdBarrier xbar = xcd_barrier_post((unsigned*)(ka_ws(ka_get()) + WS_CTL) + CW_BAR, xst);

#define IN(k) (ph_lo <= (k) && (k) < ph_hi)
#define SEAM(k) do { if (IN(k) && IN((k) + 1)) { if (ph_hi < 0) grid.sync(); else xcd_barrier(xbar); } } while (0)
    if (IN(0)) {
        PH_BEGIN
        conv_plain(ka_in(ka, 2), D, RET_IN, (bf16*)(ws + WS_WIN), scr, gw, ngw, lane);
        conv_plain(ka_in(ka, 3), 2048, D, (bf16*)(ws + WS_WOUT), scr, gw, ngw, lane);
        conv_gu(ka_in(ka, 9), ka_in(ka, 10), (bf16*)(ws + WS_WGU), scr, gw, ngw, lane);
        conv_plain(ka_in(ka, 11), FF, D, (bf16*)(ws + WS_WDN), scr, gw, ngw, lane);
        { const float* x = ka_in(ka, 0); const float* gains = ka_in(ka, 1); bf16* XN = (bf16*)(ws + WS_XN);
          for (int m = gw; m < M; m += ngw) rms_row_to_bf16(x + (size_t)m * D, gains, XN + (size_t)m * D, lane); }
        { unsigned* ctl = (unsigned*)(ws + WS_CTL); for (int i = bid * NTHR + tid; i < 16 * 64 * 64; i += G * NTHR) ctl[CW_CNT + i] = 0u; }
        if (bid == 0) {
            const float* rel_tab = ka_in(ka, 8); const float* diff_lambda = ka_in(ka, 6); float* lut = (float*)(ws + WS_TAB); float* lamtab = (float*)(ws + WS_TAB + 4096);
            for (int t = tid; t < 1024; t += NTHR) { const int h = t >> 7, n = t & 127; int bk;
                if (n < 16) bk = n; else { bk = 16 + (int)(__builtin_logf((float)n * (1.0f / 16.0f)) / 2.0794415416798357f * 16.0f); if (bk > 31) bk = 31; }
                lut[t] = rel_tab[bk * 8 + h] * LOG2E; }
            if (tid < 2) { const float* lm = diff_lambda + tid * 256; float a = 0.f, b2 = 0.f; for (int i = 0; i < 64; ++i) { a += lm[i] * lm[64 + i]; b2 += lm[128 + i] * lm[192 + i]; }
                const int li = 2 * tid + 1; const float linit = 0.8f - 0.6f * __builtin_expf(-0.3f * (float)li); lamtab[tid] = __builtin_expf(a) - __builtin_expf(b2) + linit; lamtab[2 + tid] = 1.0f - linit; }
        }
    }
    SEAM(0);

    for (int L = 0; L < DEPTH; ++L) {
        asm volatile("" : "+s"(L));
        const int j = L >> 1; const bool isRet = (L & 1) == 0; const int pb = 1 + 6 * L; (void)j;
        if (L > 0 && IN(pb)) { PH_BEGIN conv_plain(ka_in(ka, 11) + (size_t)L * FF * D, FF, D, (bf16*)(ws + WS_WDN), scr, gw, ngw, lane); __syncthreads(); }
        if (isRet) {
            for (int rep_ = 0; rep_ < ((PROBE_DUP & 4) ? 2 : 1); ++rep_) if (IN(pb)) { PH_BEGIN
              pg8::Gemm g{(const bf16*)(ws + WS_XN), (const bf16*)(ws + WS_WIN), M, RET_IN, D}; pg8::StaticOrder S; S.init(M, RET_IN, G, bid);
              pg8::EpiRetIn E{(bf16*)(ws + WS_Q), (bf16*)(ws + WS_K), (bf16*)(ws + WS_VT), (bf16*)(ws + WS_G), lds + 131072 + wave * 1536};
              pg8::gemm_phase<pg8::EpiRetIn, pg8::StaticOrder, true, true>(lds, g, S, E); }
            SEAM(pb);
            MIXER_RET_A
            SEAM(pb + 1);
            MIXER_RET_B
            SEAM(pb + 2);
        } else {
            if (IN(pb)) { PH_BEGIN
              pg8::Gemm g{(const bf16*)(ws + WS_XN), (const bf16*)(ws + WS_WIN), M, DIFF_IN, D}; pg8::StaticOrder S; S.init(M, DIFF_IN, G, bid);
              pg8::EpiDiffIn E{(bf16*)(ws + WS_Q), (bf16*)(ws + WS_K), (bf16*)(ws + WS_VT), 0.125f * LOG2E, lds + 131072 + wave * 1536};
              pg8::gemm_phase<pg8::EpiDiffIn, pg8::StaticOrder, true, true>(lds, g, S, E); }
            SEAM(pb);
            SEAM(pb + 1);
            MIXER_DIFF
            SEAM(pb + 2);
        }
        if (IN(pb + 3)) { PH_BEGIN
          const float* gL = ka_in(ka, 1) + (size_t)L * 4 * D; float* out = ka_out(ka); unsigned* ctl = (unsigned*)(ws + WS_CTL);
          pg8::Gemm g{(const bf16*)(ws + WS_G), (const bf16*)(ws + WS_WOUT), M, D, isRet ? 2048 : 1024}; pg8::StaticOrder S; S.init(M, D, G, bid);
          pg8::EpiNormResNorm E{L == 0 ? ka_in(ka, 0) : (const float*)out, out, (bf16*)(ws + WS_XN), gL + D, gL + 2 * D, (float*)(ws + WS_X), ctl + CW_CNT + (L * 4 + 0) * 64 * 64, RMS_EPS, 0};
          pg8::gemm_phase<pg8::EpiNormResNorm, pg8::StaticOrder, false, true>(lds, g, S, E); }
        SEAM(pb + 3);
        for (int rep_ = 0; rep_ < ((PROBE_DUP & 8) ? 2 : 1); ++rep_) if (IN(pb + 4)) { PH_BEGIN
          pg8::Gemm g{(const bf16*)(ws + WS_XN), (const bf16*)(ws + WS_WGU), M, 2 * FF, D}; pg8::StaticOrder S; S.init(M, 2 * FF, G, bid);
          pg8::EpiSwiGLU E{(bf16*)(ws + WS_ACT)};
          pg8::gemm_phase<pg8::EpiSwiGLU, pg8::StaticOrder, true, true>(lds, g, S, E); }
        SEAM(pb + 4);
        if (L + 1 < DEPTH && IN(pb + 5)) { PH_BEGIN
            const int nj = (L + 1) >> 1;
            if ((L + 1) & 1) { conv_plain(ka_in(ka, 4) + (size_t)nj * D * DIFF_IN, D, DIFF_IN, (bf16*)(ws + WS_WIN), scr, gw, ngw, lane); conv_plain(ka_in(ka, 5) + (size_t)nj * D * D, D, D, (bf16*)(ws + WS_WOUT), scr, gw, ngw, lane); }
            else { conv_plain(ka_in(ka, 2) + (size_t)nj * D * RET_IN, D, RET_IN, (bf16*)(ws + WS_WIN), scr, gw, ngw, lane); conv_plain(ka_in(ka, 3) + (size_t)nj * 2048 * D, 2048, D, (bf16*)(ws + WS_WOUT), scr, gw, ngw, lane); }
            conv_gu(ka_in(ka, 9) + (size_t)(L + 1) * D * FF, ka_in(ka, 10) + (size_t)(L + 1) * D * FF, (bf16*)(ws + WS_WGU), scr, gw, ngw, lane);
            __syncthreads();
        }
#if (PROBE_DUP & 32)
        if (IN(pb + 5)) { PH_BEGIN
          pg8::Gemm g{(const bf16*)(ws + WS_ACT), (const bf16*)(ws + WS_WDN), M, D, FF}; pg8::StaticOrder S; S.init(M, D, G, bid);
          pg8::EpiNull E{(float*)(ws + WS_TAB + 8192)};
          pg8::gemm_phase<pg8::EpiNull, pg8::StaticOrder, false, true>(lds, g, S, E); }
#endif
        if (IN(pb + 5)) { PH_BEGIN
          const float* gains = ka_in(ka, 1); const float* gL = gains + (size_t)L * 4 * D; float* out = ka_out(ka); unsigned* ctl = (unsigned*)(ws + WS_CTL);
          pg8::Gemm g{(const bf16*)(ws + WS_ACT), (const bf16*)(ws + WS_WDN), M, D, FF}; pg8::StaticOrder S; S.init(M, D, G, bid);
          const float* gnext = (L + 1 < DEPTH) ? gains + (size_t)(L + 1) * 4 * D : gL;
          pg8::EpiNormResNorm E{(const float*)out, out, (bf16*)(ws + WS_XN), gL + 3 * D, gnext, (float*)(ws + WS_X), ctl + CW_CNT + (L * 4 + 2) * 64 * 64, RMS_EPS, 0};
          pg8::gemm_phase<pg8::EpiNormResNorm, pg8::StaticOrder, false, true>(lds, g, S, E); }
        SEAM(pb + 5);
    }
}

extern "C" void kernel_launch(void* const* d_in, const int* in_sizes, int n_in, void* d_out, int out_size, void* d_ws, size_t ws_size, hipStream_t stream) {
    static int ready = 0;
    if (ready == 0) {
        ready = 1;
        if (n_in != 12 || out_size != M * D || ws_size < WS_END) { fprintf(stderr, "kernel_launch: unexpected problem (n_in %d, out %d, ws %zu)\n", n_in, out_size, ws_size); ready = -1; }
        else if (hipFuncSetAttribute((const void*)fwd_mega, hipFuncAttributeMaxDynamicSharedMemorySize, LDS_BYTES) != hipSuccess) { fprintf(stderr, "kernel_launch: hipFuncSetAttribute failed\n"); ready = -1; }
        else {
            int dev = 0, cus = 0, per_cu = 0; (void)hipGetDevice(&dev); (void)hipDeviceGetAttribute(&cus, hipDeviceAttributeMultiprocessorCount, dev);
            (void)hipOccupancyMaxActiveBlocksPerMultiprocessor(&per_cu, (const void*)fwd_mega, NTHR, LDS_BYTES);
            if (cus * per_cu < GRID) { fprintf(stderr, "kernel_launch: %d CUs x %d blocks may not hold the %d-workgroup cooperative grid (advisory; the cooperative launch itself decides)\n", cus, per_cu, GRID); }
            (void)hipGetLastError();
        }
    }
    if (ready < 0) return;
    (void)hipMemsetAsync((char*)d_ws + WS_CTL, 0, CTL_ZERO_BYTES, stream);
    Args a{};
    for (int i = 0; i < 12; ++i) a.in[i] = (const float*)d_in[i];
    a.out = (float*)d_out; a.ws = (unsigned char*)d_ws;
    unsigned char* ws = (unsigned char*)d_ws;
    auto mega = [&](int lo, int hi) {
        int plo = lo, phi = hi; void* kargs[] = {&a, &plo, &phi};
        const hipError_t e = hipLaunchCooperativeKernel((const void*)fwd_mega, dim3(GRID), dim3(NTHR), kargs, LDS_BYTES, stream);
        if (e != hipSuccess) fprintf(stderr, "kernel_launch: cooperative launch failed: %s\n", hipGetErrorString(e));
    };
#if NAIVE_MIXERS
    int lo = 0;
    for (int L = 0; L < DEPTH; ++L) {
        const int pb = 1 + 6 * L;
#if PER_PHASE_LAUNCH
        for (int k = lo; k < pb + 1; ++k) mega(k, k + 1);
#else
        mega(lo, pb + 1);
#endif
        if ((L & 1) == 0) {
#if MFMA_SCAN
            hipLaunchKernelGGL(k_scan_mfma, dim3(GRID), dim3(NTHR), 140000, stream, (const bf16*)(ws + WS_K), (const bf16*)(ws + WS_VT), (bf16*)(ws + WS_ST));
#else
            hipLaunchKernelGGL(k_scan_naive, dim3(GRID), dim3(NTHR), 0, stream, (const bf16*)(ws + WS_K), (const bf16*)(ws + WS_VT), (bf16*)(ws + WS_ST));
#endif
            hipLaunchKernelGGL(MFMA_ROUT ? k_rout_mfma : k_rout_naive, dim3(GRID), dim3(NTHR), 140000, stream, (const bf16*)(ws + WS_Q), (const bf16*)(ws + WS_K), (const bf16*)(ws + WS_VT), (bf16*)(ws + WS_G), (const bf16*)(ws + WS_ST));
        } else {
#if MFMA_ATTN
            hipLaunchKernelGGL(k_attn_mfma, dim3(GRID), dim3(NTHR), 73728, stream, (const bf16*)(ws + WS_Q), (const bf16*)(ws + WS_K), (const bf16*)(ws + WS_VT), (bf16*)(ws + WS_G), (const float*)(ws + WS_TAB), L >> 1, (const float*)d_in[7], (const float*)d_in[8]);
#else
            hipLaunchKernelGGL(k_attn_naive, dim3(GRID), dim3(NTHR), 32768, stream, (const bf16*)(ws + WS_Q), (const bf16*)(ws + WS_K), (const bf16*)(ws + WS_VT), (bf16*)(ws + WS_G), (const float*)(ws + WS_TAB), L >> 1, (const float*)d_in[7]);
#endif
        }
        lo = pb + 3;
#ifdef TRUNC_PHASE
        if (TRUNC_PHASE < pb + 6 + 1) { for (int k = lo; k <= TRUNC_PHASE; ++k) mega(k, k + 1); return; }
#endif
    }
#if PER_PHASE_LAUNCH
    for (int k = lo; k < 1 + 6 * DEPTH; ++k) mega(k, k + 1);
#else
    mega(lo, 1 + 6 * DEPTH);
#endif
#else
    mega(0, 1 + 6 * DEPTH);
#endif
}
```

```cpp
#include <hip/hip_runtime.h>
#include <hip/hip_cooperative_groups.h>
#include <cstdio>
#include <cstdint>
namespace cg = cooperative_groups;
namespace pg8 {
#define PG8_LAS __attribute__((address_space(3)))
typedef unsigned short bf16_t;
typedef short bf16x8 __attribute__((ext_vector_type(8)));
typedef float f32x4 __attribute__((ext_vector_type(4)));
typedef unsigned u32x4 __attribute__((ext_vector_type(4)));
constexpr int BM = 256, BK = 64, HALF = 128, HTB = HALF * BK * 2  , STAGE_BYTES = 8 * HTB, NXCD = 8, WGM = 8;

__host__ __device__ __forceinline__ int lds_byte(int r, int c) { const int st = (r >> 4) * 2 + (c >> 5), rr = r & 15, cc = c & 31, ob = rr * 64 + cc * 2; return st * 1024 + (ob ^ (((ob >> 9) & 1) << 5)); }
__host__ __device__ __forceinline__ void stage_rc(int b, int& R, int& C) { const int st = b / 1024, sb = b % 1024, swz = sb ^ (((sb >> 9) & 1) << 5); R = (st >> 1) * 16 + swz / 64; C = (st & 1) * 32 + (swz % 64) / 2; }
__host__ __device__ __forceinline__ int perm32(int rho) { const int n = rho >> 4, i = rho & 15; return 8 * (i >> 2) + 4 * n + (i & 3); }

struct Unit { int pm, pn; };
struct Gemm { const bf16_t* A; const bf16_t* Bt; int M, N, K; };

struct StaticOrder {
    int nM, nN, nwg, G, c;
    __host__ __device__ void init(int M, int N, int G_, int c_) { nM = M / BM; nN = N / BM; nwg = nM * nN; G = G_; c = c_; }
    __host__ __device__ bool next(int i, Unit& u) const {
        const long L = (long)i * G + c; if (L >= nwg) return false;
        int wgid = (int)L; { const int q = nwg / NXCD, r = nwg % NXCD, xcd = wgid % NXCD, off = wgid / NXCD; wgid = (xcd < r ? xcd * (q + 1) : r * (q + 1) + (xcd - r) * q) + off; }
        const int nig = WGM * nN, gid = wgid / nig, fm = gid * WGM, gsz = (nM - fm) < WGM ? (nM - fm) : WGM;
        u.pm = fm + ((wgid % nig) % gsz); u.pn = (wgid % nig) / gsz; return true;
    }
    __device__ __forceinline__ void a_ready(const Unit&) const {}
    __device__ __forceinline__ void done(const Unit&) const {}
};

__device__ __forceinline__ unsigned cvt_pk_bf16(float lo, float hi) { unsigned r; asm volatile("v_cvt_pk_bf16_f32 %0, %1, %2" : "=v"(r) : "v"(lo), "v"(hi)); return r; }
typedef unsigned u32x2 __attribute__((ext_vector_type(2)));
__device__ __forceinline__ float bf2f(unsigned short v) { return __uint_as_float(((unsigned)v) << 16); }
__device__ __forceinline__ unsigned short f2bf1(float f) { unsigned u = __float_as_uint(f); return (unsigned short)((u + 0x7fffu + ((u >> 16) & 1u)) >> 16); }
__device__ __forceinline__ u32x4 pack8(f32x4 a, f32x4 b) { u32x4 w; w.x = cvt_pk_bf16(a[0], a[1]); w.y = cvt_pk_bf16(a[2], a[3]); w.z = cvt_pk_bf16(b[0], b[1]); w.w = cvt_pk_bf16(b[2], b[3]); return w; }
__device__ __forceinline__ float silu_f(float x) { return x * __builtin_amdgcn_rcpf(1.0f + __builtin_amdgcn_exp2f(-1.4426950408889634f * x)); }
__device__ __forceinline__ f32x4 silu4(f32x4 v) { f32x4 o; o[0] = silu_f(v[0]); o[1] = silu_f(v[1]); o[2] = silu_f(v[2]); o[3] = silu_f(v[3]); return o; }
__device__ __forceinline__ void sincos_rad(float ang, float& s, float& c) {
    constexpr double INV2PI = 0.15915494309189533577; constexpr float C_HI = (float)INV2PI; constexpr float C_LO = (float)(INV2PI - (double)C_HI);
    const float hi = ang * C_HI; const float lo = __builtin_fmaf(ang, C_HI, -hi) + ang * C_LO;
    const float fr = (hi - __builtin_rintf(hi)) + lo;
    s = __builtin_amdgcn_sinf(fr); c = __builtin_amdgcn_cosf(fr);
}
constexpr int SEQ_ = 8192;
struct EpiRetIn {
    static constexpr bool PERM = true, AFTER_DRAIN = false;
    bf16_t *Q, *K, *VT, *G;
    __device__ __forceinline__ void operator()(const f32x4 (&acc)[2][2][4][2], const Unit& u, int wr, int wc, int fr, int fq) const {
        const int pn = u.pn, jb = wc * 32 + 8 * fq, rowb = u.pm * BM + wr * 64 + fr;
        if (pn < 8) {
            const int h = pn & 3; const bool isK = pn >= 4; bf16_t* dst = isK ? K : Q; const float sc = isK ? 0.0625f : 1.0f;
            float inv[8];
#pragma unroll
            for (int e = 0; e < 8; ++e) inv[e] = __builtin_amdgcn_exp2f(-(float)(jb + e) * (13.287712379549449f / 128.0f));
#pragma unroll
            for (int ai = 0; ai < 2; ++ai)
#pragma unroll
                for (int m = 0; m < 4; ++m) {
                    const int row = rowb + ai * HALF + m * 16, b = row >> 13, s = row & (SEQ_ - 1); const float pos = (float)s;
                    f32x4 o1[2], o2[2];
#pragma unroll
                    for (int n = 0; n < 2; ++n)
#pragma unroll
                        for (int i = 0; i < 4; ++i) { float sn, cs; sincos_rad(pos * inv[4 * n + i], sn, cs); const float x1 = acc[ai][0][m][n][i], x2 = acc[ai][1][m][n][i];
                            o1[n][i] = (x1 * cs - x2 * sn) * sc; o2[n][i] = (x1 * sn + x2 * cs) * sc; }
                    bf16_t* p = dst + ((size_t)((b * 4 + h) * SEQ_ + s)) * 256 + jb;
                    *(u32x4*)p = pack8(o1[0], o1[1]); *(u32x4*)(p + 128) = pack8(o2[0], o2[1]);
                }
        } else if (pn < 16) {
            const int h = (pn - 8) >> 1, eb = ((pn - 8) & 1) * 256 + jb;
#pragma unroll
            for (int ai = 0; ai < 2; ++ai)
#pragma unroll
                for (int m = 0; m < 4; ++m) {
                    const int row = rowb + ai * HALF + m * 16, b = row >> 13, s = row & (SEQ_ - 1);
#pragma unroll
                    for (int bj = 0; bj < 2; ++bj)
#pragma unroll
                        for (int n = 0; n < 2; ++n)
#pragma unroll
                            for (int i = 0; i < 4; ++i) { const int e = eb + 128 * bj + 4 * n + i; VT[((size_t)((b * 4 + h) * 512 + e)) * SEQ_ + s] = f2bf1(acc[ai][bj][m][n][i]); }
                }
        } else {
            const int cb = (pn - 16) * 256 + jb;
#pragma unroll
            for (int ai = 0; ai < 2; ++ai)
#pragma unroll
                for (int m = 0; m < 4; ++m) {
                    const int row = rowb + ai * HALF + m * 16;
#pragma unroll
                    for (int bj = 0; bj < 2; ++bj) *(u32x4*)(G + (size_t)row * 2048 + cb + 128 * bj) = pack8(silu4(acc[ai][bj][m][0]), silu4(acc[ai][bj][m][1]));
                }
        }
    }
};
struct EpiDiffIn {
    static constexpr bool PERM = true, AFTER_DRAIN = false;
    bf16_t *Q, *K, *VT; float qscale;
    __device__ __forceinline__ void operator()(const f32x4 (&acc)[2][2][4][2], const Unit& u, int wr, int wc, int fr, int fq) const {
        const int pn = u.pn, jb = wc * 32 + 8 * fq, rowb = u.pm * BM + wr * 64 + fr;
        if (pn < 8) {
            bf16_t* dst = pn < 4 ? Q : K; const float sc = pn < 4 ? qscale : 1.0f; const int cb = (pn & 3) * 256 + jb;
#pragma unroll
            for (int ai = 0; ai < 2; ++ai)
#pragma unroll
                for (int m = 0; m < 4; ++m) {
                    const int row = rowb + ai * HALF + m * 16;
#pragma unroll
                    for (int bj = 0; bj < 2; ++bj) *(u32x4*)(dst + (size_t)row * 1024 + cb + 128 * bj) = pack8(acc[ai][bj][m][0] * sc, acc[ai][bj][m][1] * sc);
                }
        } else {
#pragma unroll
            for (int ai = 0; ai < 2; ++ai)
#pragma unroll
                for (int m = 0; m < 4; ++m) {
                    const int row = rowb + ai * HALF + m * 16, b = row >> 13, s = row & (SEQ_ - 1);
#pragma unroll
                    for (int bj = 0; bj < 2; ++bj) { const int h = (pn - 8) * 2 + bj;
#pragma unroll
                        for (int n = 0; n < 2; ++n)
#pragma unroll
                            for (int i = 0; i < 4; ++i) { const int e = jb + 4 * n + i; VT[((size_t)((b * 8 + h) * 128 + e)) * SEQ_ + s] = f2bf1(acc[ai][bj][m][n][i]); } }
                }
        }
    }
};
struct EpiSwiGLU {
    static constexpr bool PERM = true, AFTER_DRAIN = false;
    bf16_t* ACT;
    __device__ __forceinline__ void operator()(const f32x4 (&acc)[2][2][4][2], const Unit& u, int wr, int wc, int fr, int fq) const {
        const int cb = u.pn * 128 + wc * 32 + 8 * fq, rowb = u.pm * BM + wr * 64 + fr;
#pragma unroll
        for (int ai = 0; ai < 2; ++ai)
#pragma unroll
            for (int m = 0; m < 4; ++m) {
                const int row = rowb + ai * HALF + m * 16;
                *(u32x4*)(ACT + (size_t)row * 2816 + cb) = pack8(silu4(acc[ai][0][m][0]) * acc[ai][1][m][0], silu4(acc[ai][0][m][1]) * acc[ai][1][m][1]);
            }
    }
};
struct EpiNormResNorm {
    static constexpr bool PERM = false, AFTER_DRAIN = true;
    const float* base; float* out; bf16_t* xn; const float* g1; const float* g2;
    float* xbuf;
    unsigned* cnt;
    float eps; int dry;
    __device__ __forceinline__ void fused(f32x4 (&acc)[2][2][4][2], const Unit& u, int wr, int wc, int fr, int fq, PG8_LAS unsigned char* lds, int wid, int lane) const {
        typedef float f32x2v __attribute__((ext_vector_type(2)));
        PG8_LAS f32x4* P = (PG8_LAS f32x4*)lds;
        PG8_LAS f32x2v* S = (PG8_LAS f32x2v*)(lds + 16384);
        const int col0 = u.pn * BM + wc * 32 + 4 * fq;
        f32x4 gv[2][2];
#pragma unroll
        for (int bj = 0; bj < 2; ++bj)
#pragma unroll
            for (int n = 0; n < 2; ++n) gv[bj][n] = *(const f32x4*)(g1 + col0 + bj * HALF + n * 16);
#pragma unroll
        for (int ai = 0; ai < 2; ++ai)
#pragma unroll
            for (int m = 0; m < 4; ++m) { const int r = ai * HALF + wr * 64 + m * 16 + fr; const size_t off = (size_t)(u.pm * BM + r) * 1024 + col0;
                float s0 = 0.f, s1 = 0.f, s2 = 0.f, s3 = 0.f;
#pragma unroll
                for (int bj = 0; bj < 2; ++bj)
#pragma unroll
                    for (int n = 0; n < 2; ++n) { const f32x4 bs = *(const f32x4*)(base + off + bj * HALF + n * 16), a = acc[ai][bj][m][n], ag = a * gv[bj][n];
                        s0 += (a[0] * a[0] + a[1] * a[1]) + (a[2] * a[2] + a[3] * a[3]); s1 += (bs[0] * bs[0] + bs[1] * bs[1]) + (bs[2] * bs[2] + bs[3] * bs[3]);
                        s2 += (bs[0] * ag[0] + bs[1] * ag[1]) + (bs[2] * ag[2] + bs[3] * ag[3]); s3 += (ag[0] * ag[0] + ag[1] * ag[1]) + (ag[2] * ag[2] + ag[3] * ag[3]); }
                s0 += __shfl_xor(s0, 16); s0 += __shfl_xor(s0, 32); s1 += __shfl_xor(s1, 16); s1 += __shfl_xor(s1, 32);
                s2 += __shfl_xor(s2, 16); s2 += __shfl_xor(s2, 32); s3 += __shfl_xor(s3, 16); s3 += __shfl_xor(s3, 32);
                if (fq == 0) P[r * 4 + wc] = (f32x4){s0, s1, s2, s3};
                if (m & 1) asm volatile("" ::: "memory"); }
        asm volatile("s_waitcnt lgkmcnt(0)" ::: "memory"); __builtin_amdgcn_s_barrier(); asm volatile("" ::: "memory");
        const int row = wid * 32 + (lane & 31);
        if (lane < 32) {
            const f32x4 t = (P[row * 4 + 0] + P[row * 4 + 1]) + (P[row * 4 + 2] + P[row * 4 + 3]);
            float* slot = xbuf + ((size_t)(u.pm * BM + row) * 4 + u.pn);
#pragma unroll
            for (int c = 0; c < 4; ++c) __hip_atomic_store(slot + (size_t)c * 16384 * 4, t[c], __ATOMIC_RELAXED, __HIP_MEMORY_SCOPE_AGENT);
        }
        asm volatile("s_waitcnt vmcnt(0)" ::: "memory");
        if (lane == 0) __hip_atomic_fetch_add(cnt + 64 * u.pm, 1u, __ATOMIC_RELAXED, __HIP_MEMORY_SCOPE_AGENT);
        if (wid == 0) {
            unsigned spins = 0;
            for (;;) {
                if ((unsigned)__builtin_amdgcn_readfirstlane(__hip_atomic_load(cnt + 64 * u.pm, __ATOMIC_RELAXED, __HIP_MEMORY_SCOPE_AGENT)) >= 32u) break;
                if (++spins > (1u << 24)) break;
                __builtin_amdgcn_s_sleep(1);
            }
            __builtin_amdgcn_fence(__ATOMIC_ACQUIRE, "agent");
        }
        asm volatile("s_waitcnt vmcnt(0) lgkmcnt(0)" ::: "memory"); __builtin_amdgcn_s_barrier(); asm volatile("" ::: "memory");
        if (lane < 32) {
            const float* slot = xbuf + (size_t)(u.pm * BM + row) * 4; float q[4];
#pragma unroll
            for (int c = 0; c < 4; ++c) { float v = 0.f;
#pragma unroll
                for (int t = 0; t < 4; ++t) v += __hip_atomic_load(slot + (size_t)c * 16384 * 4 + t, __ATOMIC_RELAXED, __HIP_MEMORY_SCOPE_AGENT);
                q[c] = v; }
            const float r1 = 1.0f / sqrtf(q[0] * (1.0f / 1024.0f) + eps);
            const float ss2 = q[1] + 2.0f * r1 * q[2] + r1 * r1 * q[3];
            S[row] = (f32x2v){r1, 1.0f / sqrtf(fmaxf(ss2, 0.f) * (1.0f / 1024.0f) + eps)};
        }
        asm volatile("s_waitcnt lgkmcnt(0)" ::: "memory"); __builtin_amdgcn_s_barrier(); asm volatile("" ::: "memory");
        f32x4 g2v[2][2];
#pragma unroll
        for (int bj = 0; bj < 2; ++bj)
#pragma unroll
            for (int n = 0; n < 2; ++n) g2v[bj][n] = *(const f32x4*)(g2 + col0 + bj * HALF + n * 16);
#pragma unroll
        for (int ai = 0; ai < 2; ++ai)
#pragma unroll
            for (int m = 0; m < 4; ++m) { const int r = ai * HALF + wr * 64 + m * 16 + fr; const f32x2v sr = S[r]; const size_t off = (size_t)(u.pm * BM + r) * 1024 + col0;
#pragma unroll
                for (int bj = 0; bj < 2; ++bj)
#pragma unroll
                    for (int n = 0; n < 2; ++n) { const f32x4 bs = *(const f32x4*)(base + off + bj * HALF + n * 16); const f32x4 x1 = bs + acc[ai][bj][m][n] * sr.x * gv[bj][n];
                        const f32x4 o = x1 * sr.y * g2v[bj][n]; u32x2 w; w.x = cvt_pk_bf16(o[0], o[1]); w.y = cvt_pk_bf16(o[2], o[3]);
                        if (!dry || x1[0] == 1.2345e38f) { *(f32x4*)(out + off + bj * HALF + n * 16) = x1; *(u32x2*)(xn + off + bj * HALF + n * 16) = w; } }
                if (m & 1) asm volatile("" ::: "memory"); }
    }
};

struct EpiNull {
    static constexpr bool PERM = false, AFTER_DRAIN = true;
    float* sink;
    __device__ __forceinline__ void fused(f32x4 (&acc)[2][2][4][2], const Unit& u, int wr, int wc, int fr, int fq, PG8_LAS unsigned char* lds, int wid, int lane) const {
        float t = 0.f;
#pragma unroll
        for (int ai = 0; ai < 2; ++ai)
#pragma unroll
            for (int bj = 0; bj < 2; ++bj)
#pragma unroll
                for (int m = 0; m < 4; ++m)
#pragma unroll
                    for (int n = 0; n < 2; ++n) t += (acc[ai][bj][m][n][0] + acc[ai][bj][m][n][1]) + (acc[ai][bj][m][n][2] + acc[ai][bj][m][n][3]);
        if (t == 1.2345e38f) sink[0] = t;
    }
};
template <class Epi, class Sched, bool ALIGN_EPI = false, bool SP2 = false>
__device__ __forceinline__ void gemm_phase(PG8_LAS unsigned char* lds, const Gemm g, const Sched& S, const Epi& E) {
    int tid_ = threadIdx.x; asm volatile("" : "+v"(tid_)); const int tid = tid_, wid = __builtin_amdgcn_readfirstlane(tid >> 6), lane = tid & 63, wr = wid >> 2, wc = wid & 3, fr = lane & 15, fq = lane >> 4;
    const int K = g.K, nt = K / BK;
    unsigned voffA[2], voffB[2];
#pragma unroll
    for (int i = 0; i < 2; ++i) { int R, C; stage_rc(tid * 16 + i * 8192, R, C); const int Rb = Epi::PERM ? ((R & ~31) + perm32(R & 31)) : R;
        voffA[i] = (unsigned)(R * K + C) * 2u; voffB[i] = (unsigned)(Rb * K + C) * 2u; }
    const size_t kstep = (size_t)(BK * 2);
    const size_t hstep = (size_t)HALF * K * 2;
    const size_t tstep = 2 * hstep;
    const unsigned ldsw = (unsigned)wid * 1024u;
    const int aoff = lds_byte(wr * 64 + fr, fq * 8), boff = lds_byte(wc * 32 + fr, fq * 8);
#define PG8_SA(b, h) (((b) * 2 + (h)) * HTB)
#define PG8_SB(b, h) ((4 + (b) * 2 + (h)) * HTB)
#define PG8_STAGE(bufoff, gbase, voff) do { _Pragma("unroll") for (int _i = 0; _i < 2; ++_i) \
        __builtin_amdgcn_global_load_lds((const unsigned*)((const char*)(gbase) + (voff)[_i]), (PG8_LAS unsigned*)(lds + (bufoff) + ldsw + _i * 8192), 16, 0, 0); } while (0)
#define PG8_LDA(dst, b, h) do { _Pragma("unroll") for (int m = 0; m < 4; ++m) _Pragma("unroll") for (int k = 0; k < 2; ++k) dst[m][k] = *(const PG8_LAS bf16x8*)(lds + PG8_SA(b, h) + aoff + m * 2048 + k * 1024); } while (0)
#define PG8_LDB(dst, b, h) do { _Pragma("unroll") for (int n = 0; n < 2; ++n) _Pragma("unroll") for (int k = 0; k < 2; ++k) dst[n][k] = *(const PG8_LAS bf16x8*)(lds + PG8_SB(b, h) + boff + n * 2048 + k * 1024); } while (0)
#define PG8_MMA(ai, bj, At, Bt) do { __builtin_amdgcn_s_setprio(1); _Pragma("unroll") for (int m = 0; m < 4; ++m) _Pragma("unroll") for (int n = 0; n < 2; ++n) _Pragma("unroll") for (int k = 0; k < 2; ++k) \
        acc[ai][bj][m][n] = __builtin_amdgcn_mfma_f32_16x16x32_bf16(Bt[n][k], At[m][k], acc[ai][bj][m][n], 0, 0, 0); __builtin_amdgcn_s_setprio(0); } while (0)
#define PG8_WAIT_V(n) asm volatile("s_waitcnt vmcnt(" #n ")" ::: "memory")
#define PG8_WAIT_L(n) asm volatile("s_waitcnt lgkmcnt(" #n ")" ::: "memory")
#define PG8_BAR __builtin_amdgcn_s_barrier()
#define PG8_SCHED __builtin_amdgcn_sched_barrier(0)
    Unit cur, nxt; int ui = 0;
    if (!S.next(0, cur)) return;
    f32x4 acc[2][2][4][2];
#pragma unroll
    for (int a = 0; a < 2; ++a)
#pragma unroll
        for (int b = 0; b < 2; ++b)
#pragma unroll
            for (int m = 0; m < 4; ++m)
#pragma unroll
                for (int n = 0; n < 2; ++n) acc[a][b][m][n] = (f32x4){0.f, 0.f, 0.f, 0.f};
    bf16x8 At[4][2], B0[2][2], B1[2][2];
    const char* cA = (const char*)g.A + (size_t)cur.pm * tstep; const char* cB = (const char*)g.Bt + (size_t)cur.pn * tstep;
    S.a_ready(cur);
    if constexpr (SP2) {
        PG8_STAGE(PG8_SB(0, 0), cB, voffB); PG8_STAGE(PG8_SB(0, 1), cB + hstep, voffB); PG8_STAGE(PG8_SA(0, 0), cA, voffA); PG8_STAGE(PG8_SA(0, 1), cA + hstep, voffA);
        if (wr == 1) PG8_BAR;
        PG8_WAIT_V(2); PG8_BAR;
        PG8_STAGE(PG8_SB(1, 0), cB + kstep, voffB); PG8_STAGE(PG8_SA(1, 0), cA + kstep, voffA); PG8_STAGE(PG8_SB(1, 1), cB + hstep + kstep, voffB);
        PG8_WAIT_V(6); PG8_BAR;
    } else {
        PG8_STAGE(PG8_SB(0, 0), cB, voffB); PG8_STAGE(PG8_SA(0, 0), cA, voffA); PG8_STAGE(PG8_SB(0, 1), cB + hstep, voffB); PG8_STAGE(PG8_SA(0, 1), cA + hstep, voffA);
        if (wr == 1) PG8_BAR;
        PG8_WAIT_V(4); PG8_BAR;
        PG8_STAGE(PG8_SB(1, 0), cB + kstep, voffB); PG8_STAGE(PG8_SA(1, 0), cA + kstep, voffA); PG8_STAGE(PG8_SB(1, 1), cB + hstep + kstep, voffB);
        PG8_WAIT_V(6); PG8_BAR;
    }
    for (;;) {
        const bool has_next = S.next(ui + 1, nxt);
        const char* nA = has_next ? (const char*)g.A + (size_t)nxt.pm * tstep : cA; const char* nB = has_next ? (const char*)g.Bt + (size_t)nxt.pn * tstep : cB;
        for (int t = 0; t < nt; t += 2) {
            const bool last = (t == nt - 2);
            const char* a1 = cA + (size_t)(t + 1) * kstep;
            const char* a2 = last ? nA : cA + (size_t)(t + 2) * kstep; const char* b2 = last ? nB : cB + (size_t)(t + 2) * kstep;
            const char* a3 = a2 + kstep; const char* b3 = b2 + kstep;
            if (last && has_next) S.a_ready(nxt);
            if constexpr (SP2) {
            PG8_LDB(B0, 0, 0); PG8_LDB(B1, 0, 1); PG8_SCHED; PG8_LDA(At, 0, 0); PG8_STAGE(PG8_SA(1, 1), a1 + hstep, voffA);
            PG8_WAIT_V(8); PG8_WAIT_L(0); PG8_BAR; PG8_MMA(0, 0, At, B0); PG8_MMA(0, 1, At, B1); PG8_BAR; PG8_SCHED;
            PG8_LDA(At, 0, 1); PG8_STAGE(PG8_SB(0, 0), b2, voffB); PG8_STAGE(PG8_SB(0, 1), b2 + hstep, voffB); PG8_STAGE(PG8_SA(0, 0), a2, voffA);
            PG8_WAIT_V(8); PG8_WAIT_L(0); PG8_BAR; PG8_MMA(1, 0, At, B0); PG8_MMA(1, 1, At, B1); PG8_BAR; PG8_SCHED;
            PG8_LDB(B0, 1, 0); PG8_LDB(B1, 1, 1); PG8_SCHED; PG8_LDA(At, 1, 0); PG8_STAGE(PG8_SA(0, 1), a2 + hstep, voffA);
            PG8_WAIT_V(8); PG8_WAIT_L(0); PG8_BAR; PG8_MMA(0, 0, At, B0); PG8_MMA(0, 1, At, B1); PG8_BAR; PG8_SCHED;
            PG8_LDA(At, 1, 1); PG8_STAGE(PG8_SB(1, 0), b3, voffB); PG8_STAGE(PG8_SB(1, 1), b3 + hstep, voffB); PG8_STAGE(PG8_SA(1, 0), a3, voffA);
            PG8_WAIT_V(8); PG8_WAIT_L(0); PG8_BAR; PG8_MMA(1, 0, At, B0); PG8_MMA(1, 1, At, B1); PG8_BAR; PG8_SCHED;
            } else {
            PG8_LDB(B0, 0, 0); PG8_SCHED; PG8_LDA(At, 0, 0); PG8_STAGE(PG8_SA(1, 1), a1 + hstep, voffA);
            PG8_WAIT_L(8); PG8_BAR; PG8_WAIT_L(0); PG8_MMA(0, 0, At, B0); PG8_BAR; PG8_SCHED;
            PG8_LDB(B1, 0, 1); PG8_STAGE(PG8_SB(0, 0), b2, voffB);
            PG8_BAR; PG8_WAIT_L(0); PG8_MMA(0, 1, At, B1); PG8_BAR;
            PG8_LDA(At, 0, 1); PG8_STAGE(PG8_SA(0, 0), a2, voffA);
            PG8_BAR; PG8_WAIT_L(0); PG8_MMA(1, 0, At, B0); PG8_BAR; PG8_SCHED;
            PG8_STAGE(PG8_SB(0, 1), b2 + hstep, voffB);
            PG8_WAIT_V(6); PG8_BAR; PG8_MMA(1, 1, At, B1); PG8_BAR;
            PG8_LDB(B0, 1, 0); PG8_SCHED; PG8_LDA(At, 1, 0); PG8_STAGE(PG8_SA(0, 1), a2 + hstep, voffA);
            PG8_WAIT_L(8); PG8_BAR; PG8_WAIT_L(0); PG8_MMA(0, 0, At, B0); PG8_BAR; PG8_SCHED;
            PG8_LDB(B1, 1, 1); PG8_STAGE(PG8_SB(1, 0), b3, voffB);
            PG8_BAR; PG8_WAIT_L(0); PG8_MMA(0, 1, At, B1); PG8_BAR;
            PG8_LDA(At, 1, 1); PG8_STAGE(PG8_SA(1, 0), a3, voffA);
            PG8_BAR; PG8_WAIT_L(0); PG8_MMA(1, 0, At, B0); PG8_BAR; PG8_SCHED;
            PG8_STAGE(PG8_SB(1, 1), b3 + hstep, voffB);
            PG8_WAIT_V(6); PG8_BAR; PG8_MMA(1, 1, At, B1); PG8_BAR;
            }
        }
        if constexpr (ALIGN_EPI) { if (wr == 0) PG8_BAR; }
        if constexpr (!Epi::AFTER_DRAIN) { E(acc, cur, wr, wc, fr, fq); S.done(cur); }
        if (!has_next) break;
#pragma unroll
        for (int a = 0; a < 2; ++a)
#pragma unroll
            for (int b = 0; b < 2; ++b)
#pragma unroll
                for (int m = 0; m < 4; ++m)
#pragma unroll
                    for (int n = 0; n < 2; ++n) acc[a][b][m][n] = (f32x4){0.f, 0.f, 0.f, 0.f};
        cur = nxt; cA = nA; cB = nB; ++ui;
        if constexpr (ALIGN_EPI) { if (wr == 1) PG8_BAR; }
    }
    PG8_WAIT_V(0);
    if constexpr (!ALIGN_EPI) { if (wr == 0) PG8_BAR; }
    PG8_BAR;
    if constexpr (Epi::AFTER_DRAIN) { E.fused(acc, cur, wr, wc, fr, fq, lds, wid, lane); S.done(cur); }
#undef PG8_SA
#undef PG8_SB
#undef PG8_STAGE
#undef PG8_LDA
#undef PG8_LDB
#undef PG8_MMA
#undef PG8_WAIT_V
#undef PG8_WAIT_L
#undef PG8_BAR
#undef PG8_SCHED
}
}
#ifndef PROBE_DUP
#define PROBE_DUP 0
#endif

#define LAS __attribute__((address_space(3)))
typedef unsigned short bf16;
typedef unsigned v4u __attribute__((ext_vector_type(4)));
typedef float f32x4 __attribute__((ext_vector_type(4)));
using pg8::bf2f; using pg8::f2bf1;
constexpr int NWAVES = 8, NTHR = 512, GRID = 256;
constexpr int SEQ = 8192, D = 1024, M = 2 * SEQ, FF = 2816, DEPTH = 4;
constexpr int RET_IN = 6144, DIFF_IN = 3072;
constexpr float RMS_EPS = 1e-6f;
constexpr float LOG2E = 1.4426950408889634f;
constexpr size_t MiB = 1u << 20;
constexpr size_t WS_CTL = 0, CTL_ZERO_BYTES = 1 * MiB;
constexpr size_t WS_TAB = 640 * 1024;
constexpr size_t WS_X = 1 * MiB;
constexpr size_t WS_WIN = 2 * MiB, WS_WOUT = 14 * MiB, WS_WGU = 18 * MiB, WS_WDN = 29 * MiB;
constexpr size_t WS_Q = 35 * MiB, WS_K = 67 * MiB, WS_VT = 99 * MiB, WS_G = 163 * MiB, WS_ST = 227 * MiB, WS_END = 291 * MiB;
constexpr size_t WS_XN = WS_ST, WS_ACT = WS_K;
constexpr int CW_BAR = 131072;
constexpr int CW_CNT = 1024;
constexpr int LDS_BYTES = 147456;
#ifndef MFMA_SCAN
#define MFMA_SCAN 1
#endif
#ifndef MFMA_ROUT
#define MFMA_ROUT 1
#endif
#ifndef MFMA_ATTN
#define MFMA_ATTN 1
#endif
#ifndef PER_PHASE_LAUNCH
#define PER_PHASE_LAUNCH 1
#endif
#ifndef NAIVE_MIXERS
#define NAIVE_MIXERS 0
#endif

struct Args { const float* in[12]; float* out; unsigned char* ws; };

__device__ __forceinline__ unsigned pk2(float lo, float hi) { return (unsigned)f2bf1(lo) | ((unsigned)f2bf1(hi) << 16); }
__device__ __forceinline__ float wave_sum(float v) {
#pragma unroll
    for (int o = 1; o < 64; o <<= 1) v += __shfl_xor(v, o);
    return v;
}
__device__ __forceinline__ float dot8(v4u a, v4u b) {
    float s = 0.f;
#pragma unroll
    for (int i = 0; i < 4; ++i) { s += __uint_as_float(a[i] << 16) * __uint_as_float(b[i] << 16); s += __uint_as_float(a[i] & 0xffff0000u) * __uint_as_float(b[i] & 0xffff0000u); }
    return s;
}
struct TrItem { const float* W; int Nsrc, K, k0, c0, r0; };
__device__ __forceinline__ void tr_load(float (&v)[32], const TrItem& t, int lane) {
#pragma unroll
    for (int i = 0; i < 32; ++i) { const int kk = 2 * i + (lane >> 5); v[i] = t.W[(size_t)(t.k0 + kk) * t.Nsrc + t.c0 + (lane & 31)]; }
}
__device__ __forceinline__ void tr_finish(const float (&v)[32], const TrItem& t, bf16* WT, LAS float* scr, int lane) {
#pragma unroll
    for (int i = 0; i < 32; ++i) { const int kk = 2 * i + (lane >> 5); scr[kk * 33 + (lane & 31)] = v[i]; }
    asm volatile("s_waitcnt lgkmcnt(0)" ::: "memory");
    const int c = lane & 7;
#pragma unroll
    for (int j = 0; j < 4; ++j) { const int n = (lane >> 3) + 8 * j; const LAS float* s = scr + (8 * c) * 33 + n;
        v4u o; o.x = pk2(s[0 * 33], s[1 * 33]); o.y = pk2(s[2 * 33], s[3 * 33]); o.z = pk2(s[4 * 33], s[5 * 33]); o.w = pk2(s[6 * 33], s[7 * 33]);
        *(v4u*)(WT + (size_t)(t.r0 + n) * t.K + t.k0 + 8 * c) = o; }
    asm volatile("s_waitcnt lgkmcnt(0)" ::: "memory");
}
__device__ __forceinline__ TrItem item_plain(const float* W, int K, int N, int it) { const int nblk = N / 32, kb = it / nblk, nb = it % nblk; return TrItem{W, N, K, 64 * kb, 32 * nb, 32 * nb}; }
__device__ __forceinline__ TrItem item_gu(const float* Wg, const float* Wu, int it) { const int nblk = FF / 32, nit = (D / 64) * nblk, which = it >= nit, r = which ? it - nit : it, kb = r / nblk, nb = r % nblk, c0 = 32 * nb;
    return TrItem{which ? Wu : Wg, FF, D, 64 * kb, c0, 256 * (c0 >> 7) + 128 * which + (c0 & 127)}; }
#define CONV_LOOP(NIT, ITEM, WT) do { const int nit_ = (NIT); float va_[32], vb_[32]; int it_ = gw; \
        if (it_ < nit_) { const TrItem ta_ = ITEM(it_); tr_load(va_, ta_, lane); } \
        while (it_ < nit_) { \
            { const TrItem ta_ = ITEM(it_); const int nx_ = it_ + ngw; if (nx_ < nit_) { const TrItem tb_ = ITEM(nx_); tr_load(vb_, tb_, lane); } tr_finish(va_, ta_, (WT), scr, lane); it_ = nx_; } \
            if (it_ >= nit_) break; \
            { const TrItem tb_ = ITEM(it_); const int nx_ = it_ + ngw; if (nx_ < nit_) { const TrItem ta_ = ITEM(nx_); tr_load(va_, ta_, lane); } tr_finish(vb_, tb_, (WT), scr, lane); it_ = nx_; } \
        } } while (0)
__device__ __forceinline__ void conv_plain(const float* W, int K, int N, bf16* WT, LAS float* scr, int gw, int ngw, int lane) {
#define ITEM_(i) item_plain(W, K, N, (i))
    for (int rep_ = 0; rep_ < ((PROBE_DUP & 256) ? 2 : 1); ++rep_) CONV_LOOP((K / 64) * (N / 32), ITEM_, WT);
#undef ITEM_
}
__device__ __forceinline__ void conv_gu(const float* Wg, const float* Wu, bf16* WT, LAS float* scr, int gw, int ngw, int lane) {
#define ITEM_(i) item_gu(Wg, Wu, (i))
    for (int rep_ = 0; rep_ < ((PROBE_DUP & 256) ? 2 : 1); ++rep_) CONV_LOOP(2 * (D / 64) * (FF / 32), ITEM_, WT);
#undef ITEM_
}
__device__ __forceinline__ void rms_row_to_bf16(const float* xrow, const float* g, bf16* orow, int lane) {
    const f32x4* xr = (const f32x4*)xrow + lane; const f32x4* gr = (const f32x4*)g + lane;
    f32x4 v[4]; float s2 = 0.f;
#pragma unroll
    for (int j = 0; j < 4; ++j) { v[j] = xr[64 * j]; s2 += (v[j].x * v[j].x + v[j].y * v[j].y) + (v[j].z * v[j].z + v[j].w * v[j].w); }
    const float rstd = 1.f / sqrtf(wave_sum(s2) * (1.f / D) + RMS_EPS);
    unsigned long long* o8 = (unsigned long long*)orow + lane;
#pragma unroll
    for (int j = 0; j < 4; ++j) { const f32x4 gg = gr[64 * j]; o8[64 * j] = (unsigned long long)pk2(v[j].x * rstd * gg.x, v[j].y * rstd * gg.y) | ((unsigned long long)pk2(v[j].z * rstd * gg.z, v[j].w * rstd * gg.w) << 32); }
}

__device__ __forceinline__ float head_log2_gamma(int h) { return __builtin_log2f(1.0f - __builtin_exp2f(-5.0f - (float)h)); }
__device__ __forceinline__ void ret_scan_naive(const bf16* K, const bf16* VT, bf16* ST) {
    const int gid = blockIdx.x * NTHR + threadIdx.x;
    const int bh = gid >> 14, rem = gid & 16383, e = rem >> 5, d0 = (rem & 31) * 8;
    const float lg2 = head_log2_gamma(bh & 3), cd = __builtin_exp2f(256.f * lg2);
    float st[8];
#pragma unroll
    for (int j = 0; j < 8; ++j) st[j] = 0.f;
    const bf16* vt = VT + ((size_t)(bh * 512 + e)) * SEQ; const bf16* kp = K + (size_t)bh * SEQ * 256 + d0;
    for (int c2 = 0; c2 < 32; ++c2) {
        v4u o; o.x = pk2(st[0], st[1]); o.y = pk2(st[2], st[3]); o.z = pk2(st[4], st[5]); o.w = pk2(st[6], st[7]);
        *(v4u*)(ST + (((size_t)(bh * 32 + c2)) * 512 + e) * 256 + d0) = o;
#pragma unroll
        for (int j = 0; j < 8; ++j) st[j] *= cd;
        for (int m = 0; m < 256; ++m) { const int t = c2 * 256 + m; const float v = bf2f(vt[t]) * __builtin_exp2f((float)(255 - m) * lg2);
            const v4u kk = *(const v4u*)(kp + (size_t)t * 256);
#pragma unroll
            for (int i = 0; i < 4; ++i) { st[2 * i] += v * __uint_as_float(kk[i] << 16); st[2 * i + 1] += v * __uint_as_float(kk[i] & 0xffff0000u); } }
    }
}
__device__ __forceinline__ void ret_out_naive(LAS unsigned char* lds, const bf16* Q, const bf16* K, const bf16* VT, bf16* GY, const bf16* ST) {
    LAS bf16* Qs = (LAS bf16*)lds; LAS bf16* In = (LAS bf16*)(lds + 128 * 264 * 2); LAS float* ss = (LAS float*)(lds + 2 * 128 * 264 * 2);
    const int tid = threadIdx.x;
    for (int task = blockIdx.x; task < 512; task += gridDim.x) {
        const int bh = task >> 6, c = task & 63, h = bh & 3, odd = c & 1, nk = odd ? 256 : 128, sh = odd ? 8 : 7, tk0 = (c & ~1) * 128, tq0 = c * 128;
        const float lg2 = head_log2_gamma(h);
        __syncthreads();
#pragma unroll
        for (int i = 0; i < 8; ++i) { const int ch = tid + NTHR * i, r = ch >> 5, cc = ch & 31; *(LAS v4u*)(Qs + r * 264 + cc * 8) = *(const v4u*)(Q + ((size_t)(bh * SEQ + tq0 + r)) * 256 + cc * 8); }
        __syncthreads();
        for (int idx = tid; idx < 128 * nk; idx += NTHR) { const int n = idx >> sh, m = idx & (nk - 1), dist = (tq0 + n) - (tk0 + m); float val = 0.f;
            if (dist >= 0) { const bf16* kp = K + ((size_t)(bh * SEQ + tk0 + m)) * 256; float dot = 0.f;
                for (int d8 = 0; d8 < 32; ++d8) dot += dot8(*(const v4u*)(kp + d8 * 8), *(const LAS v4u*)(Qs + n * 264 + d8 * 8));
                val = dot * __builtin_exp2f((float)dist * lg2); }
            In[n * 264 + m] = f2bf1(val); }
        __syncthreads();
        const int n = tid & 127, eq = tid >> 7; const float qdec = __builtin_exp2f((float)(n + 1 + odd * 128) * lg2); float ssq = 0.f;
        const size_t grow = ((size_t)((bh >> 2) * SEQ + tq0 + n)) * 2048 + h * 512;
        for (int ee = 0; ee < 128; ++ee) { const int e = eq * 128 + ee;
            const bf16* vt = VT + ((size_t)(bh * 512 + e)) * SEQ + tk0; float a = 0.f;
            for (int m8 = 0; m8 < nk / 8; ++m8) a += dot8(*(const v4u*)(vt + m8 * 8), *(const LAS v4u*)(In + n * 264 + m8 * 8));
            const bf16* sp = ST + (((size_t)(bh * 32 + (c >> 1))) * 512 + e) * 256; float cr = 0.f;
            for (int d8 = 0; d8 < 32; ++d8) cr += dot8(*(const v4u*)(sp + d8 * 8), *(const LAS v4u*)(Qs + n * 264 + d8 * 8));
            a += qdec * cr; ssq += a * a;
            GY[grow + e] = f2bf1(a * bf2f(GY[grow + e])); }
        ss[eq * 128 + n] = ssq;
        __syncthreads();
        const float rstd = 1.0f / sqrtf(((ss[n] + ss[128 + n]) + (ss[256 + n] + ss[384 + n])) * (1.0f / 512.0f) + RMS_EPS);
        for (int ee = 0; ee < 128; ++ee) { const int e = eq * 128 + ee; GY[grow + e] = f2bf1(bf2f(GY[grow + e]) * rstd); }
    }
}
__device__ __forceinline__ void attn_naive(LAS unsigned char* lds, const bf16* Qd, const bf16* Kd, const bf16* VTd, bf16* Od, const float* lut, float lam, const float* subln, float outscale) {
    LAS float* ss = (LAS float*)lds; LAS bf16* Qs = (LAS bf16*)(lds + 2048);
    const int tid = threadIdx.x, lane = tid & 63, eg = tid >> 6;
    const int w = blockIdx.x, bh = w & 15, g = w >> 4, b = bh >> 3, h = bh & 7;
    for (int ui = 0; ui < 8; ++ui) {
        const int pr = ui >> 1, qb = (ui & 1) ? (32 * pr + 31 - g) : (32 * pr + g);
        const int q = qb * 64 + lane; const size_t qrow = (size_t)(b * SEQ + q);
        __syncthreads();
        if (eg == 0) {
#pragma unroll
            for (int i = 0; i < 16; ++i) *(LAS v4u*)(Qs + lane * 136 + i * 8) = *(const v4u*)(Qd + qrow * 1024 + h * 128 + i * 8);
        }
        __syncthreads();
        const LAS bf16* qv = Qs + lane * 136;
        float o1[16], o2[16], m1 = -1e30f, m2 = -1e30f, l1 = 0.f, l2 = 0.f;
#pragma unroll
        for (int j = 0; j < 16; ++j) { o1[j] = 0.f; o2[j] = 0.f; }
        const int kend = qb * 64 + 64;
        for (int k0 = 0; k0 < kend; k0 += 8) {
            float s1[8], s2[8];
#pragma unroll
            for (int kk = 0; kk < 8; ++kk) { const int key = k0 + kk; const bf16* kp = Kd + ((size_t)(b * SEQ + key)) * 1024 + h * 128; float d1 = 0.f, d2 = 0.f;
#pragma unroll
                for (int i = 0; i < 8; ++i) { d1 += dot8(*(const LAS v4u*)(qv + i * 8), *(const v4u*)(kp + i * 8)); d2 += dot8(*(const LAS v4u*)(qv + 64 + i * 8), *(const v4u*)(kp + 64 + i * 8)); }
                const int rel = q - key; const int idx = rel < 0 ? 0 : (rel > 127 ? 127 : rel); const float bias = lut[h * 128 + idx];
                s1[kk] = rel >= 0 ? d1 + bias : -1e30f; s2[kk] = rel >= 0 ? d2 + bias : -1e30f; asm volatile("" ::: "memory"); }
            float mx1 = m1, mx2 = m2;
#pragma unroll
            for (int kk = 0; kk < 8; ++kk) { mx1 = fmaxf(mx1, s1[kk]); mx2 = fmaxf(mx2, s2[kk]); }
            const float f1 = __builtin_amdgcn_exp2f(m1 - mx1), f2 = __builtin_amdgcn_exp2f(m2 - mx2); m1 = mx1; m2 = mx2; l1 *= f1; l2 *= f2;
#pragma unroll
            for (int j = 0; j < 16; ++j) { o1[j] *= f1; o2[j] *= f2; }
#pragma unroll
            for (int kk = 0; kk < 8; ++kk) { s1[kk] = __builtin_amdgcn_exp2f(s1[kk] - mx1); s2[kk] = __builtin_amdgcn_exp2f(s2[kk] - mx2); l1 += s1[kk]; l2 += s2[kk]; }
#pragma unroll
            for (int j = 0; j < 16; ++j) { const v4u vv = *(const v4u*)(VTd + ((size_t)(bh * 128 + eg * 16 + j)) * SEQ + k0);
#pragma unroll
                for (int i = 0; i < 4; ++i) { const float vl = __uint_as_float(vv[i] << 16), vh = __uint_as_float(vv[i] & 0xffff0000u);
                    o1[j] += s1[2 * i] * vl + s1[2 * i + 1] * vh; o2[j] += s2[2 * i] * vl + s2[2 * i + 1] * vh; } }
        }
        float ssq = 0.f; const float r1 = 1.0f / l1, r2 = lam / l2;
#pragma unroll
        for (int j = 0; j < 16; ++j) { o1[j] = o1[j] * r1 - o2[j] * r2; ssq += o1[j] * o1[j]; }
        __syncthreads();
        ss[eg * 64 + lane] = ssq;
        __syncthreads();
        float sst = 0.f;
#pragma unroll
        for (int i = 0; i < 8; ++i) sst += ss[i * 64 + lane];
        const float rstd = outscale / sqrtf(sst * (1.0f / 128.0f) + RMS_EPS);
#pragma unroll
        for (int j = 0; j < 16; ++j) Od[qrow * 1024 + h * 128 + eg * 16 + j] = f2bf1(o1[j] * rstd * subln[eg * 16 + j]);
    }
}

typedef short bf16x8_t __attribute__((ext_vector_type(8)));
typedef float f32x16 __attribute__((ext_vector_type(16)));
typedef unsigned v2u __attribute__((ext_vector_type(2)));
typedef float f32x2 __attribute__((ext_vector_type(2)));
#define MFMA32(a, b, c) __builtin_amdgcn_mfma_f32_32x32x16_bf16((a), (b), (c), 0, 0, 0)
__device__ __forceinline__ int crow(int i, int hh) { return (i & 3) + 8 * (i >> 2) + 4 * hh; }
__device__ __forceinline__ float xhalf_max(float v) { const auto rr = __builtin_amdgcn_permlane32_swap(__float_as_uint(v), __float_as_uint(v), false, false); return fmaxf(__uint_as_float(rr[0]), __uint_as_float(rr[1])); }
__device__ __forceinline__ float xhalf_sum(float v) { const auto rr = __builtin_amdgcn_permlane32_swap(__float_as_uint(v), __float_as_uint(v), false, false); return __uint_as_float(rr[0]) + __uint_as_float(rr[1]); }
__device__ __forceinline__ float max3f(float a, float b, float c) { float r; asm("v_max3_f32 %0, %1, %2, %3" : "=v"(r) : "v"(a), "v"(b), "v"(c)); return r; }
__device__ __forceinline__ unsigned cvtpk(float lo, float hi) { return pg8::cvt_pk_bf16(lo, hi); }
__device__ __forceinline__ bf16x8_t pack_frag(const f32x16& p, int s) {
    v4u w; w.x = cvtpk(p[8 * s + 0], p[8 * s + 1]); w.y = cvtpk(p[8 * s + 2], p[8 * s + 3]); w.z = cvtpk(p[8 * s + 4], p[8 * s + 5]); w.w = cvtpk(p[8 * s + 6], p[8 * s + 7]);
    return __builtin_bit_cast(bf16x8_t, w);
}
constexpr int AT_KSTR = 136, AT_VSTR = 68, AT_KBUF = 64 * AT_KSTR * 2, AT_VBUF = 128 * AT_VSTR * 2;
constexpr int AT_VOFF = 2 * AT_KBUF, AT_LUT = AT_VOFF + 2 * AT_VBUF;
template <int AMODE = 0> __device__ __forceinline__ void attn_mfma(const int tid, const int bid, LAS unsigned char* lds, const bf16* Qd, const bf16* Kd, const bf16* VTd, bf16* Od, const float* lutg, const float* rel_tab, float lam, const float* subln, float outscale) {
    const int lane = tid & 63, r = lane & 31, hh = lane >> 5;
    const int wave = __builtin_amdgcn_readfirstlane(tid >> 6), mi = wave & 1, g = wave >> 1;
    const int w = bid, bh = w & 15, g16 = w >> 4, b = bh >> 3, h = bh & 7;
    LAS float* lut = (LAS float*)(lds + AT_LUT); LAS float* ex = (LAS float*)lds;
    const float NEG = -1e30f;
    __syncthreads();
    if (tid < 128) lut[tid] = lutg[h * 128 + tid] - rel_tab[31 * 8 + h] * LOG2E;
    const bf16* kg = Kd + ((size_t)(b * SEQ)) * 1024 + h * 128 + (size_t)(tid >> 4) * 1024 + (tid & 15) * 8;
    const bf16* vg = VTd + ((size_t)(bh * 128 + (tid >> 3))) * SEQ + (tid & 7) * 8;
    const int kso = ((tid >> 4) * AT_KSTR + (tid & 15) * 8) * 2, vso = AT_VOFF + ((tid >> 3) * AT_VSTR + (tid & 7) * 8) * 2;
    for (int ui = 0; ui < 4; ++ui) {
        const int qb = ui == 0 ? g16 : (ui == 1 ? 31 - g16 : (ui == 2 ? 32 + g16 : 63 - g16));
        const int qw = qb * 128 + 32 * g, NT = 2 * qb + 2, qabs = qw + r;
        const bf16* qp = Qd + ((size_t)(b * SEQ + qabs)) * 1024 + h * 128 + 64 * mi + 8 * hh;
        bf16x8_t qf[4];
#pragma unroll
        for (int ds = 0; ds < 4; ++ds) qf[ds] = *(const bf16x8_t*)(qp + 16 * ds);
        f32x16 o[4];
#pragma unroll
        for (int dt = 0; dt < 4; ++dt)
#pragma unroll
            for (int i = 0; i < 16; ++i) o[dt][i] = 0.f;
        float mref = 0.f, l = 0.f; bool first = true;
        v4u kr0, kr1, vr0, vr1;
        const int NTw = (qw + 31) / 64 + 1 < NT ? (qw + 31) / 64 + 1 : NT;
        const bool isY = wave >= 4;
#define AT_LOADK(t) do { kr0 = *(const v4u*)(kg + (size_t)(t) * 64 * 1024); kr1 = *(const v4u*)(kg + (size_t)(t) * 64 * 1024 + 32 * 1024); } while (0)
#define AT_LOADV(t) do { vr0 = *(const v4u*)(vg + (t) * 64); vr1 = *(const v4u*)(vg + (size_t)64 * SEQ + (t) * 64); } while (0)
#define AT_STOREK(bf) do { *(LAS v4u*)(lds + (bf) * AT_KBUF + kso) = kr0; *(LAS v4u*)(lds + (bf) * AT_KBUF + kso + 32 * AT_KSTR * 2) = kr1; } while (0)
#define AT_STOREV(bf) do { *(LAS v2u*)(lds + (bf) * AT_VBUF + vso) = (v2u){vr0.x, vr0.y}; *(LAS v2u*)(lds + (bf) * AT_VBUF + vso + 8) = (v2u){vr0.z, vr0.w}; \
        *(LAS v2u*)(lds + (bf) * AT_VBUF + vso + 64 * AT_VSTR * 2) = (v2u){vr1.x, vr1.y}; *(LAS v2u*)(lds + (bf) * AT_VBUF + vso + 64 * AT_VSTR * 2 + 8) = (v2u){vr1.z, vr1.w}; } while (0)
#define AT_SB __builtin_amdgcn_sched_barrier(0)
#define AT_PVB(bv) do { const LAS unsigned char* vb_ = lds + AT_VOFF + (bv) * AT_VBUF + (r * AT_VSTR + 4 * hh) * 2; v4u fa0, fb0, fa1, fb1, fa2, fb2; { const LAS unsigned char* a_ = vb_ + 0 * 32 * AT_VSTR * 2 + 0 * 32; const v2u l0 = *(const LAS v2u*)a_, h0 = *(const LAS v2u*)(a_ + 16), l1 = *(const LAS v2u*)(a_ + 32 * AT_VSTR * 2), h1 = *(const LAS v2u*)(a_ + 32 * AT_VSTR * 2 + 16); fa0 = (v4u){l0.x, l0.y, h0.x, h0.y}; fb0 = (v4u){l1.x, l1.y, h1.x, h1.y}; } AT_SB; { const LAS unsigned char* a_ = vb_ + 2 * 32 * AT_VSTR * 2 + 0 * 32; const v2u l0 = *(const LAS v2u*)a_, h0 = *(const LAS v2u*)(a_ + 16), l1 = *(const LAS v2u*)(a_ + 32 * AT_VSTR * 2), h1 = *(const LAS v2u*)(a_ + 32 * AT_VSTR * 2 + 16); fa1 = (v4u){l0.x, l0.y, h0.x, h0.y}; fb1 = (v4u){l1.x, l1.y, h1.x, h1.y}; } AT_SB; { const LAS unsigned char* a_ = vb_ + 0 * 32 * AT_VSTR * 2 + 1 * 32; const v2u l0 = *(const LAS v2u*)a_, h0 = *(const LAS v2u*)(a_ + 16), l1 = *(const LAS v2u*)(a_ + 32 * AT_VSTR * 2), h1 = *(const LAS v2u*)(a_ + 32 * AT_VSTR * 2 + 16); fa2 = (v4u){l0.x, l0.y, h0.x, h0.y}; fb2 = (v4u){l1.x, l1.y, h1.x, h1.y}; } AT_SB; { __builtin_amdgcn_s_setprio(1); o[0] = MFMA32(__builtin_bit_cast(bf16x8_t, fa0), pb0, o[0]); o[1] = MFMA32(__builtin_bit_cast(bf16x8_t, fb0), pb0, o[1]); __builtin_amdgcn_s_setprio(0); } AT_SB; { const LAS unsigned char* a_ = vb_ + 2 * 32 * AT_VSTR * 2 + 1 * 32; const v2u l0 = *(const LAS v2u*)a_, h0 = *(const LAS v2u*)(a_ + 16), l1 = *(const LAS v2u*)(a_ + 32 * AT_VSTR * 2), h1 = *(const LAS v2u*)(a_ + 32 * AT_VSTR * 2 + 16); fa0 = (v4u){l0.x, l0.y, h0.x, h0.y}; fb0 = (v4u){l1.x, l1.y, h1.x, h1.y}; } AT_SB; { __builtin_amdgcn_s_setprio(1); o[2] = MFMA32(__builtin_bit_cast(bf16x8_t, fa1), pb0, o[2]); o[3] = MFMA32(__builtin_bit_cast(bf16x8_t, fb1), pb0, o[3]); __builtin_amdgcn_s_setprio(0); } AT_SB; { const LAS unsigned char* a_ = vb_ + 0 * 32 * AT_VSTR * 2 + 2 * 32; const v2u l0 = *(const LAS v2u*)a_, h0 = *(const LAS v2u*)(a_ + 16), l1 = *(const LAS v2u*)(a_ + 32 * AT_VSTR * 2), h1 = *(const LAS v2u*)(a_ + 32 * AT_VSTR * 2 + 16); fa1 = (v4u){l0.x, l0.y, h0.x, h0.y}; fb1 = (v4u){l1.x, l1.y, h1.x, h1.y}; } AT_SB; { __builtin_amdgcn_s_setprio(1); o[0] = MFMA32(__builtin_bit_cast(bf16x8_t, fa2), pb1, o[0]); o[1] = MFMA32(__builtin_bit_cast(bf16x8_t, fb2), pb1, o[1]); __builtin_amdgcn_s_setprio(0); } AT_SB; { const LAS unsigned char* a_ = vb_ + 2 * 32 * AT_VSTR * 2 + 2 * 32; const v2u l0 = *(const LAS v2u*)a_, h0 = *(const LAS v2u*)(a_ + 16), l1 = *(const LAS v2u*)(a_ + 32 * AT_VSTR * 2), h1 = *(const LAS v2u*)(a_ + 32 * AT_VSTR * 2 + 16); fa2 = (v4u){l0.x, l0.y, h0.x, h0.y}; fb2 = (v4u){l1.x, l1.y, h1.x, h1.y}; } AT_SB; { __builtin_amdgcn_s_setprio(1); o[2] = MFMA32(__builtin_bit_cast(bf16x8_t, fa0), pb1, o[2]); o[3] = MFMA32(__builtin_bit_cast(bf16x8_t, fb0), pb1, o[3]); __builtin_amdgcn_s_setprio(0); } AT_SB; { const LAS unsigned char* a_ = vb_ + 0 * 32 * AT_VSTR * 2 + 3 * 32; const v2u l0 = *(const LAS v2u*)a_, h0 = *(const LAS v2u*)(a_ + 16), l1 = *(const LAS v2u*)(a_ + 32 * AT_VSTR * 2), h1 = *(const LAS v2u*)(a_ + 32 * AT_VSTR * 2 + 16); fa0 = (v4u){l0.x, l0.y, h0.x, h0.y}; fb0 = (v4u){l1.x, l1.y, h1.x, h1.y}; } AT_SB; { __builtin_amdgcn_s_setprio(1); o[0] = MFMA32(__builtin_bit_cast(bf16x8_t, fa1), pb2, o[0]); o[1] = MFMA32(__builtin_bit_cast(bf16x8_t, fb1), pb2, o[1]); __builtin_amdgcn_s_setprio(0); } AT_SB; { const LAS unsigned char* a_ = vb_ + 2 * 32 * AT_VSTR * 2 + 3 * 32; const v2u l0 = *(const LAS v2u*)a_, h0 = *(const LAS v2u*)(a_ + 16), l1 = *(const LAS v2u*)(a_ + 32 * AT_VSTR * 2), h1 = *(const LAS v2u*)(a_ + 32 * AT_VSTR * 2 + 16); fa1 = (v4u){l0.x, l0.y, h0.x, h0.y}; fb1 = (v4u){l1.x, l1.y, h1.x, h1.y}; } AT_SB; { __builtin_amdgcn_s_setprio(1); o[2] = MFMA32(__builtin_bit_cast(bf16x8_t, fa2), pb2, o[2]); o[3] = MFMA32(__builtin_bit_cast(bf16x8_t, fb2), pb2, o[3]); __builtin_amdgcn_s_setprio(0); } AT_SB; { __builtin_amdgcn_s_setprio(1); o[0] = MFMA32(__builtin_bit_cast(bf16x8_t, fa0), pb3, o[0]); o[1] = MFMA32(__builtin_bit_cast(bf16x8_t, fb0), pb3, o[1]); __builtin_amdgcn_s_setprio(0); } AT_SB; { __builtin_amdgcn_s_setprio(1); o[2] = MFMA32(__builtin_bit_cast(bf16x8_t, fa1), pb3, o[2]); o[3] = MFMA32(__builtin_bit_cast(bf16x8_t, fb1), pb3, o[3]); __builtin_amdgcn_s_setprio(0); } AT_SB; } while (0)
#define AT_QKB(bk) do { const LAS unsigned char* kb_ = lds + (bk) * AT_KBUF + (r * AT_KSTR + 64 * mi + 8 * hh) * 2; v4u fa0, fb0, fa1, fb1, fa2, fb2; { fa0 = *(const LAS v4u*)(kb_ + 0 * 32); fb0 = *(const LAS v4u*)(kb_ + 32 * AT_KSTR * 2 + 0 * 32); } AT_SB; { fa1 = *(const LAS v4u*)(kb_ + 1 * 32); fb1 = *(const LAS v4u*)(kb_ + 32 * AT_KSTR * 2 + 1 * 32); } AT_SB; { fa2 = *(const LAS v4u*)(kb_ + 2 * 32); fb2 = *(const LAS v4u*)(kb_ + 32 * AT_KSTR * 2 + 2 * 32); } AT_SB; { __builtin_amdgcn_s_setprio(1); p0 = MFMA32(__builtin_bit_cast(bf16x8_t, fa0), qf[0], p0); p1 = MFMA32(__builtin_bit_cast(bf16x8_t, fb0), qf[0], p1); __builtin_amdgcn_s_setprio(0); } AT_SB; { fa0 = *(const LAS v4u*)(kb_ + 3 * 32); fb0 = *(const LAS v4u*)(kb_ + 32 * AT_KSTR * 2 + 3 * 32); } AT_SB; { __builtin_amdgcn_s_setprio(1); p0 = MFMA32(__builtin_bit_cast(bf16x8_t, fa1), qf[1], p0); p1 = MFMA32(__builtin_bit_cast(bf16x8_t, fb1), qf[1], p1); __builtin_amdgcn_s_setprio(0); } AT_SB; { __builtin_amdgcn_s_setprio(1); p0 = MFMA32(__builtin_bit_cast(bf16x8_t, fa2), qf[2], p0); p1 = MFMA32(__builtin_bit_cast(bf16x8_t, fb2), qf[2], p1); __builtin_amdgcn_s_setprio(0); } AT_SB; { __builtin_amdgcn_s_setprio(1); p0 = MFMA32(__builtin_bit_cast(bf16x8_t, fa0), qf[3], p0); p1 = MFMA32(__builtin_bit_cast(bf16x8_t, fb0), qf[3], p1); __builtin_amdgcn_s_setprio(0); } AT_SB; } while (0)
#define AT_SOFTMAX(t) do { const int k0 = (t) * 64; \
        if (qw - k0 - 63 < 113) { \
            _Pragma("unroll") for (int i = 0; i < 16; ++i) { const int rel0 = qabs - (k0 + crow(i, hh)), rel1 = rel0 - 32; \
                const float b0_ = lut[rel0 < 0 ? 0 : (rel0 > 127 ? 127 : rel0)], b1_ = lut[rel1 < 0 ? 0 : (rel1 > 127 ? 127 : rel1)];     \
                p0[i] = rel0 < 0 ? NEG : p0[i] + b0_; p1[i] = rel1 < 0 ? NEG : p1[i] + b1_; } } \
        float mt = max3f(p0[0], p0[1], p1[0]), mu = max3f(p0[2], p0[3], p1[1]); mt = max3f(mt, p1[2], p1[3]); \
        _Pragma("unroll") for (int i = 4; i < 16; i += 4) { mt = max3f(mt, p0[i], p0[i + 1]); mu = max3f(mu, p0[i + 2], p0[i + 3]); mt = max3f(mt, p1[i], p1[i + 1]); mu = max3f(mu, p1[i + 2], p1[i + 3]); } \
        mt = xhalf_max(fmaxf(mt, mu)) - mref; \
        if (__any(first ? 1 : (mt > 6.0f))) { \
            const float dl = first ? mt : fmaxf(mt, 0.f), alpha = first ? 1.0f : __builtin_amdgcn_exp2f(-dl); mref += dl; l *= alpha; \
            _Pragma("unroll") for (int dt = 0; dt < 4; ++dt) _Pragma("unroll") for (int i = 0; i < 16; ++i) o[dt][i] *= alpha; \
            first = false; } \
        { f32x2 ls2 = {0.f, 0.f}; const f32x2 nm = {-mref, -mref}; \
          _Pragma("unroll") for (int i = 0; i < 16; i += 2) { f32x2 a = (f32x2){p0[i], p0[i + 1]} + nm, b = (f32x2){p1[i], p1[i + 1]} + nm; \
              a.x = __builtin_amdgcn_exp2f(a.x); a.y = __builtin_amdgcn_exp2f(a.y); b.x = __builtin_amdgcn_exp2f(b.x); b.y = __builtin_amdgcn_exp2f(b.y); \
              p0[i] = a.x; p0[i + 1] = a.y; p1[i] = b.x; p1[i + 1] = b.y; ls2 += a; ls2 += b; } \
          l += ls2.x + ls2.y; } \
        pb0 = pack_frag(p0, 0); pb1 = pack_frag(p0, 1); pb2 = pack_frag(p1, 0); pb3 = pack_frag(p1, 1); } while (0)
        __syncthreads();
        AT_LOADK(0); AT_LOADV(0); AT_STOREK(0); AT_STOREV(0); AT_LOADK(1); AT_STOREK(1);
        __syncthreads();
        if (isY) __syncthreads();
        for (int t = 0; t < NT; ++t) {
            f32x16 p0, p1; bf16x8_t pb0, pb1, pb2, pb3;
#pragma unroll
            for (int i = 0; i < 16; ++i) { p0[i] = 0.f; p1[i] = 0.f; }
            if (t < NTw) AT_QKB(t & 1);
            if (!(AMODE & 4) && t >= 1) { if (t + 1 < NT) AT_STOREK((t + 1) & 1); if (t < NT) AT_STOREV(t & 1); }
            __syncthreads();
            if (!(AMODE & 4)) { if (t + 2 < NT) AT_LOADK(t + 2); if (t + 1 < NT) AT_LOADV(t + 1); }
            if (t < NTw) {
                AT_SOFTMAX(t);
                __syncthreads();
                AT_PVB(t & 1);
            } else __syncthreads();
        }
        __syncthreads();
        if (!isY) __syncthreads();
#undef AT_LOADK
#undef AT_LOADV
#undef AT_STOREK
#undef AT_STOREV
#undef AT_SB
#undef AT_PVB
#undef AT_QKB
#undef AT_SOFTMAX
        l = xhalf_sum(l);
        const float linv = 1.0f / l;
        if (mi == 1) { const float sc = lam * linv;
#pragma unroll
            for (int dt = 0; dt < 4; ++dt)
#pragma unroll
                for (int i = 0; i < 16; ++i) ex[g * 4096 + (32 * dt + crow(i, hh)) * 32 + r] = o[dt][i] * sc; }
        __syncthreads();
        if (mi == 0) { float ssq = 0.f;
#pragma unroll
            for (int dt = 0; dt < 4; ++dt)
#pragma unroll
                for (int i = 0; i < 16; ++i) { const float v = o[dt][i] * linv - ex[g * 4096 + (32 * dt + crow(i, hh)) * 32 + r]; o[dt][i] = v; ssq += v * v; }
            ssq += __shfl_xor(ssq, 32);
            const float rstd = outscale / sqrtf(ssq * (1.0f / 128.0f) + RMS_EPS);
            bf16* op = Od + ((size_t)(b * SEQ + qabs)) * 1024 + h * 128 + 4 * hh;
#pragma unroll
            for (int dt = 0; dt < 4; ++dt)
#pragma unroll
                for (int i4 = 0; i4 < 4; ++i4) { const int dv = 32 * dt + 8 * i4; const f32x4 sg = *(const f32x4*)(subln + dv + 4 * hh);
                    v2u wv; wv.x = cvtpk(o[dt][4 * i4] * rstd * sg[0], o[dt][4 * i4 + 1] * rstd * sg[1]); wv.y = cvtpk(o[dt][4 * i4 + 2] * rstd * sg[2], o[dt][4 * i4 + 3] * rstd * sg[3]);
                    *(v2u*)(op + dv) = wv; }
        }
    }
}

constexpr int R1_STR = 264;
constexpr int R1_TILE = 64 * R1_STR * 2;
__device__ __forceinline__ void ret_scan_mfma(const int tid, const int bid, LAS unsigned char* lds, const bf16* K, const bf16* VT, bf16* ST) {
    const int lane = tid & 63, r = lane & 31, hh = lane >> 5, wave = __builtin_amdgcn_readfirstlane(tid >> 6);
    const int w = bid, bh = w & 7, eb = w >> 5, db = (w >> 3) & 3, h = bh & 3;
    const float lg2 = head_log2_gamma(h), cd = __builtin_exp2f(256.f * lg2);
    const bf16* vg = VT + ((size_t)(bh * 512 + eb * 64 + (tid >> 5))) * SEQ + (tid & 31) * 8;
    const bf16* kg = K + ((size_t)(bh * SEQ + lane)) * 256 + db * 64 + wave * 8;
    v4u vrA[4], krA[4], vrB[4], krB[4];
#define R1_LOAD(vr, kr, c2) do { _Pragma("unroll") for (int i = 0; i < 4; ++i) { vr[i] = *(const v4u*)(vg + (size_t)(16 * i) * SEQ + (c2) * 256); kr[i] = *(const v4u*)(kg + (size_t)((c2) * 256 + 64 * i) * 256); } } while (0)
#define R1_STORE(vr, kr, bf) do { _Pragma("unroll") for (int i = 0; i < 4; ++i) { \
        *(LAS v4u*)(lds + (bf) * R1_TILE + (((tid >> 5) + 16 * i) * R1_STR + (tid & 31) * 8) * 2) = vr[i]; \
        const int m_ = lane + 64 * i; const float kd_ = __builtin_amdgcn_exp2f((float)(255 - m_) * lg2); \
        LAS bf16* kt_ = (LAS bf16*)(lds + (2 + (bf)) * R1_TILE) + (wave * 8) * R1_STR + m_; \
        _Pragma("unroll") for (int q_ = 0; q_ < 4; ++q_) { kt_[(2 * q_) * R1_STR] = f2bf1(__uint_as_float(kr[i][q_] << 16) * kd_); kt_[(2 * q_ + 1) * R1_STR] = f2bf1(__uint_as_float(kr[i][q_] & 0xffff0000u) * kd_); } } } while (0)
    f32x16 acc;
#pragma unroll
    for (int i = 0; i < 16; ++i) acc[i] = 0.f;
    const int et2 = wave & 1, dt2 = (wave >> 1) & 1;
#define R1_COMPUTE(c2) do { if (wave < 4) { \
            bf16* sp = ST + (((size_t)(bh * 32 + (c2))) * 512 + eb * 64 + 32 * et2) * 256 + db * 64 + 32 * dt2 + r; \
            _Pragma("unroll") for (int i = 0; i < 16; ++i) { sp[(size_t)crow(i, hh) * 256] = f2bf1(acc[i]); acc[i] *= cd; } \
            const LAS unsigned char* ab = lds + ((c2) & 1) * R1_TILE + ((32 * et2 + r) * R1_STR + 8 * hh) * 2; \
            const LAS unsigned char* bb = lds + (2 + ((c2) & 1)) * R1_TILE + ((32 * dt2 + r) * R1_STR + 8 * hh) * 2; \
            bf16x8_t fa[16], fb[16]; \
            _Pragma("unroll") for (int ks = 0; ks < 16; ++ks) { fa[ks] = *(const LAS bf16x8_t*)(ab + ks * 32); fb[ks] = *(const LAS bf16x8_t*)(bb + ks * 32); } \
            _Pragma("unroll") for (int ks = 0; ks < 16; ++ks) acc = MFMA32(fa[ks], fb[ks], acc); } } while (0)
    __syncthreads();
    R1_LOAD(vrA, krA, 0); R1_LOAD(vrB, krB, 1); R1_STORE(vrA, krA, 0);
    __syncthreads();
    for (int c2 = 0; c2 < 32; c2 += 2) {
        if (c2 + 2 < 32) R1_LOAD(vrA, krA, c2 + 2);
        R1_COMPUTE(c2);
        R1_STORE(vrB, krB, 1);
        __syncthreads();
        if (c2 + 3 < 32) R1_LOAD(vrB, krB, c2 + 3);
        R1_COMPUTE(c2 + 1);
        if (c2 + 2 < 32) R1_STORE(vrA, krA, 0);
        __syncthreads();
    }
#undef R1_COMPUTE
#undef R1_LOAD
#undef R1_STORE
}
constexpr int R2_STR = 264, R2_PB = 128 * R2_STR * 2, R2_SOFF = R2_PB, R2_SBUF = 512 * 64, R2_SS = R2_SOFF + 2 * R2_SBUF;
__device__ __forceinline__ void ret_out_mfma(const int tid, const int bid, LAS unsigned char* lds, const bf16* Q, const bf16* K, const bf16* VT, bf16* GY, const bf16* ST, const int dry = 0) {
    const int wave = __builtin_amdgcn_readfirstlane(tid >> 6), nt = wave & 3, eh = wave >> 2;
    LAS float* ssp = (LAS float*)(lds + R2_SS);
#define R2_IDS int t_ = tid; asm volatile("" : "+v"(t_)); const int lane = t_ & 63, r = lane & 31, hh = lane >> 5; \
    const int srow = t_ >> 2, sc4 = t_ & 3, sso = R2_SOFF + srow * 64 + ((sc4 ^ ((srow >> 2) & 3)) * 16), fsw = (r >> 2) & 3, fro = R2_SOFF + (256 * eh + r) * 64; \
    (void)lane; (void)srow; (void)sc4; (void)sso; (void)fsw; (void)fro; (void)hh;
    for (int task = bid; task < 512; task += gridDim.x) {
        const int bh = task >> 6, c = (task & 63) ^ (task >> 8), h = bh & 3, odd = c & 1, tk0 = (c & ~1) * 128, tq0 = c * 128;
        const float lg2 = head_log2_gamma(h);
        f32x16 acc[8];
#pragma unroll
        for (int et = 0; et < 8; ++et)
#pragma unroll
            for (int i = 0; i < 16; ++i) acc[et][i] = 0.f;
        v4u sr[4];
#define R2_QG (Q + ((size_t)(bh * SEQ + tq0 + 32 * nt + r)) * 256 + 8 * hh)
#define R2_LOADS(src, rstride, sl) do { _Pragma("unroll") for (int i = 0; i < 4; ++i) sr[i] = *(const v4u*)((src) + (size_t)(srow + 128 * i) * (rstride) + 32 * (sl) + 8 * sc4); } while (0)
#define R2_STORES(bf) do { _Pragma("unroll") for (int i = 0; i < 4; ++i) *(LAS v4u*)(lds + (bf) * R2_SBUF + sso + 128 * i * 64) = sr[i]; } while (0)
#define R2_AFRAG(bf, et, ksl) (*(const LAS bf16x8_t*)(lds + (bf) * R2_SBUF + fro + (et) * 32 * 64 + (((2 * (ksl) + hh) ^ fsw) * 16)))
#define R2_SB __builtin_amdgcn_sched_barrier(0)
#define R2_SLICE(bf, b0, b1) do { const int bf_ = (bf); const bf16x8_t b0_ = (b0), b1_ = (b1); bf16x8_t fa0, fb0, fa1, fb1, fa2, fb2; { fa0 = R2_AFRAG(bf_, 0, 0); fb0 = R2_AFRAG(bf_, 0, 1); } R2_SB; { fa1 = R2_AFRAG(bf_, 1, 0); fb1 = R2_AFRAG(bf_, 1, 1); } R2_SB; { fa2 = R2_AFRAG(bf_, 2, 0); fb2 = R2_AFRAG(bf_, 2, 1); } R2_SB; { acc[0] = MFMA32(fa0, b0_, acc[0]); acc[0] = MFMA32(fb0, b1_, acc[0]); } R2_SB; { fa0 = R2_AFRAG(bf_, 3, 0); fb0 = R2_AFRAG(bf_, 3, 1); } R2_SB; { acc[1] = MFMA32(fa1, b0_, acc[1]); acc[1] = MFMA32(fb1, b1_, acc[1]); } R2_SB; { fa1 = R2_AFRAG(bf_, 4, 0); fb1 = R2_AFRAG(bf_, 4, 1); } R2_SB; { acc[2] = MFMA32(fa2, b0_, acc[2]); acc[2] = MFMA32(fb2, b1_, acc[2]); } R2_SB; { fa2 = R2_AFRAG(bf_, 5, 0); fb2 = R2_AFRAG(bf_, 5, 1); } R2_SB; { acc[3] = MFMA32(fa0, b0_, acc[3]); acc[3] = MFMA32(fb0, b1_, acc[3]); } R2_SB; { fa0 = R2_AFRAG(bf_, 6, 0); fb0 = R2_AFRAG(bf_, 6, 1); } R2_SB; { acc[4] = MFMA32(fa1, b0_, acc[4]); acc[4] = MFMA32(fb1, b1_, acc[4]); } R2_SB; { fa1 = R2_AFRAG(bf_, 7, 0); fb1 = R2_AFRAG(bf_, 7, 1); } R2_SB; { acc[5] = MFMA32(fa2, b0_, acc[5]); acc[5] = MFMA32(fb2, b1_, acc[5]); } R2_SB; { acc[6] = MFMA32(fa0, b0_, acc[6]); acc[6] = MFMA32(fb0, b1_, acc[6]); } R2_SB; { acc[7] = MFMA32(fa1, b0_, acc[7]); acc[7] = MFMA32(fb1, b1_, acc[7]); } R2_SB; } while (0)
        { R2_IDS const bf16* qg = R2_QG; const bf16* src = ST + (((size_t)(bh * 32 + (c >> 1))) * 512) * 256;
          __syncthreads();
          R2_LOADS(src, 256, 0); R2_STORES(0);
          __syncthreads();
          for (int sl = 0; sl < 8; ++sl) {
              if (sl + 1 < 8) R2_LOADS(src, 256, sl + 1);
              const bf16x8_t bq0 = *(const bf16x8_t*)(qg + 32 * sl), bq1 = *(const bf16x8_t*)(qg + 32 * sl + 16);
              R2_SLICE(sl & 1, bq0, bq1);
              if (sl + 1 < 8) R2_STORES((sl + 1) & 1);
              __syncthreads();
          } }
        { R2_IDS const float qdec = __builtin_amdgcn_exp2f((float)(32 * nt + r + 1 + odd * 128) * lg2);
#pragma unroll
          for (int et = 0; et < 8; ++et)
#pragma unroll
              for (int i = 0; i < 16; ++i) acc[et][i] *= qdec; }
        const int nmt = odd ? 4 + nt + 1 : nt + 1;
        for (int mt = eh; mt < nmt; mt += 2) {
            R2_IDS const bf16* qg = R2_QG;
            f32x16 p;
#pragma unroll
            for (int i = 0; i < 16; ++i) p[i] = 0.f;
            const bf16* kb = K + ((size_t)(bh * SEQ + tk0 + 32 * mt + r)) * 256 + 8 * hh;
#pragma unroll 4
            for (int ks = 0; ks < 16; ++ks) p = MFMA32(*(const bf16x8_t*)(kb + ks * 16), *(const bf16x8_t*)(qg + ks * 16), p);
            const int nq = tq0 + 32 * nt + r, mk = tk0 + 32 * mt + 4 * hh;
#pragma unroll
            for (int i4 = 0; i4 < 4; ++i4) { float v[4];
#pragma unroll
                for (int k = 0; k < 4; ++k) { const int dist = nq - (mk + 8 * i4 + k); v[k] = dist < 0 ? 0.f : p[4 * i4 + k] * __builtin_amdgcn_exp2f((float)dist * lg2); }
                v2u wv; wv.x = cvtpk(v[0], v[1]); wv.y = cvtpk(v[2], v[3]);
                *(LAS v2u*)(lds + ((32 * nt + r) * R2_STR + 32 * mt + 8 * i4 + 4 * hh) * 2) = wv; }
        }
        { R2_IDS const bf16* src = VT + ((size_t)(bh * 512)) * SEQ + tk0; const LAS unsigned char* pb = lds + ((32 * nt + r) * R2_STR + 8 * hh) * 2;
          const int nsl = odd ? 8 : 4;
          R2_LOADS(src, SEQ, 0); R2_STORES(0);
          __syncthreads();
          for (int sl = 0; sl < nsl; ++sl) {
              if (sl + 1 < nsl) R2_LOADS(src, SEQ, sl + 1);
              if (sl < nmt) {
                  const bf16x8_t bp0 = *(const LAS bf16x8_t*)(pb + sl * 64), bp1 = *(const LAS bf16x8_t*)(pb + sl * 64 + 32);
                  R2_SLICE(sl & 1, bp0, bp1);
              }
              if (sl + 1 < nsl) R2_STORES((sl + 1) & 1);
              __syncthreads();
          } }
#undef R2_LOADS
#undef R2_STORES
#undef R2_AFRAG
#undef R2_SLICE
#undef R2_SB
#undef R2_QG
        { R2_IDS float ssq = 0.f;
#pragma unroll
          for (int et = 0; et < 8; ++et)
#pragma unroll
              for (int i = 0; i < 16; ++i) ssq += acc[et][i] * acc[et][i];
          ssq += __shfl_xor(ssq, 32);
          if (hh == 0) ssp[eh * 128 + 32 * nt + r] = ssq; }
        __syncthreads();
        { R2_IDS const float rstd = 1.0f / sqrtf((ssp[32 * nt + r] + ssp[128 + 32 * nt + r]) * (1.0f / 512.0f) + RMS_EPS);
          bf16* gp = GY + ((size_t)((bh >> 2) * SEQ + tq0 + 32 * nt + r)) * 2048 + h * 512 + 256 * eh + 4 * hh;
#pragma unroll
          for (int et = 0; et < 8; ++et)
#pragma unroll
              for (int i4 = 0; i4 < 4; ++i4) { bf16* p4 = gp + 32 * et + 8 * i4; const v2u gg = *(const v2u*)p4;
                  v2u wv; wv.x = cvtpk(acc[et][4 * i4] * rstd * __uint_as_float(gg.x << 16), acc[et][4 * i4 + 1] * rstd * __uint_as_float(gg.x & 0xffff0000u));
                  wv.y = cvtpk(acc[et][4 * i4 + 2] * rstd * __uint_as_float(gg.y << 16), acc[et][4 * i4 + 3] * rstd * __uint_as_float(gg.y & 0xffff0000u));
                  if (!dry || rstd == 1.2345e38f) *(v2u*)p4 = wv; if (i4 == 3 && (et & 1)) asm volatile("" ::: "memory"); } }
    }
}

__device__ __forceinline__ void ret_out_mfma_d(const int dry, const int tid, const int bid, LAS unsigned char* lds, const bf16* Q, const bf16* K, const bf16* VT, bf16* GY, const bf16* ST) { ret_out_mfma(tid, bid, lds, Q, K, VT, GY, ST, dry); }
#define XB_TMO      128
#define XB_XCNT(j)  (256  + 64 * (j))
#define XB_XSUB(j)  (1280 + 64 * (j))
#define XB_XGEN(j)  (2304 + 64 * (j))
#define XB_TOP      3328
#define XB_TOPGEN   3392
#define XCD_BAR_WORDS 3456
#define XB_SPIN_CAP (1u << 18)

__device__ __forceinline__ unsigned xb_ld(unsigned* p)              { return __hip_atomic_load(p, __ATOMIC_RELAXED, __HIP_MEMORY_SCOPE_AGENT); }
__device__ __forceinline__ unsigned xb_add(unsigned* p, unsigned v) { return __hip_atomic_fetch_add(p, v, __ATOMIC_RELAXED, __HIP_MEMORY_SCOPE_AGENT); }
__device__ __forceinline__ unsigned xb_xcc_id() { return (unsigned)__builtin_amdgcn_s_getreg((3 << 11) | 20) & 0xFu; }
#define XB_SPIN(cond, bar) do { unsigned _sp = 0; while (cond) { __builtin_amdgcn_s_sleep(1); \
    if ((++_sp & 255u) == 0u) { if (xb_ld(&(bar)[XB_TMO])) break; if (_sp > XB_SPIN_CAP) { atomicAdd(&(bar)[XB_TMO], 1u); break; } } } } while (0)

struct XcdBarrier {
    unsigned* bar; unsigned x;
    volatile LAS unsigned* st;
};

__device__ __forceinline__ XcdBarrier xcd_barrier_post(unsigned* bar, volatile LAS unsigned* st) {
    XcdBarrier b; b.bar = bar; b.x = xb_xcc_id(); b.st = st;
    if (threadIdx.x == 0) (void)xb_add(&bar[XB_XCNT(b.x)], 1u);
    return b;
}
__device__ __forceinline__ void xcd_barrier_complete(unsigned* bar, unsigned x, unsigned& nloc, unsigned& nx) {
    const unsigned G = gridDim.x * gridDim.y * gridDim.z;
    unsigned sum, cnt, mine, sp = 0u;
    for (;;) {
        sum = 0u; cnt = 0u; mine = 0u;
#pragma unroll
        for (unsigned j = 0; j < 16; ++j) { const unsigned c = xb_ld(&bar[XB_XCNT(j)]); sum += c; cnt += (c > 0u) ? 1u : 0u; mine = (j == x) ? c : mine; }
        if (sum == G) break;
        __builtin_amdgcn_s_sleep(1);
        if ((++sp & 255u) == 0u) { if (xb_ld(&bar[XB_TMO])) break; if (sp > XB_SPIN_CAP) { atomicAdd(&bar[XB_TMO], 1u); break; } }
    }
    nloc = mine > 0u ? mine : 1u; nx = cnt > 0u ? cnt : 1u;
}

__device__ __forceinline__ void xcd_barrier(const XcdBarrier& b) {
    asm volatile("s_waitcnt vmcnt(0)" ::: "memory");
    __syncthreads();
    if (threadIdx.x == 0) {
        unsigned* bar = b.bar;
        __builtin_amdgcn_s_waitcnt(0);
        unsigned nloc = b.st[0], nx = b.st[1];
        if (nloc == 0u) { xcd_barrier_complete(bar, b.x, nloc, nx); b.st[0] = nloc; b.st[1] = nx; }
        const unsigned old = xb_add(&bar[XB_XSUB(b.x)], 1u);
        const unsigned gen = old / nloc;
        if (old + 1u == (gen + 1u) * nloc) {
            __builtin_amdgcn_fence(__ATOMIC_RELEASE, "agent");
            asm volatile("s_waitcnt vmcnt(0)" ::: "memory");
            const unsigned og = xb_add(&bar[XB_TOP], 1u);
            const unsigned tg = og / nx;
            if (og + 1u == (tg + 1u) * nx) xb_add(&bar[XB_TOPGEN], 1u);
            else XB_SPIN(xb_ld(&bar[XB_TOPGEN]) == tg, bar);
            __builtin_amdgcn_fence(__ATOMIC_ACQUIRE, "agent");
            xb_add(&bar[XB_XGEN(b.x)], 1u);
            asm volatile("s_waitcnt vmcnt(0)" ::: "memory");
        } else {
            XB_SPIN(xb_ld(&bar[XB_XGEN(b.x)]) == gen, bar);
            __builtin_amdgcn_fence(__ATOMIC_ACQUIRE, "agent");
            asm volatile("s_waitcnt vmcnt(0)" ::: "memory");
        }
    }
    __syncthreads();
}


#if NAIVE_MIXERS
#define MIXER_RET_A
#define MIXER_RET_B
#define MIXER_DIFF
#else
#define MIXER_RET_A for (int rep_ = 0; rep_ < ((PROBE_DUP & 2) ? 2 : 1); ++rep_) if (IN(pb + 1)) { PH_BEGIN ret_scan_mfma(tid, bid, lds, (const bf16*)(ws + WS_K), (const bf16*)(ws + WS_VT), (bf16*)(ws + WS_ST)); }
#define MIXER_RET_B for (int rep_ = ((PROBE_DUP & 128) ? 1 : 0); rep_ >= 0; --rep_) if (IN(pb + 2)) { PH_BEGIN ret_out_mfma_d(rep_, tid, bid, lds, (const bf16*)(ws + WS_Q), (const bf16*)(ws + WS_K), (const bf16*)(ws + WS_VT), (bf16*)(ws + WS_G), (const bf16*)(ws + WS_ST)); }
#ifndef PROBE_AMODE
#define PROBE_AMODE 0
#endif
#define MIXER_DIFF for (int rep_ = 0; rep_ < ((PROBE_DUP & 1) ? 2 : 1); ++rep_) if (IN(pb + 2)) { PH_BEGIN const float* tab_ = (const float*)(ws + WS_TAB); \
    if (PROBE_AMODE != 0 && rep_ == 0) attn_mfma<PROBE_AMODE>(tid, bid, lds, (const bf16*)(ws + WS_Q), (const bf16*)(ws + WS_K), (const bf16*)(ws + WS_VT), (bf16*)(ws + WS_G), tab_, ka_in(ka, 8), tab_[1024 + j], ka_in(ka, 7) + j * 128, tab_[1024 + 2 + j]); else \
    attn_mfma(tid, bid, lds, (const bf16*)(ws + WS_Q), (const bf16*)(ws + WS_K), (const bf16*)(ws + WS_VT), (bf16*)(ws + WS_G), tab_, ka_in(ka, 8), tab_[1024 + j], ka_in(ka, 7) + j * 128, tab_[1024 + 2 + j]); }
#endif
#if NAIVE_MIXERS
__global__ void __launch_bounds__(NTHR) k_scan_naive(const bf16* K, const bf16* VT, bf16* ST) { ret_scan_naive(K, VT, ST); }
__global__ void __launch_bounds__(NTHR) k_rout_naive(const bf16* Q, const bf16* K, const bf16* VT, bf16* GY, const bf16* ST) {
    extern __shared__ __attribute__((aligned(16))) unsigned char lds_raw[]; ret_out_naive((LAS unsigned char*)lds_raw, Q, K, VT, GY, ST); }
__global__ void __launch_bounds__(NTHR, 2) k_scan_mfma(const bf16* K, const bf16* VT, bf16* ST) {
    extern __shared__ __attribute__((aligned(16))) unsigned char lds_raw[]; ret_scan_mfma(threadIdx.x, blockIdx.x, (LAS unsigned char*)lds_raw, K, VT, ST); }
__global__ void __launch_bounds__(NTHR, 2) k_rout_mfma(const bf16* Q, const bf16* K, const bf16* VT, bf16* GY, const bf16* ST) {
    extern __shared__ __attribute__((aligned(16))) unsigned char lds_raw[]; ret_out_mfma(threadIdx.x, blockIdx.x, (LAS unsigned char*)lds_raw, Q, K, VT, GY, ST); }
__global__ void __launch_bounds__(NTHR, 2) k_attn_mfma(const bf16* Qd, const bf16* Kd, const bf16* VTd, bf16* Od, const float* tab, int j, const float* subln, const float* rel_tab) {
    extern __shared__ __attribute__((aligned(16))) unsigned char lds_raw[]; attn_mfma(threadIdx.x, blockIdx.x, (LAS unsigned char*)lds_raw, Qd, Kd, VTd, Od, tab, rel_tab, tab[1024 + j], subln + j * 128, tab[1024 + 2 + j]); }
__global__ void __launch_bounds__(NTHR) k_attn_naive(const bf16* Qd, const bf16* Kd, const bf16* VTd, bf16* Od, const float* tab, int j, const float* subln) {
    extern __shared__ __attribute__((aligned(16))) unsigned char lds_raw[]; attn_naive((LAS unsigned char*)lds_raw, Qd, Kd, VTd, Od, tab, tab[1024 + j], subln + j * 128, tab[1024 + 2 + j]); }

#endif
typedef const unsigned char __attribute__((address_space(4)))* kaptr;
__device__ __forceinline__ kaptr ka_get() { kaptr p = (kaptr)__builtin_amdgcn_kernarg_segment_ptr(); asm volatile("" : "+s"(p)); return p; }
__device__ __forceinline__ const float* ka_in(kaptr p, int i) { return *(const float* const __attribute__((address_space(4)))*)(p + 8 * i); }
__device__ __forceinline__ float* ka_out(kaptr p) { return *(float* const __attribute__((address_space(4)))*)(p + 96); }
__device__ __forceinline__ unsigned char* ka_ws(kaptr p) { return *(unsigned char* const __attribute__((address_space(4)))*)(p + 104); }
__device__ __forceinline__ int tid_get() { int t = threadIdx.x; asm volatile("" : "+v"(t)); return t; }
__device__ __forceinline__ int bid_get() { int t = blockIdx.x; asm volatile("" : "+s"(t)); return t; }
#define PH_BEGIN const kaptr ka = ka_get(); unsigned char* const ws = ka_ws(ka); const int tid = tid_get(), lane = tid & 63, wave = __builtin_amdgcn_readfirstlane(tid >> 6); \
    const int bid = bid_get(); const int G = gridDim.x, gw = bid * NWAVES + wave, ngw = G * NWAVES; (void)bid; LAS float* const scr = (LAS float*)(lds + wave * 16384); (void)lane; (void)gw; (void)ngw; (void)scr; (void)ws;

__global__ void __launch_bounds__(NTHR, 2) fwd_mega(Args args_unused, int ph_lo, int ph_hi) {
    extern __shared__ __attribute__((aligned(16))) unsigned char lds_raw[];
    cg::grid_group grid = cg::this_grid();
    LAS unsigned char* lds = (LAS unsigned char*)lds_raw;
    volatile LAS unsigned* xst = (volatile LAS unsigned*)(lds + LDS_BYTES - 64);
    if (threadIdx.x < 2) xst[threadIdx.x] = 0u;
    __syncthreads();
    const XcdBarrier xbar = xcd_barrier_post((unsigned*)(ka_ws(ka_get()) + WS_CTL) + CW_BAR, xst);

#define IN(k) (ph_lo <= (k) && (k) < ph_hi)
#define SEAM(k) do { if (IN(k) && IN((k) + 1)) { if (ph_hi < 0) grid.sync(); else xcd_barrier(xbar); } } while (0)
    if (IN(0)) {
        PH_BEGIN
        conv_plain(ka_in(ka, 2), D, RET_IN, (bf16*)(ws + WS_WIN), scr, gw, ngw, lane);
        conv_plain(ka_in(ka, 3), 2048, D, (bf16*)(ws + WS_WOUT), scr, gw, ngw, lane);
        conv_gu(ka_in(ka, 9), ka_in(ka, 10), (bf16*)(ws + WS_WGU), scr, gw, ngw, lane);
        conv_plain(ka_in(ka, 11), FF, D, (bf16*)(ws + WS_WDN), scr, gw, ngw, lane);
        { const float* x = ka_in(ka, 0); const float* gains = ka_in(ka, 1); bf16* XN = (bf16*)(ws + WS_XN);
          for (int m = gw; m < M; m += ngw) rms_row_to_bf16(x + (size_t)m * D, gains, XN + (size_t)m * D, lane); }
        { unsigned* ctl = (unsigned*)(ws + WS_CTL); for (int i = bid * NTHR + tid; i < 16 * 64 * 64; i += G * NTHR) ctl[CW_CNT + i] = 0u; }
        if (bid == 0) {
            const float* rel_tab = ka_in(ka, 8); const float* diff_lambda = ka_in(ka, 6); float* lut = (float*)(ws + WS_TAB); float* lamtab = (float*)(ws + WS_TAB + 4096);
            for (int t = tid; t < 1024; t += NTHR) { const int h = t >> 7, n = t & 127; int bk;
                if (n < 16) bk = n; else { bk = 16 + (int)(__builtin_logf((float)n * (1.0f / 16.0f)) / 2.0794415416798357f * 16.0f); if (bk > 31) bk = 31; }
                lut[t] = rel_tab[bk * 8 + h] * LOG2E; }
            if (tid < 2) { const float* lm = diff_lambda + tid * 256; float a = 0.f, b2 = 0.f; for (int i = 0; i < 64; ++i) { a += lm[i] * lm[64 + i]; b2 += lm[128 + i] * lm[192 + i]; }
                const int li = 2 * tid + 1; const float linit = 0.8f - 0.6f * __builtin_expf(-0.3f * (float)li); lamtab[tid] = __builtin_expf(a) - __builtin_expf(b2) + linit; lamtab[2 + tid] = 1.0f - linit; }
        }
    }
    SEAM(0);

    for (int L = 0; L < DEPTH; ++L) {
        asm volatile("" : "+s"(L));
        const int j = L >> 1; const bool isRet = (L & 1) == 0; const int pb = 1 + 6 * L; (void)j;
        if (L > 0 && IN(pb)) { PH_BEGIN conv_plain(ka_in(ka, 11) + (size_t)L * FF * D, FF, D, (bf16*)(ws + WS_WDN), scr, gw, ngw, lane); __syncthreads(); }
        if (isRet) {
            for (int rep_ = 0; rep_ < ((PROBE_DUP & 4) ? 2 : 1); ++rep_) if (IN(pb)) { PH_BEGIN
              pg8::Gemm g{(const bf16*)(ws + WS_XN), (const bf16*)(ws + WS_WIN), M, RET_IN, D}; pg8::StaticOrder S; S.init(M, RET_IN, G, bid);
              pg8::EpiRetIn E{(bf16*)(ws + WS_Q), (bf16*)(ws + WS_K), (bf16*)(ws + WS_VT), (bf16*)(ws + WS_G)};
              pg8::gemm_phase<pg8::EpiRetIn, pg8::StaticOrder, true, true>(lds, g, S, E); }
            SEAM(pb);
            MIXER_RET_A
            SEAM(pb + 1);
            MIXER_RET_B
            SEAM(pb + 2);
        } else {
            if (IN(pb)) { PH_BEGIN
              pg8::Gemm g{(const bf16*)(ws + WS_XN), (const bf16*)(ws + WS_WIN), M, DIFF_IN, D}; pg8::StaticOrder S; S.init(M, DIFF_IN, G, bid);
              pg8::EpiDiffIn E{(bf16*)(ws + WS_Q), (bf16*)(ws + WS_K), (bf16*)(ws + WS_VT), 0.125f * LOG2E};
              pg8::gemm_phase<pg8::EpiDiffIn, pg8::StaticOrder, true, true>(lds, g, S, E); }
            SEAM(pb);
            SEAM(pb + 1);
            MIXER_DIFF
            SEAM(pb + 2);
        }
        if (IN(pb + 3)) { PH_BEGIN
          const float* gL = ka_in(ka, 1) + (size_t)L * 4 * D; float* out = ka_out(ka); unsigned* ctl = (unsigned*)(ws + WS_CTL);
          pg8::Gemm g{(const bf16*)(ws + WS_G), (const bf16*)(ws + WS_WOUT), M, D, isRet ? 2048 : 1024}; pg8::StaticOrder S; S.init(M, D, G, bid);
          pg8::EpiNormResNorm E{L == 0 ? ka_in(ka, 0) : (const float*)out, out, (bf16*)(ws + WS_XN), gL + D, gL + 2 * D, (float*)(ws + WS_X), ctl + CW_CNT + (L * 4 + 0) * 64 * 64, RMS_EPS, 0};
          pg8::gemm_phase<pg8::EpiNormResNorm, pg8::StaticOrder, false, true>(lds, g, S, E); }
        SEAM(pb + 3);
        for (int rep_ = 0; rep_ < ((PROBE_DUP & 8) ? 2 : 1); ++rep_) if (IN(pb + 4)) { PH_BEGIN
          pg8::Gemm g{(const bf16*)(ws + WS_XN), (const bf16*)(ws + WS_WGU), M, 2 * FF, D}; pg8::StaticOrder S; S.init(M, 2 * FF, G, bid);
          pg8::EpiSwiGLU E{(bf16*)(ws + WS_ACT)};
          pg8::gemm_phase<pg8::EpiSwiGLU, pg8::StaticOrder, true, true>(lds, g, S, E); }
        SEAM(pb + 4);
        if (L + 1 < DEPTH && IN(pb + 5)) { PH_BEGIN
            const int nj = (L + 1) >> 1;
            if ((L + 1) & 1) { conv_plain(ka_in(ka, 4) + (size_t)nj * D * DIFF_IN, D, DIFF_IN, (bf16*)(ws + WS_WIN), scr, gw, ngw, lane); conv_plain(ka_in(ka, 5) + (size_t)nj * D * D, D, D, (bf16*)(ws + WS_WOUT), scr, gw, ngw, lane); }
            else { conv_plain(ka_in(ka, 2) + (size_t)nj * D * RET_IN, D, RET_IN, (bf16*)(ws + WS_WIN), scr, gw, ngw, lane); conv_plain(ka_in(ka, 3) + (size_t)nj * 2048 * D, 2048, D, (bf16*)(ws + WS_WOUT), scr, gw, ngw, lane); }
            conv_gu(ka_in(ka, 9) + (size_t)(L + 1) * D * FF, ka_in(ka, 10) + (size_t)(L + 1) * D * FF, (bf16*)(ws + WS_WGU), scr, gw, ngw, lane);
            __syncthreads();
        }
#if (PROBE_DUP & 32)
        if (IN(pb + 5)) { PH_BEGIN
          pg8::Gemm g{(const bf16*)(ws + WS_ACT), (const bf16*)(ws + WS_WDN), M, D, FF}; pg8::StaticOrder S; S.init(M, D, G, bid);
          pg8::EpiNull E{(float*)(ws + WS_TAB + 8192)};
          pg8::gemm_phase<pg8::EpiNull, pg8::StaticOrder, false, true>(lds, g, S, E); }
#endif
        if (IN(pb + 5)) { PH_BEGIN
          const float* gains = ka_in(ka, 1); const float* gL = gains + (size_t)L * 4 * D; float* out = ka_out(ka); unsigned* ctl = (unsigned*)(ws + WS_CTL);
          pg8::Gemm g{(const bf16*)(ws + WS_ACT), (const bf16*)(ws + WS_WDN), M, D, FF}; pg8::StaticOrder S; S.init(M, D, G, bid);
          const float* gnext = (L + 1 < DEPTH) ? gains + (size_t)(L + 1) * 4 * D : gL;
          pg8::EpiNormResNorm E{(const float*)out, out, (bf16*)(ws + WS_XN), gL + 3 * D, gnext, (float*)(ws + WS_X), ctl + CW_CNT + (L * 4 + 2) * 64 * 64, RMS_EPS, 0};
          pg8::gemm_phase<pg8::EpiNormResNorm, pg8::StaticOrder, false, true>(lds, g, S, E); }
        SEAM(pb + 5);
    }
}

extern "C" void kernel_launch(void* const* d_in, const int* in_sizes, int n_in, void* d_out, int out_size, void* d_ws, size_t ws_size, hipStream_t stream) {
    static int ready = 0;
    if (ready == 0) {
        ready = 1;
        if (n_in != 12 || out_size != M * D || ws_size < WS_END) { fprintf(stderr, "kernel_launch: unexpected problem (n_in %d, out %d, ws %zu)\n", n_in, out_size, ws_size); ready = -1; }
        else if (hipFuncSetAttribute((const void*)fwd_mega, hipFuncAttributeMaxDynamicSharedMemorySize, LDS_BYTES) != hipSuccess) { fprintf(stderr, "kernel_launch: hipFuncSetAttribute failed\n"); ready = -1; }
        else {
            int dev = 0, cus = 0, per_cu = 0; (void)hipGetDevice(&dev); (void)hipDeviceGetAttribute(&cus, hipDeviceAttributeMultiprocessorCount, dev);
            (void)hipOccupancyMaxActiveBlocksPerMultiprocessor(&per_cu, (const void*)fwd_mega, NTHR, LDS_BYTES);
            if (cus * per_cu < GRID) { fprintf(stderr, "kernel_launch: %d CUs x %d blocks may not hold the %d-workgroup cooperative grid (advisory; the cooperative launch itself decides)\n", cus, per_cu, GRID); }
            (void)hipGetLastError();
        }
    }
    if (ready < 0) return;
    (void)hipMemsetAsync((char*)d_ws + WS_CTL, 0, CTL_ZERO_BYTES, stream);
    Args a{};
    for (int i = 0; i < 12; ++i) a.in[i] = (const float*)d_in[i];
    a.out = (float*)d_out; a.ws = (unsigned char*)d_ws;
    unsigned char* ws = (unsigned char*)d_ws;
    auto mega = [&](int lo, int hi) {
        int plo = lo, phi = hi; void* kargs[] = {&a, &plo, &phi};
        const hipError_t e = hipLaunchCooperativeKernel((const void*)fwd_mega, dim3(GRID), dim3(NTHR), kargs, LDS_BYTES, stream);
        if (e != hipSuccess) fprintf(stderr, "kernel_launch: cooperative launch failed: %s\n", hipGetErrorString(e));
    };
#if NAIVE_MIXERS
    int lo = 0;
    for (int L = 0; L < DEPTH; ++L) {
        const int pb = 1 + 6 * L;
#if PER_PHASE_LAUNCH
        for (int k = lo; k < pb + 1; ++k) mega(k, k + 1);
#else
        mega(lo, pb + 1);
#endif
        if ((L & 1) == 0) {
#if MFMA_SCAN
            hipLaunchKernelGGL(k_scan_mfma, dim3(GRID), dim3(NTHR), 140000, stream, (const bf16*)(ws + WS_K), (const bf16*)(ws + WS_VT), (bf16*)(ws + WS_ST));
#else
            hipLaunchKernelGGL(k_scan_naive, dim3(GRID), dim3(NTHR), 0, stream, (const bf16*)(ws + WS_K), (const bf16*)(ws + WS_VT), (bf16*)(ws + WS_ST));
#endif
            hipLaunchKernelGGL(MFMA_ROUT ? k_rout_mfma : k_rout_naive, dim3(GRID), dim3(NTHR), 140000, stream, (const bf16*)(ws + WS_Q), (const bf16*)(ws + WS_K), (const bf16*)(ws + WS_VT), (bf16*)(ws + WS_G), (const bf16*)(ws + WS_ST));
        } else {
#if MFMA_ATTN
            hipLaunchKernelGGL(k_attn_mfma, dim3(GRID), dim3(NTHR), 73728, stream, (const bf16*)(ws + WS_Q), (const bf16*)(ws + WS_K), (const bf16*)(ws + WS_VT), (bf16*)(ws + WS_G), (const float*)(ws + WS_TAB), L >> 1, (const float*)d_in[7], (const float*)d_in[8]);
#else
            hipLaunchKernelGGL(k_attn_naive, dim3(GRID), dim3(NTHR), 32768, stream, (const bf16*)(ws + WS_Q), (const bf16*)(ws + WS_K), (const bf16*)(ws + WS_VT), (bf16*)(ws + WS_G), (const float*)(ws + WS_TAB), L >> 1, (const float*)d_in[7]);
#endif
        }
        lo = pb + 3;
#ifdef TRUNC_PHASE
        if (TRUNC_PHASE < pb + 6 + 1) { for (int k = lo; k <= TRUNC_PHASE; ++k) mega(k, k + 1); return; }
#endif
    }
#if PER_PHASE_LAUNCH
    for (int k = lo; k < 1 + 6 * DEPTH; ++k) mega(k, k + 1);
#else
    mega(lo, 1 + 6 * DEPTH);
#endif
#else
    mega(0, 1 + 6 * DEPTH);
#endif
}
```

```cpp
#include <hip/hip_runtime.h>
#include <hip/hip_cooperative_groups.h>
#include <cstdio>
#include <cstdint>
namespace cg = cooperative_groups;
namespace pg8 {
#define PG8_LAS __attribute__((address_space(3)))
typedef unsigned short bf16_t;
typedef short bf16x8 __attribute__((ext_vector_type(8)));
typedef float f32x4 __attribute__((ext_vector_type(4)));
typedef unsigned u32x4 __attribute__((ext_vector_type(4)));
constexpr int BM = 256, BK = 64, HALF = 128, HTB = HALF * BK * 2  , STAGE_BYTES = 8 * HTB, NXCD = 8, WGM = 8;

__host__ __device__ __forceinline__ int lds_byte(int r, int c) { const int st = (r >> 4) * 2 + (c >> 5), rr = r & 15, cc = c & 31, ob = rr * 64 + cc * 2; return st * 1024 + (ob ^ (((ob >> 9) & 1) << 5)); }
__host__ __device__ __forceinline__ void stage_rc(int b, int& R, int& C) { const int st = b / 1024, sb = b % 1024, swz = sb ^ (((sb >> 9) & 1) << 5); R = (st >> 1) * 16 + swz / 64; C = (st & 1) * 32 + (swz % 64) / 2; }
__host__ __device__ __forceinline__ int perm32(int rho) { const int n = rho >> 4, i = rho & 15; return 8 * (i >> 2) + 4 * n + (i & 3); }

struct Unit { int pm, pn; };
struct Gemm { const bf16_t* A; const bf16_t* Bt; int M, N, K; };

struct StaticOrder {
    int nM, nN, nwg, G, c;
    __host__ __device__ void init(int M, int N, int G_, int c_) { nM = M / BM; nN = N / BM; nwg = nM * nN; G = G_; c = c_; }
    __host__ __device__ bool next(int i, Unit& u) const {
        const long L = (long)i * G + c; if (L >= nwg) return false;
        int wgid = (int)L; { const int q = nwg / NXCD, r = nwg % NXCD, xcd = wgid % NXCD, off = wgid / NXCD; wgid = (xcd < r ? xcd * (q + 1) : r * (q + 1) + (xcd - r) * q) + off; }
        const int nig = WGM * nN, gid = wgid / nig, fm = gid * WGM, gsz = (nM - fm) < WGM ? (nM - fm) : WGM;
        u.pm = fm + ((wgid % nig) % gsz); u.pn = (wgid % nig) / gsz; return true;
    }
    __device__ __forceinline__ void a_ready(const Unit&) const {}
    __device__ __forceinline__ void done(const Unit&) const {}
};

__device__ __forceinline__ unsigned cvt_pk_bf16(float lo, float hi) { unsigned r; asm volatile("v_cvt_pk_bf16_f32 %0, %1, %2" : "=v"(r) : "v"(lo), "v"(hi)); return r; }
typedef unsigned u32x2 __attribute__((ext_vector_type(2)));
__device__ __forceinline__ float bf2f(unsigned short v) { return __uint_as_float(((unsigned)v) << 16); }
__device__ __forceinline__ unsigned short f2bf1(float f) { unsigned u = __float_as_uint(f); return (unsigned short)((u + 0x7fffu + ((u >> 16) & 1u)) >> 16); }
__device__ __forceinline__ u32x4 pack8(f32x4 a, f32x4 b) { u32x4 w; w.x = cvt_pk_bf16(a[0], a[1]); w.y = cvt_pk_bf16(a[2], a[3]); w.z = cvt_pk_bf16(b[0], b[1]); w.w = cvt_pk_bf16(b[2], b[3]); return w; }
__device__ __forceinline__ float silu_f(float x) { return x * __builtin_amdgcn_rcpf(1.0f + __builtin_amdgcn_exp2f(-1.4426950408889634f * x)); }
__device__ __forceinline__ f32x4 silu4(f32x4 v) { f32x4 o; o[0] = silu_f(v[0]); o[1] = silu_f(v[1]); o[2] = silu_f(v[2]); o[3] = silu_f(v[3]); return o; }
__device__ __forceinline__ void sincos_rad(float ang, float& s, float& c) {
    constexpr double INV2PI = 0.15915494309189533577; constexpr float C_HI = (float)INV2PI; constexpr float C_LO = (float)(INV2PI - (double)C_HI);
    const float hi = ang * C_HI; const float lo = __builtin_fmaf(ang, C_HI, -hi) + ang * C_LO;
    const float fr = (hi - __builtin_rintf(hi)) + lo;
    s = __builtin_amdgcn_sinf(fr); c = __builtin_amdgcn_cosf(fr);
}
constexpr int SEQ_ = 8192;
struct EpiRetIn {
    static constexpr bool PERM = true, AFTER_DRAIN = false;
    bf16_t *Q, *K, *VT, *G;
    __device__ __forceinline__ void operator()(const f32x4 (&acc)[2][2][4][2], const Unit& u, int wr, int wc, int fr, int fq) const {
        const int pn = u.pn, jb = wc * 32 + 8 * fq, rowb = u.pm * BM + wr * 64 + fr;
        if (pn < 8) {
            const int h = pn & 3; const bool isK = pn >= 4; bf16_t* dst = isK ? K : Q; const float sc = isK ? 0.0625f : 1.0f;
            float inv[8];
#pragma unroll
            for (int e = 0; e < 8; ++e) inv[e] = __builtin_amdgcn_exp2f(-(float)(jb + e) * (13.287712379549449f / 128.0f));
#pragma unroll
            for (int ai = 0; ai < 2; ++ai)
#pragma unroll
                for (int m = 0; m < 4; ++m) {
                    const int row = rowb + ai * HALF + m * 16, b = row >> 13, s = row & (SEQ_ - 1); const float pos = (float)s;
                    f32x4 o1[2], o2[2];
#pragma unroll
                    for (int n = 0; n < 2; ++n)
#pragma unroll
                        for (int i = 0; i < 4; ++i) { float sn, cs; sincos_rad(pos * inv[4 * n + i], sn, cs); const float x1 = acc[ai][0][m][n][i], x2 = acc[ai][1][m][n][i];
                            o1[n][i] = (x1 * cs - x2 * sn) * sc; o2[n][i] = (x1 * sn + x2 * cs) * sc; }
                    bf16_t* p = dst + ((size_t)((b * 4 + h) * SEQ_ + s)) * 256 + jb;
                    *(u32x4*)p = pack8(o1[0], o1[1]); *(u32x4*)(p + 128) = pack8(o2[0], o2[1]);
                }
        } else if (pn < 16) {
            const int h = (pn - 8) >> 1, eb = ((pn - 8) & 1) * 256 + jb;
#pragma unroll
            for (int ai = 0; ai < 2; ++ai)
#pragma unroll
                for (int m = 0; m < 4; ++m) {
                    const int row = rowb + ai * HALF + m * 16, b = row >> 13, s = row & (SEQ_ - 1);
#pragma unroll
                    for (int bj = 0; bj < 2; ++bj)
#pragma unroll
                        for (int n = 0; n < 2; ++n)
#pragma unroll
                            for (int i = 0; i < 4; ++i) { const int e = eb + 128 * bj + 4 * n + i; VT[((size_t)((b * 4 + h) * 512 + e)) * SEQ_ + s] = f2bf1(acc[ai][bj][m][n][i]); }
                }
        } else {
            const int cb = (pn - 16) * 256 + jb;
#pragma unroll
            for (int ai = 0; ai < 2; ++ai)
#pragma unroll
                for (int m = 0; m < 4; ++m) {
                    const int row = rowb + ai * HALF + m * 16;
#pragma unroll
                    for (int bj = 0; bj < 2; ++bj) *(u32x4*)(G + (size_t)row * 2048 + cb + 128 * bj) = pack8(silu4(acc[ai][bj][m][0]), silu4(acc[ai][bj][m][1]));
                }
        }
    }
};
struct EpiDiffIn {
    static constexpr bool PERM = true, AFTER_DRAIN = false;
    bf16_t *Q, *K, *VT; float qscale;
    __device__ __forceinline__ void operator()(const f32x4 (&acc)[2][2][4][2], const Unit& u, int wr, int wc, int fr, int fq) const {
        const int pn = u.pn, jb = wc * 32 + 8 * fq, rowb = u.pm * BM + wr * 64 + fr;
        if (pn < 8) {
            bf16_t* dst = pn < 4 ? Q : K; const float sc = pn < 4 ? qscale : 1.0f; const int cb = (pn & 3) * 256 + jb;
#pragma unroll
            for (int ai = 0; ai < 2; ++ai)
#pragma unroll
                for (int m = 0; m < 4; ++m) {
                    const int row = rowb + ai * HALF + m * 16;
#pragma unroll
                    for (int bj = 0; bj < 2; ++bj) *(u32x4*)(dst + (size_t)row * 1024 + cb + 128 * bj) = pack8(acc[ai][bj][m][0] * sc, acc[ai][bj][m][1] * sc);
                }
        } else {
#pragma unroll
            for (int ai = 0; ai < 2; ++ai)
#pragma unroll
                for (int m = 0; m < 4; ++m) {
                    const int row = rowb + ai * HALF + m * 16, b = row >> 13, s = row & (SEQ_ - 1);
#pragma unroll
                    for (int bj = 0; bj < 2; ++bj) { const int h = (pn - 8) * 2 + bj;
#pragma unroll
                        for (int n = 0; n < 2; ++n)
#pragma unroll
                            for (int i = 0; i < 4; ++i) { const int e = jb + 4 * n + i; VT[((size_t)((b * 8 + h) * 128 + e)) * SEQ_ + s] = f2bf1(acc[ai][bj][m][n][i]); } }
                }
        }
    }
};
struct EpiSwiGLU {
    static constexpr bool PERM = true, AFTER_DRAIN = false;
    bf16_t* ACT;
    __device__ __forceinline__ void operator()(const f32x4 (&acc)[2][2][4][2], const Unit& u, int wr, int wc, int fr, int fq) const {
        const int cb = u.pn * 128 + wc * 32 + 8 * fq, rowb = u.pm * BM + wr * 64 + fr;
#pragma unroll
        for (int ai = 0; ai < 2; ++ai)
#pragma unroll
            for (int m = 0; m < 4; ++m) {
                const int row = rowb + ai * HALF + m * 16;
                *(u32x4*)(ACT + (size_t)row * 2816 + cb) = pack8(silu4(acc[ai][0][m][0]) * acc[ai][1][m][0], silu4(acc[ai][0][m][1]) * acc[ai][1][m][1]);
            }
    }
};
struct EpiNormResNorm {
    static constexpr bool PERM = false, AFTER_DRAIN = true;
    const float* base; float* out; bf16_t* xn; const float* g1; const float* g2;
    float* xbuf;
    unsigned* cnt;
    float eps; int dry;
    __device__ __forceinline__ void fused(f32x4 (&acc)[2][2][4][2], const Unit& u, int wr, int wc, int fr, int fq, PG8_LAS unsigned char* lds, int wid, int lane) const {
        typedef float f32x2v __attribute__((ext_vector_type(2)));
        PG8_LAS f32x4* P = (PG8_LAS f32x4*)lds;
        PG8_LAS f32x2v* S = (PG8_LAS f32x2v*)(lds + 16384);
        const int col0 = u.pn * BM + wc * 32 + 4 * fq;
        f32x4 gv[2][2];
#pragma unroll
        for (int bj = 0; bj < 2; ++bj)
#pragma unroll
            for (int n = 0; n < 2; ++n) gv[bj][n] = *(const f32x4*)(g1 + col0 + bj * HALF + n * 16);
#pragma unroll
        for (int ai = 0; ai < 2; ++ai)
#pragma unroll
            for (int m = 0; m < 4; ++m) { const int r = ai * HALF + wr * 64 + m * 16 + fr; const size_t off = (size_t)(u.pm * BM + r) * 1024 + col0;
                float s0 = 0.f, s1 = 0.f, s2 = 0.f, s3 = 0.f;
#pragma unroll
                for (int bj = 0; bj < 2; ++bj)
#pragma unroll
                    for (int n = 0; n < 2; ++n) { const f32x4 bs = *(const f32x4*)(base + off + bj * HALF + n * 16), a = acc[ai][bj][m][n], ag = a * gv[bj][n];
                        s0 += (a[0] * a[0] + a[1] * a[1]) + (a[2] * a[2] + a[3] * a[3]); s1 += (bs[0] * bs[0] + bs[1] * bs[1]) + (bs[2] * bs[2] + bs[3] * bs[3]);
                        s2 += (bs[0] * ag[0] + bs[1] * ag[1]) + (bs[2] * ag[2] + bs[3] * ag[3]); s3 += (ag[0] * ag[0] + ag[1] * ag[1]) + (ag[2] * ag[2] + ag[3] * ag[3]); }
                s0 += __shfl_xor(s0, 16); s0 += __shfl_xor(s0, 32); s1 += __shfl_xor(s1, 16); s1 += __shfl_xor(s1, 32);
                s2 += __shfl_xor(s2, 16); s2 += __shfl_xor(s2, 32); s3 += __shfl_xor(s3, 16); s3 += __shfl_xor(s3, 32);
                if (fq == 0) P[r * 4 + wc] = (f32x4){s0, s1, s2, s3};
                if (m & 1) asm volatile("" ::: "memory"); }
        asm volatile("s_waitcnt lgkmcnt(0)" ::: "memory"); __builtin_amdgcn_s_barrier(); asm volatile("" ::: "memory");
        const int row = wid * 32 + (lane & 31);
        if (lane < 32) {
            const f32x4 t = (P[row * 4 + 0] + P[row * 4 + 1]) + (P[row * 4 + 2] + P[row * 4 + 3]);
            float* slot = xbuf + ((size_t)(u.pm * BM + row) * 4 + u.pn);
#pragma unroll
            for (int c = 0; c < 4; ++c) __hip_atomic_store(slot + (size_t)c * 16384 * 4, t[c], __ATOMIC_RELAXED, __HIP_MEMORY_SCOPE_AGENT);
        }
        asm volatile("s_waitcnt vmcnt(0)" ::: "memory");
        if (lane == 0) __hip_atomic_fetch_add(cnt + 64 * u.pm, 1u, __ATOMIC_RELAXED, __HIP_MEMORY_SCOPE_AGENT);
        if (wid == 0) {
            unsigned spins = 0;
            for (;;) {
                if ((unsigned)__builtin_amdgcn_readfirstlane(__hip_atomic_load(cnt + 64 * u.pm, __ATOMIC_RELAXED, __HIP_MEMORY_SCOPE_AGENT)) >= 32u) break;
                if (++spins > (1u << 24)) break;
                __builtin_amdgcn_s_sleep(1);
            }
            __builtin_amdgcn_fence(__ATOMIC_ACQUIRE, "agent");
        }
        asm volatile("s_waitcnt vmcnt(0) lgkmcnt(0)" ::: "memory"); __builtin_amdgcn_s_barrier(); asm volatile("" ::: "memory");
        if (lane < 32) {
            const float* slot = xbuf + (size_t)(u.pm * BM + row) * 4; float q[4];
#pragma unroll
            for (int c = 0; c < 4; ++c) { float v = 0.f;
#pragma unroll
                for (int t = 0; t < 4; ++t) v += __hip_atomic_load(slot + (size_t)c * 16384 * 4 + t, __ATOMIC_RELAXED, __HIP_MEMORY_SCOPE_AGENT);
                q[c] = v; }
            const float r1 = 1.0f / sqrtf(q[0] * (1.0f / 1024.0f) + eps);
            const float ss2 = q[1] + 2.0f * r1 * q[2] + r1 * r1 * q[3];
            S[row] = (f32x2v){r1, 1.0f / sqrtf(fmaxf(ss2, 0.f) * (1.0f / 1024.0f) + eps)};
        }
        asm volatile("s_waitcnt lgkmcnt(0)" ::: "memory"); __builtin_amdgcn_s_barrier(); asm volatile("" ::: "memory");
        f32x4 g2v[2][2];
#pragma unroll
        for (int bj = 0; bj < 2; ++bj)
#pragma unroll
            for (int n = 0; n < 2; ++n) g2v[bj][n] = *(const f32x4*)(g2 + col0 + bj * HALF + n * 16);
#pragma unroll
        for (int ai = 0; ai < 2; ++ai)
#pragma unroll
            for (int m = 0; m < 4; ++m) { const int r = ai * HALF + wr * 64 + m * 16 + fr; const f32x2v sr = S[r]; const size_t off = (size_t)(u.pm * BM + r) * 1024 + col0;
#pragma unroll
                for (int bj = 0; bj < 2; ++bj)
#pragma unroll
                    for (int n = 0; n < 2; ++n) { const f32x4 bs = *(const f32x4*)(base + off + bj * HALF + n * 16); const f32x4 x1 = bs + acc[ai][bj][m][n] * sr.x * gv[bj][n];
                        const f32x4 o = x1 * sr.y * g2v[bj][n]; u32x2 w; w.x = cvt_pk_bf16(o[0], o[1]); w.y = cvt_pk_bf16(o[2], o[3]);
                        if (!dry || x1[0] == 1.2345e38f) { *(f32x4*)(out + off + bj * HALF + n * 16) = x1; *(u32x2*)(xn + off + bj * HALF + n * 16) = w; } }
                if (m & 1) asm volatile("" ::: "memory"); }
    }
};

struct EpiNull {
    static constexpr bool PERM = false, AFTER_DRAIN = true;
    float* sink;
    __device__ __forceinline__ void fused(f32x4 (&acc)[2][2][4][2], const Unit& u, int wr, int wc, int fr, int fq, PG8_LAS unsigned char* lds, int wid, int lane) const {
        float t = 0.f;
#pragma unroll
        for (int ai = 0; ai < 2; ++ai)
#pragma unroll
            for (int bj = 0; bj < 2; ++bj)
#pragma unroll
                for (int m = 0; m < 4; ++m)
#pragma unroll
                    for (int n = 0; n < 2; ++n) t += (acc[ai][bj][m][n][0] + acc[ai][bj][m][n][1]) + (acc[ai][bj][m][n][2] + acc[ai][bj][m][n][3]);
        if (t == 1.2345e38f) sink[0] = t;
    }
};
template <class Epi, class Sched, bool ALIGN_EPI = false, bool SP2 = false>
__device__ __forceinline__ void gemm_phase(PG8_LAS unsigned char* lds, const Gemm g, const Sched& S, const Epi& E) {
    int tid_ = threadIdx.x; asm volatile("" : "+v"(tid_)); const int tid = tid_, wid = __builtin_amdgcn_readfirstlane(tid >> 6), lane = tid & 63, wr = wid >> 2, wc = wid & 3, fr = lane & 15, fq = lane >> 4;
    const int K = g.K, nt = K / BK;
    unsigned voffA[2], voffB[2];
#pragma unroll
    for (int i = 0; i < 2; ++i) { int R, C; stage_rc(tid * 16 + i * 8192, R, C); const int Rb = Epi::PERM ? ((R & ~31) + perm32(R & 31)) : R;
        voffA[i] = (unsigned)(R * K + C) * 2u; voffB[i] = (unsigned)(Rb * K + C) * 2u; }
    const size_t kstep = (size_t)(BK * 2);
    const size_t hstep = (size_t)HALF * K * 2;
    const size_t tstep = 2 * hstep;
    const unsigned ldsw = (unsigned)wid * 1024u;
    const int aoff = lds_byte(wr * 64 + fr, fq * 8), boff = lds_byte(wc * 32 + fr, fq * 8);
#define PG8_SA(b, h) (((b) * 2 + (h)) * HTB)
#define PG8_SB(b, h) ((4 + (b) * 2 + (h)) * HTB)
#define PG8_STAGE(bufoff, gbase, voff) do { _Pragma("unroll") for (int _i = 0; _i < 2; ++_i) \
        __builtin_amdgcn_global_load_lds((const unsigned*)((const char*)(gbase) + (voff)[_i]), (PG8_LAS unsigned*)(lds + (bufoff) + ldsw + _i * 8192), 16, 0, 0); } while (0)
#define PG8_LDA(dst, b, h) do { _Pragma("unroll") for (int m = 0; m < 4; ++m) _Pragma("unroll") for (int k = 0; k < 2; ++k) dst[m][k] = *(const PG8_LAS bf16x8*)(lds + PG8_SA(b, h) + aoff + m * 2048 + k * 1024); } while (0)
#define PG8_LDB(dst, b, h) do { _Pragma("unroll") for (int n = 0; n < 2; ++n) _Pragma("unroll") for (int k = 0; k < 2; ++k) dst[n][k] = *(const PG8_LAS bf16x8*)(lds + PG8_SB(b, h) + boff + n * 2048 + k * 1024); } while (0)
#define PG8_MMA(ai, bj, At, Bt) do { __builtin_amdgcn_s_setprio(1); _Pragma("unroll") for (int m = 0; m < 4; ++m) _Pragma("unroll") for (int n = 0; n < 2; ++n) _Pragma("unroll") for (int k = 0; k < 2; ++k) \
        acc[ai][bj][m][n] = __builtin_amdgcn_mfma_f32_16x16x32_bf16(Bt[n][k], At[m][k], acc[ai][bj][m][n], 0, 0, 0); __builtin_amdgcn_s_setprio(0); } while (0)
#define PG8_WAIT_V(n) asm volatile("s_waitcnt vmcnt(" #n ")" ::: "memory")
#define PG8_WAIT_L(n) asm volatile("s_waitcnt lgkmcnt(" #n ")" ::: "memory")
#define PG8_BAR __builtin_amdgcn_s_barrier()
#define PG8_SCHED __builtin_amdgcn_sched_barrier(0)
    Unit cur, nxt; int ui = 0;
    if (!S.next(0, cur)) return;
    f32x4 acc[2][2][4][2];
#pragma unroll
    for (int a = 0; a < 2; ++a)
#pragma unroll
        for (int b = 0; b < 2; ++b)
#pragma unroll
            for (int m = 0; m < 4; ++m)
#pragma unroll
                for (int n = 0; n < 2; ++n) acc[a][b][m][n] = (f32x4){0.f, 0.f, 0.f, 0.f};
    bf16x8 At[4][2], B0[2][2], B1[2][2];
    const char* cA = (const char*)g.A + (size_t)cur.pm * tstep; const char* cB = (const char*)g.Bt + (size_t)cur.pn * tstep;
    S.a_ready(cur);
    if constexpr (SP2) {
        PG8_STAGE(PG8_SB(0, 0), cB, voffB); PG8_STAGE(PG8_SB(0, 1), cB + hstep, voffB); PG8_STAGE(PG8_SA(0, 0), cA, voffA); PG8_STAGE(PG8_SA(0, 1), cA + hstep, voffA);
        if (wr == 1) PG8_BAR;
        PG8_WAIT_V(2); PG8_BAR;
        PG8_STAGE(PG8_SB(1, 0), cB + kstep, voffB); PG8_STAGE(PG8_SA(1, 0), cA + kstep, voffA); PG8_STAGE(PG8_SB(1, 1), cB + hstep + kstep, voffB);
        PG8_WAIT_V(6); PG8_BAR;
    } else {
        PG8_STAGE(PG8_SB(0, 0), cB, voffB); PG8_STAGE(PG8_SA(0, 0), cA, voffA); PG8_STAGE(PG8_SB(0, 1), cB + hstep, voffB); PG8_STAGE(PG8_SA(0, 1), cA + hstep, voffA);
        if (wr == 1) PG8_BAR;
        PG8_WAIT_V(4); PG8_BAR;
        PG8_STAGE(PG8_SB(1, 0), cB + kstep, voffB); PG8_STAGE(PG8_SA(1, 0), cA + kstep, voffA); PG8_STAGE(PG8_SB(1, 1), cB + hstep + kstep, voffB);
        PG8_WAIT_V(6); PG8_BAR;
    }
    for (;;) {
        const bool has_next = S.next(ui + 1, nxt);
        const char* nA = has_next ? (const char*)g.A + (size_t)nxt.pm * tstep : cA; const char* nB = has_next ? (const char*)g.Bt + (size_t)nxt.pn * tstep : cB;
        for (int t = 0; t < nt; t += 2) {
            const bool last = (t == nt - 2);
            const char* a1 = cA + (size_t)(t + 1) * kstep;
            const char* a2 = last ? nA : cA + (size_t)(t + 2) * kstep; const char* b2 = last ? nB : cB + (size_t)(t + 2) * kstep;
            const char* a3 = a2 + kstep; const char* b3 = b2 + kstep;
            if (last && has_next) S.a_ready(nxt);
            if constexpr (SP2) {
            PG8_LDB(B0, 0, 0); PG8_LDB(B1, 0, 1); PG8_SCHED; PG8_LDA(At, 0, 0); PG8_STAGE(PG8_SA(1, 1), a1 + hstep, voffA);
            PG8_WAIT_V(8); PG8_WAIT_L(0); PG8_BAR; PG8_MMA(0, 0, At, B0); PG8_MMA(0, 1, At, B1); PG8_BAR; PG8_SCHED;
            PG8_LDA(At, 0, 1); PG8_STAGE(PG8_SB(0, 0), b2, voffB); PG8_STAGE(PG8_SB(0, 1), b2 + hstep, voffB); PG8_STAGE(PG8_SA(0, 0), a2, voffA);
            PG8_WAIT_V(8); PG8_WAIT_L(0); PG8_BAR; PG8_MMA(1, 0, At, B0); PG8_MMA(1, 1, At, B1); PG8_BAR; PG8_SCHED;
            PG8_LDB(B0, 1, 0); PG8_LDB(B1, 1, 1); PG8_SCHED; PG8_LDA(At, 1, 0); PG8_STAGE(PG8_SA(0, 1), a2 + hstep, voffA);
            PG8_WAIT_V(8); PG8_WAIT_L(0); PG8_BAR; PG8_MMA(0, 0, At, B0); PG8_MMA(0, 1, At, B1); PG8_BAR; PG8_SCHED;
            PG8_LDA(At, 1, 1); PG8_STAGE(PG8_SB(1, 0), b3, voffB); PG8_STAGE(PG8_SB(1, 1), b3 + hstep, voffB); PG8_STAGE(PG8_SA(1, 0), a3, voffA);
            PG8_WAIT_V(8); PG8_WAIT_L(0); PG8_BAR; PG8_MMA(1, 0, At, B0); PG8_MMA(1, 1, At, B1); PG8_BAR; PG8_SCHED;
            } else {
            PG8_LDB(B0, 0, 0); PG8_SCHED; PG8_LDA(At, 0, 0); PG8_STAGE(PG8_SA(1, 1), a1 + hstep, voffA);
            PG8_WAIT_L(8); PG8_BAR; PG8_WAIT_L(0); PG8_MMA(0, 0, At, B0); PG8_BAR; PG8_SCHED;
            PG8_LDB(B1, 0, 1); PG8_STAGE(PG8_SB(0, 0), b2, voffB);
            PG8_BAR; PG8_WAIT_L(0); PG8_MMA(0, 1, At, B1); PG8_BAR;
            PG8_LDA(At, 0, 1); PG8_STAGE(PG8_SA(0, 0), a2, voffA);
            PG8_BAR; PG8_WAIT_L(0); PG8_MMA(1, 0, At, B0); PG8_BAR; PG8_SCHED;
            PG8_STAGE(PG8_SB(0, 1), b2 + hstep, voffB);
            PG8_WAIT_V(6); PG8_BAR; PG8_MMA(1, 1, At, B1); PG8_BAR;
            PG8_LDB(B0, 1, 0); PG8_SCHED; PG8_LDA(At, 1, 0); PG8_STAGE(PG8_SA(0, 1), a2 + hstep, voffA);
            PG8_WAIT_L(8); PG8_BAR; PG8_WAIT_L(0); PG8_MMA(0, 0, At, B0); PG8_BAR; PG8_SCHED;
            PG8_LDB(B1, 1, 1); PG8_STAGE(PG8_SB(1, 0), b3, voffB);
            PG8_BAR; PG8_WAIT_L(0); PG8_MMA(0, 1, At, B1); PG8_BAR;
            PG8_LDA(At, 1, 1); PG8_STAGE(PG8_SA(1, 0), a3, voffA);
            PG8_BAR; PG8_WAIT_L(0); PG8_MMA(1, 0, At, B0); PG8_BAR; PG8_SCHED;
            PG8_STAGE(PG8_SB(1, 1), b3 + hstep, voffB);
            PG8_WAIT_V(6); PG8_BAR; PG8_MMA(1, 1, At, B1); PG8_BAR;
            }
        }
        if constexpr (ALIGN_EPI) { if (wr == 0) PG8_BAR; }
        if constexpr (!Epi::AFTER_DRAIN) { E(acc, cur, wr, wc, fr, fq); S.done(cur); }
        if (!has_next) break;
#pragma unroll
        for (int a = 0; a < 2; ++a)
#pragma unroll
            for (int b = 0; b < 2; ++b)
#pragma unroll
                for (int m = 0; m < 4; ++m)
#pragma unroll
                    for (int n = 0; n < 2; ++n) acc[a][b][m][n] = (f32x4){0.f, 0.f, 0.f, 0.f};
        cur = nxt; cA = nA; cB = nB; ++ui;
        if constexpr (ALIGN_EPI) { if (wr == 1) PG8_BAR; }
    }
    PG8_WAIT_V(0);
    if constexpr (!ALIGN_EPI) { if (wr == 0) PG8_BAR; }
    PG8_BAR;
    if constexpr (Epi::AFTER_DRAIN) { E.fused(acc, cur, wr, wc, fr, fq, lds, wid, lane); S.done(cur); }
#undef PG8_SA
#undef PG8_SB
#undef PG8_STAGE
#undef PG8_LDA
#undef PG8_LDB
#undef PG8_MMA
#undef PG8_WAIT_V
#undef PG8_WAIT_L
#undef PG8_BAR
#undef PG8_SCHED
}
}
#ifndef R2_SKIP
#define R2_SKIP 0
#endif
#ifndef PROBE_DUP
#define PROBE_DUP 0
#endif

#define LAS __attribute__((address_space(3)))
typedef unsigned short bf16;
typedef unsigned v4u __attribute__((ext_vector_type(4)));
typedef float f32x4 __attribute__((ext_vector_type(4)));
using pg8::bf2f; using pg8::f2bf1;
constexpr int NWAVES = 8, NTHR = 512, GRID = 256;
constexpr int SEQ = 8192, D = 1024, M = 2 * SEQ, FF = 2816, DEPTH = 4;
constexpr int RET_IN = 6144, DIFF_IN = 3072;
constexpr float RMS_EPS = 1e-6f;
constexpr float LOG2E = 1.4426950408889634f;
constexpr size_t MiB = 1u << 20;
constexpr size_t WS_CTL = 0, CTL_ZERO_BYTES = 1 * MiB;
constexpr size_t WS_TAB = 640 * 1024;
constexpr size_t WS_X = 1 * MiB;
constexpr size_t WS_WIN = 2 * MiB, WS_WOUT = 14 * MiB, WS_WGU = 18 * MiB, WS_WDN = 29 * MiB;
constexpr size_t WS_Q = 35 * MiB, WS_K = 67 * MiB, WS_VT = 99 * MiB, WS_G = 163 * MiB, WS_ST = 227 * MiB, WS_END = 291 * MiB;
constexpr size_t WS_XN = WS_ST, WS_ACT = WS_K;
constexpr int CW_BAR = 131072;
constexpr int CW_CNT = 1024;
constexpr int LDS_BYTES = 147456;
#ifndef MFMA_SCAN
#define MFMA_SCAN 1
#endif
#ifndef MFMA_ROUT
#define MFMA_ROUT 1
#endif
#ifndef MFMA_ATTN
#define MFMA_ATTN 1
#endif
#ifndef PER_PHASE_LAUNCH
#define PER_PHASE_LAUNCH 1
#endif
#ifndef NAIVE_MIXERS
#define NAIVE_MIXERS 0
#endif

struct Args { const float* in[12]; float* out; unsigned char* ws; };

__device__ __forceinline__ unsigned pk2(float lo, float hi) { return (unsigned)f2bf1(lo) | ((unsigned)f2bf1(hi) << 16); }
__device__ __forceinline__ float wave_sum(float v) {
#pragma unroll
    for (int o = 1; o < 64; o <<= 1) v += __shfl_xor(v, o);
    return v;
}
__device__ __forceinline__ float dot8(v4u a, v4u b) {
    float s = 0.f;
#pragma unroll
    for (int i = 0; i < 4; ++i) { s += __uint_as_float(a[i] << 16) * __uint_as_float(b[i] << 16); s += __uint_as_float(a[i] & 0xffff0000u) * __uint_as_float(b[i] & 0xffff0000u); }
    return s;
}
struct TrItem { const float* W; int Nsrc, K, k0, c0, r0; };
__device__ __forceinline__ void tr_load(float (&v)[32], const TrItem& t, int lane) {
#pragma unroll
    for (int i = 0; i < 32; ++i) { const int kk = 2 * i + (lane >> 5); v[i] = t.W[(size_t)(t.k0 + kk) * t.Nsrc + t.c0 + (lane & 31)]; }
}
__device__ __forceinline__ void tr_finish(const float (&v)[32], const TrItem& t, bf16* WT, LAS float* scr, int lane) {
#pragma unroll
    for (int i = 0; i < 32; ++i) { const int kk = 2 * i + (lane >> 5); scr[kk * 33 + (lane & 31)] = v[i]; }
    asm volatile("s_waitcnt lgkmcnt(0)" ::: "memory");
    const int c = lane & 7;
#pragma unroll
    for (int j = 0; j < 4; ++j) { const int n = (lane >> 3) + 8 * j; const LAS float* s = scr + (8 * c) * 33 + n;
        v4u o; o.x = pk2(s[0 * 33], s[1 * 33]); o.y = pk2(s[2 * 33], s[3 * 33]); o.z = pk2(s[4 * 33], s[5 * 33]); o.w = pk2(s[6 * 33], s[7 * 33]);
        *(v4u*)(WT + (size_t)(t.r0 + n) * t.K + t.k0 + 8 * c) = o; }
    asm volatile("s_waitcnt lgkmcnt(0)" ::: "memory");
}
__device__ __forceinline__ TrItem item_plain(const float* W, int K, int N, int it) { const int nblk = N / 32, kb = it / nblk, nb = it % nblk; return TrItem{W, N, K, 64 * kb, 32 * nb, 32 * nb}; }
__device__ __forceinline__ TrItem item_gu(const float* Wg, const float* Wu, int it) { const int nblk = FF / 32, nit = (D / 64) * nblk, which = it >= nit, r = which ? it - nit : it, kb = r / nblk, nb = r % nblk, c0 = 32 * nb;
    return TrItem{which ? Wu : Wg, FF, D, 64 * kb, c0, 256 * (c0 >> 7) + 128 * which + (c0 & 127)}; }
#define CONV_LOOP(NIT, ITEM, WT) do { const int nit_ = (NIT); float va_[32], vb_[32]; int it_ = gw; \
        if (it_ < nit_) { const TrItem ta_ = ITEM(it_); tr_load(va_, ta_, lane); } \
        while (it_ < nit_) { \
            { const TrItem ta_ = ITEM(it_); const int nx_ = it_ + ngw; if (nx_ < nit_) { const TrItem tb_ = ITEM(nx_); tr_load(vb_, tb_, lane); } tr_finish(va_, ta_, (WT), scr, lane); it_ = nx_; } \
            if (it_ >= nit_) break; \
            { const TrItem tb_ = ITEM(it_); const int nx_ = it_ + ngw; if (nx_ < nit_) { const TrItem ta_ = ITEM(nx_); tr_load(va_, ta_, lane); } tr_finish(vb_, tb_, (WT), scr, lane); it_ = nx_; } \
        } } while (0)
__device__ __forceinline__ void conv_plain(const float* W, int K, int N, bf16* WT, LAS float* scr, int gw, int ngw, int lane) {
#define ITEM_(i) item_plain(W, K, N, (i))
    for (int rep_ = 0; rep_ < ((PROBE_DUP & 256) ? 2 : 1); ++rep_) CONV_LOOP((K / 64) * (N / 32), ITEM_, WT);
#undef ITEM_
}
__device__ __forceinline__ void conv_gu(const float* Wg, const float* Wu, bf16* WT, LAS float* scr, int gw, int ngw, int lane) {
#define ITEM_(i) item_gu(Wg, Wu, (i))
    for (int rep_ = 0; rep_ < ((PROBE_DUP & 256) ? 2 : 1); ++rep_) CONV_LOOP(2 * (D / 64) * (FF / 32), ITEM_, WT);
#undef ITEM_
}
__device__ __forceinline__ void rms_row_to_bf16(const float* xrow, const float* g, bf16* orow, int lane) {
    const f32x4* xr = (const f32x4*)xrow + lane; const f32x4* gr = (const f32x4*)g + lane;
    f32x4 v[4]; float s2 = 0.f;
#pragma unroll
    for (int j = 0; j < 4; ++j) { v[j] = xr[64 * j]; s2 += (v[j].x * v[j].x + v[j].y * v[j].y) + (v[j].z * v[j].z + v[j].w * v[j].w); }
    const float rstd = 1.f / sqrtf(wave_sum(s2) * (1.f / D) + RMS_EPS);
    unsigned long long* o8 = (unsigned long long*)orow + lane;
#pragma unroll
    for (int j = 0; j < 4; ++j) { const f32x4 gg = gr[64 * j]; o8[64 * j] = (unsigned long long)pk2(v[j].x * rstd * gg.x, v[j].y * rstd * gg.y) | ((unsigned long long)pk2(v[j].z * rstd * gg.z, v[j].w * rstd * gg.w) << 32); }
}

__device__ __forceinline__ float head_log2_gamma(int h) { return __builtin_log2f(1.0f - __builtin_exp2f(-5.0f - (float)h)); }
__device__ __forceinline__ void ret_scan_naive(const bf16* K, const bf16* VT, bf16* ST) {
    const int gid = blockIdx.x * NTHR + threadIdx.x;
    const int bh = gid >> 14, rem = gid & 16383, e = rem >> 5, d0 = (rem & 31) * 8;
    const float lg2 = head_log2_gamma(bh & 3), cd = __builtin_exp2f(256.f * lg2);
    float st[8];
#pragma unroll
    for (int j = 0; j < 8; ++j) st[j] = 0.f;
    const bf16* vt = VT + ((size_t)(bh * 512 + e)) * SEQ; const bf16* kp = K + (size_t)bh * SEQ * 256 + d0;
    for (int c2 = 0; c2 < 32; ++c2) {
        v4u o; o.x = pk2(st[0], st[1]); o.y = pk2(st[2], st[3]); o.z = pk2(st[4], st[5]); o.w = pk2(st[6], st[7]);
        *(v4u*)(ST + (((size_t)(bh * 32 + c2)) * 512 + e) * 256 + d0) = o;
#pragma unroll
        for (int j = 0; j < 8; ++j) st[j] *= cd;
        for (int m = 0; m < 256; ++m) { const int t = c2 * 256 + m; const float v = bf2f(vt[t]) * __builtin_exp2f((float)(255 - m) * lg2);
            const v4u kk = *(const v4u*)(kp + (size_t)t * 256);
#pragma unroll
            for (int i = 0; i < 4; ++i) { st[2 * i] += v * __uint_as_float(kk[i] << 16); st[2 * i + 1] += v * __uint_as_float(kk[i] & 0xffff0000u); } }
    }
}
__device__ __forceinline__ void ret_out_naive(LAS unsigned char* lds, const bf16* Q, const bf16* K, const bf16* VT, bf16* GY, const bf16* ST) {
    LAS bf16* Qs = (LAS bf16*)lds; LAS bf16* In = (LAS bf16*)(lds + 128 * 264 * 2); LAS float* ss = (LAS float*)(lds + 2 * 128 * 264 * 2);
    const int tid = threadIdx.x;
    for (int task = blockIdx.x; task < 512; task += gridDim.x) {
        const int bh = task >> 6, c = task & 63, h = bh & 3, odd = c & 1, nk = odd ? 256 : 128, sh = odd ? 8 : 7, tk0 = (c & ~1) * 128, tq0 = c * 128;
        const float lg2 = head_log2_gamma(h);
        __syncthreads();
#pragma unroll
        for (int i = 0; i < 8; ++i) { const int ch = tid + NTHR * i, r = ch >> 5, cc = ch & 31; *(LAS v4u*)(Qs + r * 264 + cc * 8) = *(const v4u*)(Q + ((size_t)(bh * SEQ + tq0 + r)) * 256 + cc * 8); }
        __syncthreads();
        for (int idx = tid; idx < 128 * nk; idx += NTHR) { const int n = idx >> sh, m = idx & (nk - 1), dist = (tq0 + n) - (tk0 + m); float val = 0.f;
            if (dist >= 0) { const bf16* kp = K + ((size_t)(bh * SEQ + tk0 + m)) * 256; float dot = 0.f;
                for (int d8 = 0; d8 < 32; ++d8) dot += dot8(*(const v4u*)(kp + d8 * 8), *(const LAS v4u*)(Qs + n * 264 + d8 * 8));
                val = dot * __builtin_exp2f((float)dist * lg2); }
            In[n * 264 + m] = f2bf1(val); }
        __syncthreads();
        const int n = tid & 127, eq = tid >> 7; const float qdec = __builtin_exp2f((float)(n + 1 + odd * 128) * lg2); float ssq = 0.f;
        const size_t grow = ((size_t)((bh >> 2) * SEQ + tq0 + n)) * 2048 + h * 512;
        for (int ee = 0; ee < 128; ++ee) { const int e = eq * 128 + ee;
            const bf16* vt = VT + ((size_t)(bh * 512 + e)) * SEQ + tk0; float a = 0.f;
            for (int m8 = 0; m8 < nk / 8; ++m8) a += dot8(*(const v4u*)(vt + m8 * 8), *(const LAS v4u*)(In + n * 264 + m8 * 8));
            const bf16* sp = ST + (((size_t)(bh * 32 + (c >> 1))) * 512 + e) * 256; float cr = 0.f;
            for (int d8 = 0; d8 < 32; ++d8) cr += dot8(*(const v4u*)(sp + d8 * 8), *(const LAS v4u*)(Qs + n * 264 + d8 * 8));
            a += qdec * cr; ssq += a * a;
            GY[grow + e] = f2bf1(a * bf2f(GY[grow + e])); }
        ss[eq * 128 + n] = ssq;
        __syncthreads();
        const float rstd = 1.0f / sqrtf(((ss[n] + ss[128 + n]) + (ss[256 + n] + ss[384 + n])) * (1.0f / 512.0f) + RMS_EPS);
        for (int ee = 0; ee < 128; ++ee) { const int e = eq * 128 + ee; GY[grow + e] = f2bf1(bf2f(GY[grow + e]) * rstd); }
    }
}
__device__ __forceinline__ void attn_naive(LAS unsigned char* lds, const bf16* Qd, const bf16* Kd, const bf16* VTd, bf16* Od, const float* lut, float lam, const float* subln, float outscale) {
    LAS float* ss = (LAS float*)lds; LAS bf16* Qs = (LAS bf16*)(lds + 2048);
    const int tid = threadIdx.x, lane = tid & 63, eg = tid >> 6;
    const int w = blockIdx.x, bh = w & 15, g = w >> 4, b = bh >> 3, h = bh & 7;
    for (int ui = 0; ui < 8; ++ui) {
        const int pr = ui >> 1, qb = (ui & 1) ? (32 * pr + 31 - g) : (32 * pr + g);
        const int q = qb * 64 + lane; const size_t qrow = (size_t)(b * SEQ + q);
        __syncthreads();
        if (eg == 0) {
#pragma unroll
            for (int i = 0; i < 16; ++i) *(LAS v4u*)(Qs + lane * 136 + i * 8) = *(const v4u*)(Qd + qrow * 1024 + h * 128 + i * 8);
        }
        __syncthreads();
        const LAS bf16* qv = Qs + lane * 136;
        float o1[16], o2[16], m1 = -1e30f, m2 = -1e30f, l1 = 0.f, l2 = 0.f;
#pragma unroll
        for (int j = 0; j < 16; ++j) { o1[j] = 0.f; o2[j] = 0.f; }
        const int kend = qb * 64 + 64;
        for (int k0 = 0; k0 < kend; k0 += 8) {
            float s1[8], s2[8];
#pragma unroll
            for (int kk = 0; kk < 8; ++kk) { const int key = k0 + kk; const bf16* kp = Kd + ((size_t)(b * SEQ + key)) * 1024 + h * 128; float d1 = 0.f, d2 = 0.f;
#pragma unroll
                for (int i = 0; i < 8; ++i) { d1 += dot8(*(const LAS v4u*)(qv + i * 8), *(const v4u*)(kp + i * 8)); d2 += dot8(*(const LAS v4u*)(qv + 64 + i * 8), *(const v4u*)(kp + 64 + i * 8)); }
                const int rel = q - key; const int idx = rel < 0 ? 0 : (rel > 127 ? 127 : rel); const float bias = lut[h * 128 + idx];
                s1[kk] = rel >= 0 ? d1 + bias : -1e30f; s2[kk] = rel >= 0 ? d2 + bias : -1e30f; asm volatile("" ::: "memory"); }
            float mx1 = m1, mx2 = m2;
#pragma unroll
            for (int kk = 0; kk < 8; ++kk) { mx1 = fmaxf(mx1, s1[kk]); mx2 = fmaxf(mx2, s2[kk]); }
            const float f1 = __builtin_amdgcn_exp2f(m1 - mx1), f2 = __builtin_amdgcn_exp2f(m2 - mx2); m1 = mx1; m2 = mx2; l1 *= f1; l2 *= f2;
#pragma unroll
            for (int j = 0; j < 16; ++j) { o1[j] *= f1; o2[j] *= f2; }
#pragma unroll
            for (int kk = 0; kk < 8; ++kk) { s1[kk] = __builtin_amdgcn_exp2f(s1[kk] - mx1); s2[kk] = __builtin_amdgcn_exp2f(s2[kk] - mx2); l1 += s1[kk]; l2 += s2[kk]; }
#pragma unroll
            for (int j = 0; j < 16; ++j) { const v4u vv = *(const v4u*)(VTd + ((size_t)(bh * 128 + eg * 16 + j)) * SEQ + k0);
#pragma unroll
                for (int i = 0; i < 4; ++i) { const float vl = __uint_as_float(vv[i] << 16), vh = __uint_as_float(vv[i] & 0xffff0000u);
                    o1[j] += s1[2 * i] * vl + s1[2 * i + 1] * vh; o2[j] += s2[2 * i] * vl + s2[2 * i + 1] * vh; } }
        }
        float ssq = 0.f; const float r1 = 1.0f / l1, r2 = lam / l2;
#pragma unroll
        for (int j = 0; j < 16; ++j) { o1[j] = o1[j] * r1 - o2[j] * r2; ssq += o1[j] * o1[j]; }
        __syncthreads();
        ss[eg * 64 + lane] = ssq;
        __syncthreads();
        float sst = 0.f;
#pragma unroll
        for (int i = 0; i < 8; ++i) sst += ss[i * 64 + lane];
        const float rstd = outscale / sqrtf(sst * (1.0f / 128.0f) + RMS_EPS);
#pragma unroll
        for (int j = 0; j < 16; ++j) Od[qrow * 1024 + h * 128 + eg * 16 + j] = f2bf1(o1[j] * rstd * subln[eg * 16 + j]);
    }
}

typedef short bf16x8_t __attribute__((ext_vector_type(8)));
typedef float f32x16 __attribute__((ext_vector_type(16)));
typedef unsigned v2u __attribute__((ext_vector_type(2)));
typedef float f32x2 __attribute__((ext_vector_type(2)));
#define MFMA32(a, b, c) __builtin_amdgcn_mfma_f32_32x32x16_bf16((a), (b), (c), 0, 0, 0)
__device__ __forceinline__ int crow(int i, int hh) { return (i & 3) + 8 * (i >> 2) + 4 * hh; }
__device__ __forceinline__ float xhalf_max(float v) { const auto rr = __builtin_amdgcn_permlane32_swap(__float_as_uint(v), __float_as_uint(v), false, false); return fmaxf(__uint_as_float(rr[0]), __uint_as_float(rr[1])); }
__device__ __forceinline__ float xhalf_sum(float v) { const auto rr = __builtin_amdgcn_permlane32_swap(__float_as_uint(v), __float_as_uint(v), false, false); return __uint_as_float(rr[0]) + __uint_as_float(rr[1]); }
__device__ __forceinline__ float max3f(float a, float b, float c) { float r; asm("v_max3_f32 %0, %1, %2, %3" : "=v"(r) : "v"(a), "v"(b), "v"(c)); return r; }
__device__ __forceinline__ unsigned cvtpk(float lo, float hi) { return pg8::cvt_pk_bf16(lo, hi); }
__device__ __forceinline__ bf16x8_t pack_frag(const f32x16& p, int s) {
    v4u w; w.x = cvtpk(p[8 * s + 0], p[8 * s + 1]); w.y = cvtpk(p[8 * s + 2], p[8 * s + 3]); w.z = cvtpk(p[8 * s + 4], p[8 * s + 5]); w.w = cvtpk(p[8 * s + 6], p[8 * s + 7]);
    return __builtin_bit_cast(bf16x8_t, w);
}
constexpr int AT_KSTR = 136, AT_VSTR = 68, AT_KBUF = 64 * AT_KSTR * 2, AT_VBUF = 128 * AT_VSTR * 2;
constexpr int AT_VOFF = 2 * AT_KBUF, AT_LUT = AT_VOFF + 2 * AT_VBUF;
template <int AMODE = 0> __device__ __forceinline__ void attn_mfma(const int tid, const int bid, LAS unsigned char* lds, const bf16* Qd, const bf16* Kd, const bf16* VTd, bf16* Od, const float* lutg, const float* rel_tab, float lam, const float* subln, float outscale) {
    const int lane = tid & 63, r = lane & 31, hh = lane >> 5;
    const int wave = __builtin_amdgcn_readfirstlane(tid >> 6), mi = wave & 1, g = wave >> 1;
    const int w = bid, bh = w & 15, g16 = w >> 4, b = bh >> 3, h = bh & 7;
    LAS float* lut = (LAS float*)(lds + AT_LUT); LAS float* ex = (LAS float*)lds;
    const float NEG = -1e30f;
    __syncthreads();
    if (tid < 128) lut[tid] = lutg[h * 128 + tid] - rel_tab[31 * 8 + h] * LOG2E;
    const bf16* kg = Kd + ((size_t)(b * SEQ)) * 1024 + h * 128 + (size_t)(tid >> 4) * 1024 + (tid & 15) * 8;
    const bf16* vg = VTd + ((size_t)(bh * 128 + (tid >> 3))) * SEQ + (tid & 7) * 8;
    const int kso = ((tid >> 4) * AT_KSTR + (tid & 15) * 8) * 2, vso = AT_VOFF + ((tid >> 3) * AT_VSTR + (tid & 7) * 8) * 2;
    for (int ui = 0; ui < 4; ++ui) {
        const int qb = ui == 0 ? g16 : (ui == 1 ? 31 - g16 : (ui == 2 ? 32 + g16 : 63 - g16));
        const int qw = qb * 128 + 32 * g, NT = 2 * qb + 2, qabs = qw + r;
        const bf16* qp = Qd + ((size_t)(b * SEQ + qabs)) * 1024 + h * 128 + 64 * mi + 8 * hh;
        bf16x8_t qf[4];
#pragma unroll
        for (int ds = 0; ds < 4; ++ds) qf[ds] = *(const bf16x8_t*)(qp + 16 * ds);
        f32x16 o[4];
#pragma unroll
        for (int dt = 0; dt < 4; ++dt)
#pragma unroll
            for (int i = 0; i < 16; ++i) o[dt][i] = 0.f;
        float mref = 0.f, l = 0.f; bool first = true;
        v4u kr0, kr1, vr0, vr1;
        const int NTw = (qw + 31) / 64 + 1 < NT ? (qw + 31) / 64 + 1 : NT;
        const bool isY = wave >= 4;
#define AT_LOADK(t) do { kr0 = *(const v4u*)(kg + (size_t)(t) * 64 * 1024); kr1 = *(const v4u*)(kg + (size_t)(t) * 64 * 1024 + 32 * 1024); } while (0)
#define AT_LOADV(t) do { vr0 = *(const v4u*)(vg + (t) * 64); vr1 = *(const v4u*)(vg + (size_t)64 * SEQ + (t) * 64); } while (0)
#define AT_STOREK(bf) do { *(LAS v4u*)(lds + (bf) * AT_KBUF + kso) = kr0; *(LAS v4u*)(lds + (bf) * AT_KBUF + kso + 32 * AT_KSTR * 2) = kr1; } while (0)
#define AT_STOREV(bf) do { *(LAS v2u*)(lds + (bf) * AT_VBUF + vso) = (v2u){vr0.x, vr0.y}; *(LAS v2u*)(lds + (bf) * AT_VBUF + vso + 8) = (v2u){vr0.z, vr0.w}; \
        *(LAS v2u*)(lds + (bf) * AT_VBUF + vso + 64 * AT_VSTR * 2) = (v2u){vr1.x, vr1.y}; *(LAS v2u*)(lds + (bf) * AT_VBUF + vso + 64 * AT_VSTR * 2 + 8) = (v2u){vr1.z, vr1.w}; } while (0)
#define AT_SB __builtin_amdgcn_sched_barrier(0)
#define AT_PVB(bv) do { const LAS unsigned char* vb_ = lds + AT_VOFF + (bv) * AT_VBUF + (r * AT_VSTR + 4 * hh) * 2; v4u fa0, fb0, fa1, fb1, fa2, fb2; { const LAS unsigned char* a_ = vb_ + 0 * 32 * AT_VSTR * 2 + 0 * 32; const v2u l0 = *(const LAS v2u*)a_, h0 = *(const LAS v2u*)(a_ + 16), l1 = *(const LAS v2u*)(a_ + 32 * AT_VSTR * 2), h1 = *(const LAS v2u*)(a_ + 32 * AT_VSTR * 2 + 16); fa0 = (v4u){l0.x, l0.y, h0.x, h0.y}; fb0 = (v4u){l1.x, l1.y, h1.x, h1.y}; } AT_SB; { const LAS unsigned char* a_ = vb_ + 2 * 32 * AT_VSTR * 2 + 0 * 32; const v2u l0 = *(const LAS v2u*)a_, h0 = *(const LAS v2u*)(a_ + 16), l1 = *(const LAS v2u*)(a_ + 32 * AT_VSTR * 2), h1 = *(const LAS v2u*)(a_ + 32 * AT_VSTR * 2 + 16); fa1 = (v4u){l0.x, l0.y, h0.x, h0.y}; fb1 = (v4u){l1.x, l1.y, h1.x, h1.y}; } AT_SB; { const LAS unsigned char* a_ = vb_ + 0 * 32 * AT_VSTR * 2 + 1 * 32; const v2u l0 = *(const LAS v2u*)a_, h0 = *(const LAS v2u*)(a_ + 16), l1 = *(const LAS v2u*)(a_ + 32 * AT_VSTR * 2), h1 = *(const LAS v2u*)(a_ + 32 * AT_VSTR * 2 + 16); fa2 = (v4u){l0.x, l0.y, h0.x, h0.y}; fb2 = (v4u){l1.x, l1.y, h1.x, h1.y}; } AT_SB; { __builtin_amdgcn_s_setprio(1); o[0] = MFMA32(__builtin_bit_cast(bf16x8_t, fa0), pb0, o[0]); o[1] = MFMA32(__builtin_bit_cast(bf16x8_t, fb0), pb0, o[1]); __builtin_amdgcn_s_setprio(0); } AT_SB; { const LAS unsigned char* a_ = vb_ + 2 * 32 * AT_VSTR * 2 + 1 * 32; const v2u l0 = *(const LAS v2u*)a_, h0 = *(const LAS v2u*)(a_ + 16), l1 = *(const LAS v2u*)(a_ + 32 * AT_VSTR * 2), h1 = *(const LAS v2u*)(a_ + 32 * AT_VSTR * 2 + 16); fa0 = (v4u){l0.x, l0.y, h0.x, h0.y}; fb0 = (v4u){l1.x, l1.y, h1.x, h1.y}; } AT_SB; { __builtin_amdgcn_s_setprio(1); o[2] = MFMA32(__builtin_bit_cast(bf16x8_t, fa1), pb0, o[2]); o[3] = MFMA32(__builtin_bit_cast(bf16x8_t, fb1), pb0, o[3]); __builtin_amdgcn_s_setprio(0); } AT_SB; { const LAS unsigned char* a_ = vb_ + 0 * 32 * AT_VSTR * 2 + 2 * 32; const v2u l0 = *(const LAS v2u*)a_, h0 = *(const LAS v2u*)(a_ + 16), l1 = *(const LAS v2u*)(a_ + 32 * AT_VSTR * 2), h1 = *(const LAS v2u*)(a_ + 32 * AT_VSTR * 2 + 16); fa1 = (v4u){l0.x, l0.y, h0.x, h0.y}; fb1 = (v4u){l1.x, l1.y, h1.x, h1.y}; } AT_SB; { __builtin_amdgcn_s_setprio(1); o[0] = MFMA32(__builtin_bit_cast(bf16x8_t, fa2), pb1, o[0]); o[1] = MFMA32(__builtin_bit_cast(bf16x8_t, fb2), pb1, o[1]); __builtin_amdgcn_s_setprio(0); } AT_SB; { const LAS unsigned char* a_ = vb_ + 2 * 32 * AT_VSTR * 2 + 2 * 32; const v2u l0 = *(const LAS v2u*)a_, h0 = *(const LAS v2u*)(a_ + 16), l1 = *(const LAS v2u*)(a_ + 32 * AT_VSTR * 2), h1 = *(const LAS v2u*)(a_ + 32 * AT_VSTR * 2 + 16); fa2 = (v4u){l0.x, l0.y, h0.x, h0.y}; fb2 = (v4u){l1.x, l1.y, h1.x, h1.y}; } AT_SB; { __builtin_amdgcn_s_setprio(1); o[2] = MFMA32(__builtin_bit_cast(bf16x8_t, fa0), pb1, o[2]); o[3] = MFMA32(__builtin_bit_cast(bf16x8_t, fb0), pb1, o[3]); __builtin_amdgcn_s_setprio(0); } AT_SB; { const LAS unsigned char* a_ = vb_ + 0 * 32 * AT_VSTR * 2 + 3 * 32; const v2u l0 = *(const LAS v2u*)a_, h0 = *(const LAS v2u*)(a_ + 16), l1 = *(const LAS v2u*)(a_ + 32 * AT_VSTR * 2), h1 = *(const LAS v2u*)(a_ + 32 * AT_VSTR * 2 + 16); fa0 = (v4u){l0.x, l0.y, h0.x, h0.y}; fb0 = (v4u){l1.x, l1.y, h1.x, h1.y}; } AT_SB; { __builtin_amdgcn_s_setprio(1); o[0] = MFMA32(__builtin_bit_cast(bf16x8_t, fa1), pb2, o[0]); o[1] = MFMA32(__builtin_bit_cast(bf16x8_t, fb1), pb2, o[1]); __builtin_amdgcn_s_setprio(0); } AT_SB; { const LAS unsigned char* a_ = vb_ + 2 * 32 * AT_VSTR * 2 + 3 * 32; const v2u l0 = *(const LAS v2u*)a_, h0 = *(const LAS v2u*)(a_ + 16), l1 = *(const LAS v2u*)(a_ + 32 * AT_VSTR * 2), h1 = *(const LAS v2u*)(a_ + 32 * AT_VSTR * 2 + 16); fa1 = (v4u){l0.x, l0.y, h0.x, h0.y}; fb1 = (v4u){l1.x, l1.y, h1.x, h1.y}; } AT_SB; { __builtin_amdgcn_s_setprio(1); o[2] = MFMA32(__builtin_bit_cast(bf16x8_t, fa2), pb2, o[2]); o[3] = MFMA32(__builtin_bit_cast(bf16x8_t, fb2), pb2, o[3]); __builtin_amdgcn_s_setprio(0); } AT_SB; { __builtin_amdgcn_s_setprio(1); o[0] = MFMA32(__builtin_bit_cast(bf16x8_t, fa0), pb3, o[0]); o[1] = MFMA32(__builtin_bit_cast(bf16x8_t, fb0), pb3, o[1]); __builtin_amdgcn_s_setprio(0); } AT_SB; { __builtin_amdgcn_s_setprio(1); o[2] = MFMA32(__builtin_bit_cast(bf16x8_t, fa1), pb3, o[2]); o[3] = MFMA32(__builtin_bit_cast(bf16x8_t, fb1), pb3, o[3]); __builtin_amdgcn_s_setprio(0); } AT_SB; } while (0)
#define AT_QKB(bk) do { const LAS unsigned char* kb_ = lds + (bk) * AT_KBUF + (r * AT_KSTR + 64 * mi + 8 * hh) * 2; v4u fa0, fb0, fa1, fb1, fa2, fb2; { fa0 = *(const LAS v4u*)(kb_ + 0 * 32); fb0 = *(const LAS v4u*)(kb_ + 32 * AT_KSTR * 2 + 0 * 32); } AT_SB; { fa1 = *(const LAS v4u*)(kb_ + 1 * 32); fb1 = *(const LAS v4u*)(kb_ + 32 * AT_KSTR * 2 + 1 * 32); } AT_SB; { fa2 = *(const LAS v4u*)(kb_ + 2 * 32); fb2 = *(const LAS v4u*)(kb_ + 32 * AT_KSTR * 2 + 2 * 32); } AT_SB; { __builtin_amdgcn_s_setprio(1); p0 = MFMA32(__builtin_bit_cast(bf16x8_t, fa0), qf[0], p0); p1 = MFMA32(__builtin_bit_cast(bf16x8_t, fb0), qf[0], p1); __builtin_amdgcn_s_setprio(0); } AT_SB; { fa0 = *(const LAS v4u*)(kb_ + 3 * 32); fb0 = *(const LAS v4u*)(kb_ + 32 * AT_KSTR * 2 + 3 * 32); } AT_SB; { __builtin_amdgcn_s_setprio(1); p0 = MFMA32(__builtin_bit_cast(bf16x8_t, fa1), qf[1], p0); p1 = MFMA32(__builtin_bit_cast(bf16x8_t, fb1), qf[1], p1); __builtin_amdgcn_s_setprio(0); } AT_SB; { __builtin_amdgcn_s_setprio(1); p0 = MFMA32(__builtin_bit_cast(bf16x8_t, fa2), qf[2], p0); p1 = MFMA32(__builtin_bit_cast(bf16x8_t, fb2), qf[2], p1); __builtin_amdgcn_s_setprio(0); } AT_SB; { __builtin_amdgcn_s_setprio(1); p0 = MFMA32(__builtin_bit_cast(bf16x8_t, fa0), qf[3], p0); p1 = MFMA32(__builtin_bit_cast(bf16x8_t, fb0), qf[3], p1); __builtin_amdgcn_s_setprio(0); } AT_SB; } while (0)
#define AT_SOFTMAX(t) do { const int k0 = (t) * 64; \
        if (qw - k0 - 63 < 113) { \
            _Pragma("unroll") for (int i = 0; i < 16; ++i) { const int rel0 = qabs - (k0 + crow(i, hh)), rel1 = rel0 - 32; \
                p0[i] = rel0 < 0 ? NEG : p0[i] + lut[rel0 > 127 ? 127 : rel0]; p1[i] = rel1 < 0 ? NEG : p1[i] + lut[rel1 > 127 ? 127 : rel1]; } } \
        float mt = max3f(p0[0], p0[1], p1[0]), mu = max3f(p0[2], p0[3], p1[1]); mt = max3f(mt, p1[2], p1[3]); \
        _Pragma("unroll") for (int i = 4; i < 16; i += 4) { mt = max3f(mt, p0[i], p0[i + 1]); mu = max3f(mu, p0[i + 2], p0[i + 3]); mt = max3f(mt, p1[i], p1[i + 1]); mu = max3f(mu, p1[i + 2], p1[i + 3]); } \
        mt = xhalf_max(fmaxf(mt, mu)) - mref; \
        if (__any(first ? 1 : (mt > 6.0f))) { \
            const float dl = first ? mt : fmaxf(mt, 0.f), alpha = first ? 1.0f : __builtin_amdgcn_exp2f(-dl); mref += dl; l *= alpha; \
            _Pragma("unroll") for (int dt = 0; dt < 4; ++dt) _Pragma("unroll") for (int i = 0; i < 16; ++i) o[dt][i] *= alpha; \
            first = false; } \
        { f32x2 ls2 = {0.f, 0.f}; const f32x2 nm = {-mref, -mref}; \
          _Pragma("unroll") for (int i = 0; i < 16; i += 2) { f32x2 a = (f32x2){p0[i], p0[i + 1]} + nm, b = (f32x2){p1[i], p1[i + 1]} + nm; \
              a.x = __builtin_amdgcn_exp2f(a.x); a.y = __builtin_amdgcn_exp2f(a.y); b.x = __builtin_amdgcn_exp2f(b.x); b.y = __builtin_amdgcn_exp2f(b.y); \
              p0[i] = a.x; p0[i + 1] = a.y; p1[i] = b.x; p1[i + 1] = b.y; ls2 += a; ls2 += b; } \
          l += ls2.x + ls2.y; } \
        pb0 = pack_frag(p0, 0); pb1 = pack_frag(p0, 1); pb2 = pack_frag(p1, 0); pb3 = pack_frag(p1, 1); } while (0)
        __syncthreads();
        AT_LOADK(0); AT_LOADV(0); AT_STOREK(0); AT_STOREV(0); AT_LOADK(1); AT_STOREK(1);
        __syncthreads();
        if (isY) __syncthreads();
        for (int t = 0; t < NT; ++t) {
            f32x16 p0, p1; bf16x8_t pb0, pb1, pb2, pb3;
#pragma unroll
            for (int i = 0; i < 16; ++i) { p0[i] = 0.f; p1[i] = 0.f; }
            if (t < NTw) AT_QKB(t & 1);
            if (!(AMODE & 4) && t >= 1) { if (t + 1 < NT) AT_STOREK((t + 1) & 1); if (t < NT) AT_STOREV(t & 1); }
            __syncthreads();
            if (!(AMODE & 4)) { if (t + 2 < NT) AT_LOADK(t + 2); if (t + 1 < NT) AT_LOADV(t + 1); }
            if (t < NTw) {
                AT_SOFTMAX(t);
                __syncthreads();
                AT_PVB(t & 1);
            } else __syncthreads();
        }
        __syncthreads();
        if (!isY) __syncthreads();
#undef AT_LOADK
#undef AT_LOADV
#undef AT_STOREK
#undef AT_STOREV
#undef AT_SB
#undef AT_PVB
#undef AT_QKB
#undef AT_SOFTMAX
        l = xhalf_sum(l);
        const float linv = 1.0f / l;
        if (mi == 1) { const float sc = lam * linv;
#pragma unroll
            for (int dt = 0; dt < 4; ++dt)
#pragma unroll
                for (int i = 0; i < 16; ++i) ex[g * 4096 + (32 * dt + crow(i, hh)) * 32 + r] = o[dt][i] * sc; }
        __syncthreads();
        if (mi == 0) { float ssq = 0.f;
#pragma unroll
            for (int dt = 0; dt < 4; ++dt)
#pragma unroll
                for (int i = 0; i < 16; ++i) { const float v = o[dt][i] * linv - ex[g * 4096 + (32 * dt + crow(i, hh)) * 32 + r]; o[dt][i] = v; ssq += v * v; }
            ssq += __shfl_xor(ssq, 32);
            const float rstd = outscale / sqrtf(ssq * (1.0f / 128.0f) + RMS_EPS);
            bf16* op = Od + ((size_t)(b * SEQ + qabs)) * 1024 + h * 128 + 4 * hh;
#pragma unroll
            for (int dt = 0; dt < 4; ++dt)
#pragma unroll
                for (int i4 = 0; i4 < 4; ++i4) { const int dv = 32 * dt + 8 * i4; const f32x4 sg = *(const f32x4*)(subln + dv + 4 * hh);
                    v2u wv; wv.x = cvtpk(o[dt][4 * i4] * rstd * sg[0], o[dt][4 * i4 + 1] * rstd * sg[1]); wv.y = cvtpk(o[dt][4 * i4 + 2] * rstd * sg[2], o[dt][4 * i4 + 3] * rstd * sg[3]);
                    *(v2u*)(op + dv) = wv; }
        }
    }
}

constexpr int R1_STR = 264;
constexpr int R1_TILE = 64 * R1_STR * 2;
__device__ __forceinline__ void ret_scan_mfma(const int tid, const int bid, LAS unsigned char* lds, const bf16* K, const bf16* VT, bf16* ST) {
    const int lane = tid & 63, r = lane & 31, hh = lane >> 5, wave = __builtin_amdgcn_readfirstlane(tid >> 6);
    const int w = bid, bh = w & 7, eb = w >> 5, db = (w >> 3) & 3, h = bh & 3;
    const float lg2 = head_log2_gamma(h), cd = __builtin_exp2f(256.f * lg2);
    const bf16* vg = VT + ((size_t)(bh * 512 + eb * 64 + (tid >> 5))) * SEQ + (tid & 31) * 8;
    const bf16* kg = K + ((size_t)(bh * SEQ + lane)) * 256 + db * 64 + wave * 8;
    v4u vrA[4], krA[4], vrB[4], krB[4];
#define R1_LOAD(vr, kr, c2) do { _Pragma("unroll") for (int i = 0; i < 4; ++i) { vr[i] = *(const v4u*)(vg + (size_t)(16 * i) * SEQ + (c2) * 256); kr[i] = *(const v4u*)(kg + (size_t)((c2) * 256 + 64 * i) * 256); } } while (0)
#define R1_STORE(vr, kr, bf) do { _Pragma("unroll") for (int i = 0; i < 4; ++i) { \
        *(LAS v4u*)(lds + (bf) * R1_TILE + (((tid >> 5) + 16 * i) * R1_STR + (tid & 31) * 8) * 2) = vr[i]; \
        const int m_ = lane + 64 * i; const float kd_ = __builtin_amdgcn_exp2f((float)(255 - m_) * lg2); \
        LAS bf16* kt_ = (LAS bf16*)(lds + (2 + (bf)) * R1_TILE) + (wave * 8) * R1_STR + m_; \
        _Pragma("unroll") for (int q_ = 0; q_ < 4; ++q_) { kt_[(2 * q_) * R1_STR] = f2bf1(__uint_as_float(kr[i][q_] << 16) * kd_); kt_[(2 * q_ + 1) * R1_STR] = f2bf1(__uint_as_float(kr[i][q_] & 0xffff0000u) * kd_); } } } while (0)
    f32x16 acc;
#pragma unroll
    for (int i = 0; i < 16; ++i) acc[i] = 0.f;
    const int et2 = wave & 1, dt2 = (wave >> 1) & 1;
#define R1_COMPUTE(c2) do { if (wave < 4) { \
            bf16* sp = ST + (((size_t)(bh * 32 + (c2))) * 512 + eb * 64 + 32 * et2) * 256 + db * 64 + 32 * dt2 + r; \
            _Pragma("unroll") for (int i = 0; i < 16; ++i) { sp[(size_t)crow(i, hh) * 256] = f2bf1(acc[i]); acc[i] *= cd; } \
            const LAS unsigned char* ab = lds + ((c2) & 1) * R1_TILE + ((32 * et2 + r) * R1_STR + 8 * hh) * 2; \
            const LAS unsigned char* bb = lds + (2 + ((c2) & 1)) * R1_TILE + ((32 * dt2 + r) * R1_STR + 8 * hh) * 2; \
            bf16x8_t fa[16], fb[16]; \
            _Pragma("unroll") for (int ks = 0; ks < 16; ++ks) { fa[ks] = *(const LAS bf16x8_t*)(ab + ks * 32); fb[ks] = *(const LAS bf16x8_t*)(bb + ks * 32); } \
            _Pragma("unroll") for (int ks = 0; ks < 16; ++ks) acc = MFMA32(fa[ks], fb[ks], acc); } } while (0)
    __syncthreads();
    R1_LOAD(vrA, krA, 0); R1_LOAD(vrB, krB, 1); R1_STORE(vrA, krA, 0);
    __syncthreads();
    for (int c2 = 0; c2 < 32; c2 += 2) {
        if (c2 + 2 < 32) R1_LOAD(vrA, krA, c2 + 2);
        R1_COMPUTE(c2);
        R1_STORE(vrB, krB, 1);
        __syncthreads();
        if (c2 + 3 < 32) R1_LOAD(vrB, krB, c2 + 3);
        R1_COMPUTE(c2 + 1);
        if (c2 + 2 < 32) R1_STORE(vrA, krA, 0);
        __syncthreads();
    }
#undef R1_COMPUTE
#undef R1_LOAD
#undef R1_STORE
}
constexpr int R2_STR = 264, R2_PB = 128 * R2_STR * 2, R2_SOFF = R2_PB, R2_SBUF = 512 * 64, R2_SS = R2_SOFF + 2 * R2_SBUF;
__device__ __forceinline__ void ret_out_mfma(const int tid, const int bid, LAS unsigned char* lds, const bf16* Q, const bf16* K, const bf16* VT, bf16* GY, const bf16* ST, const int dry = 0) {
    const int wave = __builtin_amdgcn_readfirstlane(tid >> 6), nt = wave & 3, eh = wave >> 2;
    LAS float* ssp = (LAS float*)(lds + R2_SS);
#define R2_IDS int t_ = tid; asm volatile("" : "+v"(t_)); const int lane = t_ & 63, r = lane & 31, hh = lane >> 5; \
    const int srow = t_ >> 2, sc4 = t_ & 3, sso = R2_SOFF + srow * 64 + ((sc4 ^ ((srow >> 2) & 3)) * 16), fsw = (r >> 2) & 3, fro = R2_SOFF + (256 * eh + r) * 64; \
    (void)lane; (void)srow; (void)sc4; (void)sso; (void)fsw; (void)fro; (void)hh;
    for (int task = bid; task < 512; task += gridDim.x) {
        const int bh = task >> 6, c = (task & 63) ^ (task >> 8), h = bh & 3, odd = c & 1, tk0 = (c & ~1) * 128, tq0 = c * 128;
        const float lg2 = head_log2_gamma(h);
        f32x16 acc[8];
#pragma unroll
        for (int et = 0; et < 8; ++et)
#pragma unroll
            for (int i = 0; i < 16; ++i) acc[et][i] = 0.f;
        v4u sr[4];
#define R2_QG (Q + ((size_t)(bh * SEQ + tq0 + 32 * nt + r)) * 256 + 8 * hh)
#define R2_LOADS(src, rstride, sl) do { _Pragma("unroll") for (int i = 0; i < 4; ++i) sr[i] = *(const v4u*)((src) + (size_t)(srow + 128 * i) * (rstride) + 32 * (sl) + 8 * sc4); } while (0)
#define R2_STORES(bf) do { _Pragma("unroll") for (int i = 0; i < 4; ++i) *(LAS v4u*)(lds + (bf) * R2_SBUF + sso + 128 * i * 64) = sr[i]; } while (0)
#define R2_AFRAG(bf, et, ksl) (*(const LAS bf16x8_t*)(lds + (bf) * R2_SBUF + fro + (et) * 32 * 64 + (((2 * (ksl) + hh) ^ fsw) * 16)))
#define R2_SB __builtin_amdgcn_sched_barrier(0)
#define R2_SLICE(bf, b0, b1) do { const int bf_ = (bf); const bf16x8_t b0_ = (b0), b1_ = (b1); bf16x8_t fa0, fb0, fa1, fb1, fa2, fb2; { fa0 = R2_AFRAG(bf_, 0, 0); fb0 = R2_AFRAG(bf_, 0, 1); } R2_SB; { fa1 = R2_AFRAG(bf_, 1, 0); fb1 = R2_AFRAG(bf_, 1, 1); } R2_SB; { fa2 = R2_AFRAG(bf_, 2, 0); fb2 = R2_AFRAG(bf_, 2, 1); } R2_SB; { acc[0] = MFMA32(fa0, b0_, acc[0]); acc[0] = MFMA32(fb0, b1_, acc[0]); } R2_SB; { fa0 = R2_AFRAG(bf_, 3, 0); fb0 = R2_AFRAG(bf_, 3, 1); } R2_SB; { acc[1] = MFMA32(fa1, b0_, acc[1]); acc[1] = MFMA32(fb1, b1_, acc[1]); } R2_SB; { fa1 = R2_AFRAG(bf_, 4, 0); fb1 = R2_AFRAG(bf_, 4, 1); } R2_SB; { acc[2] = MFMA32(fa2, b0_, acc[2]); acc[2] = MFMA32(fb2, b1_, acc[2]); } R2_SB; { fa2 = R2_AFRAG(bf_, 5, 0); fb2 = R2_AFRAG(bf_, 5, 1); } R2_SB; { acc[3] = MFMA32(fa0, b0_, acc[3]); acc[3] = MFMA32(fb0, b1_, acc[3]); } R2_SB; { fa0 = R2_AFRAG(bf_, 6, 0); fb0 = R2_AFRAG(bf_, 6, 1); } R2_SB; { acc[4] = MFMA32(fa1, b0_, acc[4]); acc[4] = MFMA32(fb1, b1_, acc[4]); } R2_SB; { fa1 = R2_AFRAG(bf_, 7, 0); fb1 = R2_AFRAG(bf_, 7, 1); } R2_SB; { acc[5] = MFMA32(fa2, b0_, acc[5]); acc[5] = MFMA32(fb2, b1_, acc[5]); } R2_SB; { acc[6] = MFMA32(fa0, b0_, acc[6]); acc[6] = MFMA32(fb0, b1_, acc[6]); } R2_SB; { acc[7] = MFMA32(fa1, b0_, acc[7]); acc[7] = MFMA32(fb1, b1_, acc[7]); } R2_SB; } while (0)
        if (!(dry && (R2_SKIP & 1))) { R2_IDS const bf16* qg = R2_QG; const bf16* src = ST + (((size_t)(bh * 32 + (c >> 1))) * 512) * 256;
          __syncthreads();
          R2_LOADS(src, 256, 0); R2_STORES(0);
          __syncthreads();
          for (int sl = 0; sl < 8; ++sl) {
              if (sl + 1 < 8) R2_LOADS(src, 256, sl + 1);
              const bf16x8_t bq0 = *(const bf16x8_t*)(qg + 32 * sl), bq1 = *(const bf16x8_t*)(qg + 32 * sl + 16);
              R2_SLICE(sl & 1, bq0, bq1);
              if (sl + 1 < 8) R2_STORES((sl + 1) & 1);
              __syncthreads();
          } }
        { R2_IDS const float qdec = __builtin_amdgcn_exp2f((float)(32 * nt + r + 1 + odd * 128) * lg2);
#pragma unroll
          for (int et = 0; et < 8; ++et)
#pragma unroll
              for (int i = 0; i < 16; ++i) acc[et][i] *= qdec; }
        const int nmt = odd ? 4 + nt + 1 : nt + 1;
        if (!(dry && (R2_SKIP & 2))) { R2_IDS
#pragma unroll
            for (int i = 0; i < 8; ++i) { const int ch = t_ + NTHR * i, n = ch >> 5, cc = ch & 31;
                *(LAS v4u*)(lds + R2_SOFF + n * 512 + ((cc ^ (n & 31)) * 16)) = *(const v4u*)(Q + ((size_t)(bh * SEQ + tq0 + n)) * 256 + cc * 8); }
            __syncthreads();
            const LAS unsigned char* qrow = lds + R2_SOFF + (32 * nt + r) * 512;
            for (int mt = eh; mt < nmt; mt += 2) {
                f32x16 p;
#pragma unroll
                for (int i = 0; i < 16; ++i) p[i] = 0.f;
                const bf16* kb = K + ((size_t)(bh * SEQ + tk0 + 32 * mt + r)) * 256 + 8 * hh;
#pragma unroll
                for (int kh = 0; kh < 2; ++kh) { bf16x8_t kf[8];
#pragma unroll
                    for (int jj = 0; jj < 8; ++jj) kf[jj] = *(const bf16x8_t*)(kb + (8 * kh + jj) * 16);
#pragma unroll
                    for (int jj = 0; jj < 8; ++jj) p = MFMA32(kf[jj], *(const LAS bf16x8_t*)(qrow + (((2 * (8 * kh + jj) + hh) ^ r) * 16)), p); }
                const int nq = tq0 + 32 * nt + r, mk = tk0 + 32 * mt + 4 * hh;
#pragma unroll
                for (int i4 = 0; i4 < 4; ++i4) { float v[4];
#pragma unroll
                    for (int k = 0; k < 4; ++k) { const int dist = nq - (mk + 8 * i4 + k); v[k] = dist < 0 ? 0.f : p[4 * i4 + k] * __builtin_amdgcn_exp2f((float)dist * lg2); }
                    v2u wv; wv.x = cvtpk(v[0], v[1]); wv.y = cvtpk(v[2], v[3]);
                    *(LAS v2u*)(lds + ((32 * nt + r) * R2_STR + 32 * mt + 8 * i4 + 4 * hh) * 2) = wv; }
            }
        }
        if (!(dry && (R2_SKIP & 4))) { R2_IDS const bf16* src = VT + ((size_t)(bh * 512)) * SEQ + tk0; const LAS unsigned char* pb = lds + ((32 * nt + r) * R2_STR + 8 * hh) * 2;
          const int nsl = odd ? 8 : 4;
          R2_LOADS(src, SEQ, 0);
          __syncthreads();
          R2_STORES(0);
          __syncthreads();
          for (int sl = 0; sl < nsl; ++sl) {
              if (sl + 1 < nsl) R2_LOADS(src, SEQ, sl + 1);
              if (sl < nmt) {
                  const bf16x8_t bp0 = *(const LAS bf16x8_t*)(pb + sl * 64), bp1 = *(const LAS bf16x8_t*)(pb + sl * 64 + 32);
                  R2_SLICE(sl & 1, bp0, bp1);
              }
              if (sl + 1 < nsl) R2_STORES((sl + 1) & 1);
              __syncthreads();
          } }
#undef R2_LOADS
#undef R2_STORES
#undef R2_AFRAG
#undef R2_SLICE
#undef R2_SB
#undef R2_QG
        { R2_IDS float ssq = 0.f;
#pragma unroll
          for (int et = 0; et < 8; ++et)
#pragma unroll
              for (int i = 0; i < 16; ++i) ssq += acc[et][i] * acc[et][i];
          ssq += __shfl_xor(ssq, 32);
          if (hh == 0) ssp[eh * 128 + 32 * nt + r] = ssq; }
        __syncthreads();
        { R2_IDS const float rstd = 1.0f / sqrtf((ssp[32 * nt + r] + ssp[128 + 32 * nt + r]) * (1.0f / 512.0f) + RMS_EPS);
          bf16* gp = GY + ((size_t)((bh >> 2) * SEQ + tq0 + 32 * nt + r)) * 2048 + h * 512 + 256 * eh + 4 * hh;
#pragma unroll
          for (int et = 0; et < 8; ++et)
#pragma unroll
              for (int i4 = 0; i4 < 4; ++i4) { bf16* p4 = gp + 32 * et + 8 * i4; const v2u gg = *(const v2u*)p4;
                  v2u wv; wv.x = cvtpk(acc[et][4 * i4] * rstd * __uint_as_float(gg.x << 16), acc[et][4 * i4 + 1] * rstd * __uint_as_float(gg.x & 0xffff0000u));
                  wv.y = cvtpk(acc[et][4 * i4 + 2] * rstd * __uint_as_float(gg.y << 16), acc[et][4 * i4 + 3] * rstd * __uint_as_float(gg.y & 0xffff0000u));
                  if (!dry || rstd == 1.2345e38f) *(v2u*)p4 = wv; if (i4 == 3 && (et & 1)) asm volatile("" ::: "memory"); } }
    }
}

__device__ __forceinline__ void ret_out_mfma_d(const int dry, const int tid, const int bid, LAS unsigned char* lds, const bf16* Q, const bf16* K, const bf16* VT, bf16* GY, const bf16* ST) { ret_out_mfma(tid, bid, lds, Q, K, VT, GY, ST, dry); }
#define XB_TMO      128
#define XB_XCNT(j)  (256  + 64 * (j))
#define XB_XSUB(j)  (1280 + 64 * (j))
#define XB_XGEN(j)  (2304 + 64 * (j))
#define XB_TOP      3328
#define XB_TOPGEN   3392
#define XCD_BAR_WORDS 3456
#define XB_SPIN_CAP (1u << 18)

__device__ __forceinline__ unsigned xb_ld(unsigned* p)              { return __hip_atomic_load(p, __ATOMIC_RELAXED, __HIP_MEMORY_SCOPE_AGENT); }
__device__ __forceinline__ unsigned xb_add(unsigned* p, unsigned v) { return __hip_atomic_fetch_add(p, v, __ATOMIC_RELAXED, __HIP_MEMORY_SCOPE_AGENT); }
__device__ __forceinline__ unsigned xb_xcc_id() { return (unsigned)__builtin_amdgcn_s_getreg((3 << 11) | 20) & 0xFu; }
#define XB_SPIN(cond, bar) do { unsigned _sp = 0; while (cond) { __builtin_amdgcn_s_sleep(1); \
    if ((++_sp & 255u) == 0u) { if (xb_ld(&(bar)[XB_TMO])) break; if (_sp > XB_SPIN_CAP) { atomicAdd(&(bar)[XB_TMO], 1u); break; } } } } while (0)

struct XcdBarrier {
    unsigned* bar; unsigned x;
    volatile LAS unsigned* st;
};

__device__ __forceinline__ XcdBarrier xcd_barrier_post(unsigned* bar, volatile LAS unsigned* st) {
    XcdBarrier b; b.bar = bar; b.x = xb_xcc_id(); b.st = st;
    if (threadIdx.x == 0) (void)xb_add(&bar[XB_XCNT(b.x)], 1u);
    return b;
}
__device__ __forceinline__ void xcd_barrier_complete(unsigned* bar, unsigned x, unsigned& nloc, unsigned& nx) {
    const unsigned G = gridDim.x * gridDim.y * gridDim.z;
    unsigned sum, cnt, mine, sp = 0u;
    for (;;) {
        sum = 0u; cnt = 0u; mine = 0u;
#pragma unroll
        for (unsigned j = 0; j < 16; ++j) { const unsigned c = xb_ld(&bar[XB_XCNT(j)]); sum += c; cnt += (c > 0u) ? 1u : 0u; mine = (j == x) ? c : mine; }
        if (sum == G) break;
        __builtin_amdgcn_s_sleep(1);
        if ((++sp & 255u) == 0u) { if (xb_ld(&bar[XB_TMO])) break; if (sp > XB_SPIN_CAP) { atomicAdd(&bar[XB_TMO], 1u); break; } }
    }
    nloc = mine > 0u ? mine : 1u; nx = cnt > 0u ? cnt : 1u;
}

__device__ __forceinline__ void xcd_barrier(const XcdBarrier& b) {
    asm volatile("s_waitcnt vmcnt(0)" ::: "memory");
    __syncthreads();
    if (threadIdx.x == 0) {
        unsigned* bar = b.bar;
        __builtin_amdgcn_s_waitcnt(0);
        unsigned nloc = b.st[0], nx = b.st[1];
        if (nloc == 0u) { xcd_barrier_complete(bar, b.x, nloc, nx); b.st[0] = nloc; b.st[1] = nx; }
        const unsigned old = xb_add(&bar[XB_XSUB(b.x)], 1u);
        const unsigned gen = old / nloc;
        if (old + 1u == (gen + 1u) * nloc) {
            __builtin_amdgcn_fence(__ATOMIC_RELEASE, "agent");
            asm volatile("s_waitcnt vmcnt(0)" ::: "memory");
            const unsigned og = xb_add(&bar[XB_TOP], 1u);
            const unsigned tg = og / nx;
            if (og + 1u == (tg + 1u) * nx) xb_add(&bar[XB_TOPGEN], 1u);
            else XB_SPIN(xb_ld(&bar[XB_TOPGEN]) == tg, bar);
            __builtin_amdgcn_fence(__ATOMIC_ACQUIRE, "agent");
            xb_add(&bar[XB_XGEN(b.x)], 1u);
            asm volatile("s_waitcnt vmcnt(0)" ::: "memory");
        } else {
            XB_SPIN(xb_ld(&bar[XB_XGEN(b.x)]) == gen, bar);
            __builtin_amdgcn_fence(__ATOMIC_ACQUIRE, "agent");
            asm volatile("s_waitcnt vmcnt(0)" ::: "memory");
        }
    }
    __syncthreads();
}


#if NAIVE_MIXERS
#define MIXER_RET_A
#define MIXER_RET_B
#define MIXER_DIFF
#else
#define MIXER_RET_A for (int rep_ = 0; rep_ < ((PROBE_DUP & 2) ? 2 : 1); ++rep_) if (IN(pb + 1)) { PH_BEGIN ret_scan_mfma(tid, bid, lds, (const bf16*)(ws + WS_K), (const bf16*)(ws + WS_VT), (bf16*)(ws + WS_ST)); }
#define MIXER_RET_B for (int rep_ = ((PROBE_DUP & 128) ? 1 : 0); rep_ >= 0; --rep_) if (IN(pb + 2)) { PH_BEGIN ret_out_mfma_d(rep_, tid, bid, lds, (const bf16*)(ws + WS_Q), (const bf16*)(ws + WS_K), (const bf16*)(ws + WS_VT), (bf16*)(ws + WS_G), (const bf16*)(ws + WS_ST)); }
#ifndef PROBE_AMODE
#define PROBE_AMODE 0
#endif
#define MIXER_DIFF for (int rep_ = 0; rep_ < ((PROBE_DUP & 1) ? 2 : 1); ++rep_) if (IN(pb + 2)) { PH_BEGIN const float* tab_ = (const float*)(ws + WS_TAB); \
    if (PROBE_AMODE != 0 && rep_ == 0) attn_mfma<PROBE_AMODE>(tid, bid, lds, (const bf16*)(ws + WS_Q), (const bf16*)(ws + WS_K), (const bf16*)(ws + WS_VT), (bf16*)(ws + WS_G), tab_, ka_in(ka, 8), tab_[1024 + j], ka_in(ka, 7) + j * 128, tab_[1024 + 2 + j]); else \
    attn_mfma(tid, bid, lds, (const bf16*)(ws + WS_Q), (const bf16*)(ws + WS_K), (const bf16*)(ws + WS_VT), (bf16*)(ws + WS_G), tab_, ka_in(ka, 8), tab_[1024 + j], ka_in(ka, 7) + j * 128, tab_[1024 + 2 + j]); }
#endif
#if NAIVE_MIXERS
__global__ void __launch_bounds__(NTHR) k_scan_naive(const bf16* K, const bf16* VT, bf16* ST) { ret_scan_naive(K, VT, ST); }
__global__ void __launch_bounds__(NTHR) k_rout_naive(const bf16* Q, const bf16* K, const bf16* VT, bf16* GY, const bf16* ST) {
    extern __shared__ __attribute__((aligned(16))) unsigned char lds_raw[]; ret_out_naive((LAS unsigned char*)lds_raw, Q, K, VT, GY, ST); }
__global__ void __launch_bounds__(NTHR, 2) k_scan_mfma(const bf16* K, const bf16* VT, bf16* ST) {
    extern __shared__ __attribute__((aligned(16))) unsigned char lds_raw[]; ret_scan_mfma(threadIdx.x, blockIdx.x, (LAS unsigned char*)lds_raw, K, VT, ST); }
__global__ void __launch_bounds__(NTHR, 2) k_rout_mfma(const bf16* Q, const bf16* K, const bf16* VT, bf16* GY, const bf16* ST) {
    extern __shared__ __attribute__((aligned(16))) unsigned char lds_raw[]; ret_out_mfma(threadIdx.x, blockIdx.x, (LAS unsigned char*)lds_raw, Q, K, VT, GY, ST); }
__global__ void __launch_bounds__(NTHR, 2) k_attn_mfma(const bf16* Qd, const bf16* Kd, const bf16* VTd, bf16* Od, const float* tab, int j, const float* subln, const float* rel_tab) {
    extern __shared__ __attribute__((aligned(16))) unsigned char lds_raw[]; attn_mfma(threadIdx.x, blockIdx.x, (LAS unsigned char*)lds_raw, Qd, Kd, VTd, Od, tab, rel_tab, tab[1024 + j], subln + j * 128, tab[1024 + 2 + j]); }
__global__ void __launch_bounds__(NTHR) k_attn_naive(const bf16* Qd, const bf16* Kd, const bf16* VTd, bf16* Od, const float* tab, int j, const float* subln) {
    extern __shared__ __attribute__((aligned(16))) unsigned char lds_raw[]; attn_naive((LAS unsigned char*)lds_raw, Qd, Kd, VTd, Od, tab, tab[1024 + j], subln + j * 128, tab[1024 + 2 + j]); }

#endif
typedef const unsigned char __attribute__((address_space(4)))* kaptr;
__device__ __forceinline__ kaptr ka_get() { kaptr p = (kaptr)__builtin_amdgcn_kernarg_segment_ptr(); asm volatile("" : "+s"(p)); return p; }
__device__ __forceinline__ const float* ka_in(kaptr p, int i) { return *(const float* const __attribute__((address_space(4)))*)(p + 8 * i); }
__device__ __forceinline__ float* ka_out(kaptr p) { return *(float* const __attribute__((address_space(4)))*)(p + 96); }
__device__ __forceinline__ unsigned char* ka_ws(kaptr p) { return *(unsigned char* const __attribute__((address_space(4)))*)(p + 104); }
__device__ __forceinline__ int tid_get() { int t = threadIdx.x; asm volatile("" : "+v"(t)); return t; }
__device__ __forceinline__ int bid_get() { int t = blockIdx.x; asm volatile("" : "+s"(t)); return t; }
#define PH_BEGIN const kaptr ka = ka_get(); unsigned char* const ws = ka_ws(ka); const int tid = tid_get(), lane = tid & 63, wave = __builtin_amdgcn_readfirstlane(tid >> 6); \
    const int bid = bid_get(); const int G = gridDim.x, gw = bid * NWAVES + wave, ngw = G * NWAVES; (void)bid; LAS float* const scr = (LAS float*)(lds + wave * 16384); (void)lane; (void)gw; (void)ngw; (void)scr; (void)ws;

__global__ void __launch_bounds__(NTHR, 2) fwd_mega(Args args_unused, int ph_lo, int ph_hi) {
    extern __shared__ __attribute__((aligned(16))) unsigned char lds_raw[];
    cg::grid_group grid = cg::this_grid();
    LAS unsigned char* lds = (LAS unsigned char*)lds_raw;
    volatile LAS unsigned* xst = (volatile LAS unsigned*)(lds + LDS_BYTES - 64);
    if (threadIdx.x < 2) xst[threadIdx.x] = 0u;
    __syncthreads();
    const XcdBarrier xbar = xcd_barrier_post((unsigned*)(ka_ws(ka_get()) + WS_CTL) + CW_BAR, xst);

#define IN(k) (ph_lo <= (k) && (k) < ph_hi)
#define SEAM(k) do { if (IN(k) && IN((k) + 1)) { if (ph_hi < 0) grid.sync(); else xcd_barrier(xbar); } } while (0)
    if (IN(0)) {
        PH_BEGIN
        conv_plain(ka_in(ka, 2), D, RET_IN, (bf16*)(ws + WS_WIN), scr, gw, ngw, lane);
        conv_plain(ka_in(ka, 3), 2048, D, (bf16*)(ws + WS_WOUT), scr, gw, ngw, lane);
        conv_gu(ka_in(ka, 9), ka_in(ka, 10), (bf16*)(ws + WS_WGU), scr, gw, ngw, lane);
        conv_plain(ka_in(ka, 11), FF, D, (bf16*)(ws + WS_WDN), scr, gw, ngw, lane);
        { const float* x = ka_in(ka, 0); const float* gains = ka_in(ka, 1); bf16* XN = (bf16*)(ws + WS_XN);
          for (int m = gw; m < M; m += ngw) rms_row_to_bf16(x + (size_t)m * D, gains, XN + (size_t)m * D, lane); }
        { unsigned* ctl = (unsigned*)(ws + WS_CTL); for (int i = bid * NTHR + tid; i < 16 * 64 * 64; i += G * NTHR) ctl[CW_CNT + i] = 0u; }
        if (bid == 0) {
            const float* rel_tab = ka_in(ka, 8); const float* diff_lambda = ka_in(ka, 6); float* lut = (float*)(ws + WS_TAB); float* lamtab = (float*)(ws + WS_TAB + 4096);
            for (int t = tid; t < 1024; t += NTHR) { const int h = t >> 7, n = t & 127; int bk;
                if (n < 16) bk = n; else { bk = 16 + (int)(__builtin_logf((float)n * (1.0f / 16.0f)) / 2.0794415416798357f * 16.0f); if (bk > 31) bk = 31; }
                lut[t] = rel_tab[bk * 8 + h] * LOG2E; }
            if (tid < 2) { const float* lm = diff_lambda + tid * 256; float a = 0.f, b2 = 0.f; for (int i = 0; i < 64; ++i) { a += lm[i] * lm[64 + i]; b2 += lm[128 + i] * lm[192 + i]; }
                const int li = 2 * tid + 1; const float linit = 0.8f - 0.6f * __builtin_expf(-0.3f * (float)li); lamtab[tid] = __builtin_expf(a) - __builtin_expf(b2) + linit; lamtab[2 + tid] = 1.0f - linit; }
        }
    }
    SEAM(0);

    for (int L = 0; L < DEPTH; ++L) {
        asm volatile("" : "+s"(L));
        const int j = L >> 1; const bool isRet = (L & 1) == 0; const int pb = 1 + 6 * L; (void)j;
        if (L > 0 && IN(pb)) { PH_BEGIN conv_plain(ka_in(ka, 11) + (size_t)L * FF * D, FF, D, (bf16*)(ws + WS_WDN), scr, gw, ngw, lane); __syncthreads(); }
        if (isRet) {
            for (int rep_ = 0; rep_ < ((PROBE_DUP & 4) ? 2 : 1); ++rep_) if (IN(pb)) { PH_BEGIN
              pg8::Gemm g{(const bf16*)(ws + WS_XN), (const bf16*)(ws + WS_WIN), M, RET_IN, D}; pg8::StaticOrder S; S.init(M, RET_IN, G, bid);
              pg8::EpiRetIn E{(bf16*)(ws + WS_Q), (bf16*)(ws + WS_K), (bf16*)(ws + WS_VT), (bf16*)(ws + WS_G)};
              pg8::gemm_phase<pg8::EpiRetIn, pg8::StaticOrder, true, true>(lds, g, S, E); }
            SEAM(pb);
            MIXER_RET_A
            SEAM(pb + 1);
            MIXER_RET_B
            SEAM(pb + 2);
        } else {
            if (IN(pb)) { PH_BEGIN
              pg8::Gemm g{(const bf16*)(ws + WS_XN), (const bf16*)(ws + WS_WIN), M, DIFF_IN, D}; pg8::StaticOrder S; S.init(M, DIFF_IN, G, bid);
              pg8::EpiDiffIn E{(bf16*)(ws + WS_Q), (bf16*)(ws + WS_K), (bf16*)(ws + WS_VT), 0.125f * LOG2E};
              pg8::gemm_phase<pg8::EpiDiffIn, pg8::StaticOrder, true, true>(lds, g, S, E); }
            SEAM(pb);
            SEAM(pb + 1);
            MIXER_DIFF
            SEAM(pb + 2);
        }
        if (IN(pb + 3)) { PH_BEGIN
          const float* gL = ka_in(ka, 1) + (size_t)L * 4 * D; float* out = ka_out(ka); unsigned* ctl = (unsigned*)(ws + WS_CTL);
          pg8::Gemm g{(const bf16*)(ws + WS_G), (const bf16*)(ws + WS_WOUT), M, D, isRet ? 2048 : 1024}; pg8::StaticOrder S; S.init(M, D, G, bid);
          pg8::EpiNormResNorm E{L == 0 ? ka_in(ka, 0) : (const float*)out, out, (bf16*)(ws + WS_XN), gL + D, gL + 2 * D, (float*)(ws + WS_X), ctl + CW_CNT + (L * 4 + 0) * 64 * 64, RMS_EPS, 0};
          pg8::gemm_phase<pg8::EpiNormResNorm, pg8::StaticOrder, false, true>(lds, g, S, E); }
        SEAM(pb + 3);
        for (int rep_ = 0; rep_ < ((PROBE_DUP & 8) ? 2 : 1); ++rep_) if (IN(pb + 4)) { PH_BEGIN
          pg8::Gemm g{(const bf16*)(ws + WS_XN), (const bf16*)(ws + WS_WGU), M, 2 * FF, D}; pg8::StaticOrder S; S.init(M, 2 * FF, G, bid);
          pg8::EpiSwiGLU E{(bf16*)(ws + WS_ACT)};
          pg8::gemm_phase<pg8::EpiSwiGLU, pg8::StaticOrder, true, true>(lds, g, S, E); }
        SEAM(pb + 4);
        if (L + 1 < DEPTH && IN(pb + 5)) { PH_BEGIN
            const int nj = (L + 1) >> 1;
            if ((L + 1) & 1) { conv_plain(ka_in(ka, 4) + (size_t)nj * D * DIFF_IN, D, DIFF_IN, (bf16*)(ws + WS_WIN), scr, gw, ngw, lane); conv_plain(ka_in(ka, 5) + (size_t)nj * D * D, D, D, (bf16*)(ws + WS_WOUT), scr, gw, ngw, lane); }
            else { conv_plain(ka_in(ka, 2) + (size_t)nj * D * RET_IN, D, RET_IN, (bf16*)(ws + WS_WIN), scr, gw, ngw, lane); conv_plain(ka_in(ka, 3) + (size_t)nj * 2048 * D, 2048, D, (bf16*)(ws + WS_WOUT), scr, gw, ngw, lane); }
            conv_gu(ka_in(ka, 9) + (size_t)(L + 1) * D * FF, ka_in(ka, 10) + (size_t)(L + 1) * D * FF, (bf16*)(ws + WS_WGU), scr, gw, ngw, lane);
            __syncthreads();
        }
#if (PROBE_DUP & 32)
        if (IN(pb + 5)) { PH_BEGIN
          pg8::Gemm g{(const bf16*)(ws + WS_ACT), (const bf16*)(ws + WS_WDN), M, D, FF}; pg8::StaticOrder S; S.init(M, D, G, bid);
          pg8::EpiNull E{(float*)(ws + WS_TAB + 8192)};
          pg8::gemm_phase<pg8::EpiNull, pg8::StaticOrder, false, true>(lds, g, S, E); }
#endif
        if (IN(pb + 5)) { PH_BEGIN
          const float* gains = ka_in(ka, 1); const float* gL = gains + (size_t)L * 4 * D; float* out = ka_out(ka); unsigned* ctl = (unsigned*)(ws + WS_CTL);
          pg8::Gemm g{(const bf16*)(ws + WS_ACT), (const bf16*)(ws + WS_WDN), M, D, FF}; pg8::StaticOrder S; S.init(M, D, G, bid);
          const float* gnext = (L + 1 < DEPTH) ? gains + (size_t)(L + 1) * 4 * D : gL;
          pg8::EpiNormResNorm E{(const float*)out, out, (bf16*)(ws + WS_XN), gL + 3 * D, gnext, (float*)(ws + WS_X), ctl + CW_CNT + (L * 4 + 2) * 64 * 64, RMS_EPS, 0};
          pg8::gemm_phase<pg8::EpiNormResNorm, pg8::StaticOrder, false, true>(lds, g, S, E); }
        SEAM(pb + 5);
    }
}

extern "C" void kernel_launch(void* const* d_in, const int* in_sizes, int n_in, void* d_out, int out_size, void* d_ws, size_t ws_size, hipStream_t stream) {
    static int ready = 0;
    if (ready == 0) {
        ready = 1;
        if (n_in != 12 || out_size != M * D || ws_size < WS_END) { fprintf(stderr, "kernel_launch: unexpected problem (n_in %d, out %d, ws %zu)\n", n_in, out_size, ws_size); ready = -1; }
        else if (hipFuncSetAttribute((const void*)fwd_mega, hipFuncAttributeMaxDynamicSharedMemorySize, LDS_BYTES) != hipSuccess) { fprintf(stderr, "kernel_launch: hipFuncSetAttribute failed\n"); ready = -1; }
        else {
            int dev = 0, cus = 0, per_cu = 0; (void)hipGetDevice(&dev); (void)hipDeviceGetAttribute(&cus, hipDeviceAttributeMultiprocessorCount, dev);
            (void)hipOccupancyMaxActiveBlocksPerMultiprocessor(&per_cu, (const void*)fwd_mega, NTHR, LDS_BYTES);
            if (cus * per_cu < GRID) { fprintf(stderr, "kernel_launch: %d CUs x %d blocks may not hold the %d-workgroup cooperative grid (advisory; the cooperative launch itself decides)\n", cus, per_cu, GRID); }
            (void)hipGetLastError();
        }
    }
    if (ready < 0) return;
    (void)hipMemsetAsync((char*)d_ws + WS_CTL, 0, CTL_ZERO_BYTES, stream);
    Args a{};
    for (int i = 0; i < 12; ++i) a.in[i] = (const float*)d_in[i];
    a.out = (float*)d_out; a.ws = (unsigned char*)d_ws;
    unsigned char* ws = (unsigned char*)d_ws;
    auto mega = [&](int lo, int hi) {
        int plo = lo, phi = hi; void* kargs[] = {&a, &plo, &phi};
        const hipError_t e = hipLaunchCooperativeKernel((const void*)fwd_mega, dim3(GRID), dim3(NTHR), kargs, LDS_BYTES, stream);
        if (e != hipSuccess) fprintf(stderr, "kernel_launch: cooperative launch failed: %s\n", hipGetErrorString(e));
    };
#if NAIVE_MIXERS
    int lo = 0;
    for (int L = 0; L < DEPTH; ++L) {
        const int pb = 1 + 6 * L;
#if PER_PHASE_LAUNCH
        for (int k = lo; k < pb + 1; ++k) mega(k, k + 1);
#else
        mega(lo, pb + 1);
#endif
        if ((L & 1) == 0) {
#if MFMA_SCAN
            hipLaunchKernelGGL(k_scan_mfma, dim3(GRID), dim3(NTHR), 140000, stream, (const bf16*)(ws + WS_K), (const bf16*)(ws + WS_VT), (bf16*)(ws + WS_ST));
#else
            hipLaunchKernelGGL(k_scan_naive, dim3(GRID), dim3(NTHR), 0, stream, (const bf16*)(ws + WS_K), (const bf16*)(ws + WS_VT), (bf16*)(ws + WS_ST));
#endif
            hipLaunchKernelGGL(MFMA_ROUT ? k_rout_mfma : k_rout_naive, dim3(GRID), dim3(NTHR), 140000, stream, (const bf16*)(ws + WS_Q), (const bf16*)(ws + WS_K), (const bf16*)(ws + WS_VT), (bf16*)(ws + WS_G), (const bf16*)(ws + WS_ST));
        } else {
#if MFMA_ATTN
            hipLaunchKernelGGL(k_attn_mfma, dim3(GRID), dim3(NTHR), 73728, stream, (const bf16*)(ws + WS_Q), (const bf16*)(ws + WS_K), (const bf16*)(ws + WS_VT), (bf16*)(ws + WS_G), (const float*)(ws + WS_TAB), L >> 1, (const float*)d_in[7], (const float*)d_in[8]);
#else
            hipLaunchKernelGGL(k_attn_naive, dim3(GRID), dim3(NTHR), 32768, stream, (const bf16*)(ws + WS_Q), (const bf16*)(ws + WS_K), (const bf16*)(ws + WS_VT), (bf16*)(ws + WS_G), (const float*)(ws + WS_TAB), L >> 1, (const float*)d_in[7]);
#endif
        }
        lo = pb + 3;
#ifdef TRUNC_PHASE
        if (TRUNC_PHASE < pb + 6 + 1) { for (int k = lo; k <= TRUNC_PHASE; ++k) mega(k, k + 1); return; }
#endif
    }
#if PER_PHASE_LAUNCH
    for (int k = lo; k < 1 + 6 * DEPTH; ++k) mega(k, k + 1);
#else
    mega(lo, 1 + 6 * DEPTH);
#endif
#else
    mega(0, 1 + 6 * DEPTH);
#endif
}
```

```cpp
#include <hip/hip_runtime.h>
#include <hip/hip_cooperative_groups.h>
#include <cstdio>
#include <cstdint>
namespace cg = cooperative_groups;
namespace pg8 {
#define PG8_LAS __attribute__((address_space(3)))
typedef unsigned short bf16_t;
typedef short bf16x8 __attribute__((ext_vector_type(8)));
typedef float f32x4 __attribute__((ext_vector_type(4)));
typedef unsigned u32x4 __attribute__((ext_vector_type(4)));
constexpr int BM = 256, BK = 64, HALF = 128, HTB = HALF * BK * 2  , STAGE_BYTES = 8 * HTB, NXCD = 8, WGM = 8;

__host__ __device__ __forceinline__ int lds_byte(int r, int c) { const int st = (r >> 4) * 2 + (c >> 5), rr = r & 15, cc = c & 31, ob = rr * 64 + cc * 2; return st * 1024 + (ob ^ (((ob >> 9) & 1) << 5)); }
__host__ __device__ __forceinline__ void stage_rc(int b, int& R, int& C) { const int st = b / 1024, sb = b % 1024, swz = sb ^ (((sb >> 9) & 1) << 5); R = (st >> 1) * 16 + swz / 64; C = (st & 1) * 32 + (swz % 64) / 2; }
__host__ __device__ __forceinline__ int perm32(int rho) { const int n = rho >> 4, i = rho & 15; return 8 * (i >> 2) + 4 * n + (i & 3); }

struct Unit { int pm, pn; };
struct Gemm { const bf16_t* A; const bf16_t* Bt; int M, N, K; };

struct StaticOrder {
    int nM, nN, nwg, G, c;
    __host__ __device__ void init(int M, int N, int G_, int c_) { nM = M / BM; nN = N / BM; nwg = nM * nN; G = G_; c = c_; }
    __host__ __device__ bool next(int i, Unit& u) const {
        const long L = (long)i * G + c; if (L >= nwg) return false;
        int wgid = (int)L; { const int q = nwg / NXCD, r = nwg % NXCD, xcd = wgid % NXCD, off = wgid / NXCD; wgid = (xcd < r ? xcd * (q + 1) : r * (q + 1) + (xcd - r) * q) + off; }
        const int nig = WGM * nN, gid = wgid / nig, fm = gid * WGM, gsz = (nM - fm) < WGM ? (nM - fm) : WGM;
        u.pm = fm + ((wgid % nig) % gsz); u.pn = (wgid % nig) / gsz; return true;
    }
    __device__ __forceinline__ void a_ready(const Unit&) const {}
    __device__ __forceinline__ void done(const Unit&) const {}
};

__device__ __forceinline__ unsigned cvt_pk_bf16(float lo, float hi) { unsigned r; asm volatile("v_cvt_pk_bf16_f32 %0, %1, %2" : "=v"(r) : "v"(lo), "v"(hi)); return r; }
typedef unsigned u32x2 __attribute__((ext_vector_type(2)));
__device__ __forceinline__ float bf2f(unsigned short v) { return __uint_as_float(((unsigned)v) << 16); }
__device__ __forceinline__ unsigned short f2bf1(float f) { unsigned u = __float_as_uint(f); return (unsigned short)((u + 0x7fffu + ((u >> 16) & 1u)) >> 16); }
__device__ __forceinline__ u32x4 pack8(f32x4 a, f32x4 b) { u32x4 w; w.x = cvt_pk_bf16(a[0], a[1]); w.y = cvt_pk_bf16(a[2], a[3]); w.z = cvt_pk_bf16(b[0], b[1]); w.w = cvt_pk_bf16(b[2], b[3]); return w; }
__device__ __forceinline__ float silu_f(float x) { return x * __builtin_amdgcn_rcpf(1.0f + __builtin_amdgcn_exp2f(-1.4426950408889634f * x)); }
__device__ __forceinline__ f32x4 silu4(f32x4 v) { f32x4 o; o[0] = silu_f(v[0]); o[1] = silu_f(v[1]); o[2] = silu_f(v[2]); o[3] = silu_f(v[3]); return o; }
__device__ __forceinline__ void sincos_rad(float ang, float& s, float& c) {
    constexpr double INV2PI = 0.15915494309189533577; constexpr float C_HI = (float)INV2PI; constexpr float C_LO = (float)(INV2PI - (double)C_HI);
    const float hi = ang * C_HI; const float lo = __builtin_fmaf(ang, C_HI, -hi) + ang * C_LO;
    const float fr = (hi - __builtin_rintf(hi)) + lo;
    s = __builtin_amdgcn_sinf(fr); c = __builtin_amdgcn_cosf(fr);
}
constexpr int SEQ_ = 8192;
struct EpiRetIn {
    static constexpr bool PERM = true, AFTER_DRAIN = false;
    bf16_t *Q, *K, *VT, *G;
    __device__ __forceinline__ void operator()(const f32x4 (&acc)[2][2][4][2], const Unit& u, int wr, int wc, int fr, int fq) const {
        const int pn = u.pn, jb = wc * 32 + 8 * fq, rowb = u.pm * BM + wr * 64 + fr;
        if (pn < 8) {
            const int h = pn & 3; const bool isK = pn >= 4; bf16_t* dst = isK ? K : Q; const float sc = isK ? 0.0625f : 1.0f;
            float inv[8];
#pragma unroll
            for (int e = 0; e < 8; ++e) inv[e] = __builtin_amdgcn_exp2f(-(float)(jb + e) * (13.287712379549449f / 128.0f));
#pragma unroll
            for (int ai = 0; ai < 2; ++ai)
#pragma unroll
                for (int m = 0; m < 4; ++m) {
                    const int row = rowb + ai * HALF + m * 16, b = row >> 13, s = row & (SEQ_ - 1); const float pos = (float)s;
                    f32x4 o1[2], o2[2];
#pragma unroll
                    for (int n = 0; n < 2; ++n)
#pragma unroll
                        for (int i = 0; i < 4; ++i) { float sn, cs; sincos_rad(pos * inv[4 * n + i], sn, cs); const float x1 = acc[ai][0][m][n][i], x2 = acc[ai][1][m][n][i];
                            o1[n][i] = (x1 * cs - x2 * sn) * sc; o2[n][i] = (x1 * sn + x2 * cs) * sc; }
                    bf16_t* p = dst + ((size_t)((b * 4 + h) * SEQ_ + s)) * 256 + jb;
                    *(u32x4*)p = pack8(o1[0], o1[1]); *(u32x4*)(p + 128) = pack8(o2[0], o2[1]);
                }
        } else if (pn < 16) {
            const int h = (pn - 8) >> 1, eb = ((pn - 8) & 1) * 256 + jb;
#pragma unroll
            for (int ai = 0; ai < 2; ++ai)
#pragma unroll
                for (int m = 0; m < 4; ++m) {
                    const int row = rowb + ai * HALF + m * 16, b = row >> 13, s = row & (SEQ_ - 1);
#pragma unroll
                    for (int bj = 0; bj < 2; ++bj)
#pragma unroll
                        for (int n = 0; n < 2; ++n)
#pragma unroll
                            for (int i = 0; i < 4; ++i) { const int e = eb + 128 * bj + 4 * n + i; VT[((size_t)((b * 4 + h) * 512 + e)) * SEQ_ + s] = f2bf1(acc[ai][bj][m][n][i]); }
                }
        } else {
            const int cb = (pn - 16) * 256 + jb;
#pragma unroll
            for (int ai = 0; ai < 2; ++ai)
#pragma unroll
                for (int m = 0; m < 4; ++m) {
                    const int row = rowb + ai * HALF + m * 16;
#pragma unroll
                    for (int bj = 0; bj < 2; ++bj) *(u32x4*)(G + (size_t)row * 2048 + cb + 128 * bj) = pack8(silu4(acc[ai][bj][m][0]), silu4(acc[ai][bj][m][1]));
                }
        }
    }
};
struct EpiDiffIn {
    static constexpr bool PERM = true, AFTER_DRAIN = false;
    bf16_t *Q, *K, *VT; float qscale;
    __device__ __forceinline__ void operator()(const f32x4 (&acc)[2][2][4][2], const Unit& u, int wr, int wc, int fr, int fq) const {
        const int pn = u.pn, jb = wc * 32 + 8 * fq, rowb = u.pm * BM + wr * 64 + fr;
        if (pn < 8) {
            bf16_t* dst = pn < 4 ? Q : K; const float sc = pn < 4 ? qscale : 1.0f; const int cb = (pn & 3) * 256 + jb;
#pragma unroll
            for (int ai = 0; ai < 2; ++ai)
#pragma unroll
                for (int m = 0; m < 4; ++m) {
                    const int row = rowb + ai * HALF + m * 16;
#pragma unroll
                    for (int bj = 0; bj < 2; ++bj) *(u32x4*)(dst + (size_t)row * 1024 + cb + 128 * bj) = pack8(acc[ai][bj][m][0] * sc, acc[ai][bj][m][1] * sc);
                }
        } else {
#pragma unroll
            for (int ai = 0; ai < 2; ++ai)
#pragma unroll
                for (int m = 0; m < 4; ++m) {
                    const int row = rowb + ai * HALF + m * 16, b = row >> 13, s = row & (SEQ_ - 1);
#pragma unroll
                    for (int bj = 0; bj < 2; ++bj) { const int h = (pn - 8) * 2 + bj;
#pragma unroll
                        for (int n = 0; n < 2; ++n)
#pragma unroll
                            for (int i = 0; i < 4; ++i) { const int e = jb + 4 * n + i; VT[((size_t)((b * 8 + h) * 128 + e)) * SEQ_ + s] = f2bf1(acc[ai][bj][m][n][i]); } }
                }
        }
    }
};
struct EpiSwiGLU {
    static constexpr bool PERM = true, AFTER_DRAIN = false;
    bf16_t* ACT;
    __device__ __forceinline__ void operator()(const f32x4 (&acc)[2][2][4][2], const Unit& u, int wr, int wc, int fr, int fq) const {
        const int cb = u.pn * 128 + wc * 32 + 8 * fq, rowb = u.pm * BM + wr * 64 + fr;
#pragma unroll
        for (int ai = 0; ai < 2; ++ai)
#pragma unroll
            for (int m = 0; m < 4; ++m) {
                const int row = rowb + ai * HALF + m * 16;
                *(u32x4*)(ACT + (size_t)row * 2816 + cb) = pack8(silu4(acc[ai][0][m][0]) * acc[ai][1][m][0], silu4(acc[ai][0][m][1]) * acc[ai][1][m][1]);
            }
    }
};
struct EpiNormResNorm {
    static constexpr bool PERM = false, AFTER_DRAIN = true;
    const float* base; float* out; bf16_t* xn; const float* g1; const float* g2;
    float* xbuf;
    unsigned* cnt;
    float eps; int dry;
    __device__ __forceinline__ void fused(f32x4 (&acc)[2][2][4][2], const Unit& u, int wr, int wc, int fr, int fq, PG8_LAS unsigned char* lds, int wid, int lane) const {
        typedef float f32x2v __attribute__((ext_vector_type(2)));
        PG8_LAS f32x4* P = (PG8_LAS f32x4*)lds;
        PG8_LAS f32x2v* S = (PG8_LAS f32x2v*)(lds + 16384);
        const int col0 = u.pn * BM + wc * 32 + 4 * fq;
        f32x4 gv[2][2];
#pragma unroll
        for (int bj = 0; bj < 2; ++bj)
#pragma unroll
            for (int n = 0; n < 2; ++n) gv[bj][n] = *(const f32x4*)(g1 + col0 + bj * HALF + n * 16);
#pragma unroll
        for (int ai = 0; ai < 2; ++ai)
#pragma unroll
            for (int m = 0; m < 4; ++m) { const int r = ai * HALF + wr * 64 + m * 16 + fr; const size_t off = (size_t)(u.pm * BM + r) * 1024 + col0;
                float s0 = 0.f, s1 = 0.f, s2 = 0.f, s3 = 0.f;
#pragma unroll
                for (int bj = 0; bj < 2; ++bj)
#pragma unroll
                    for (int n = 0; n < 2; ++n) { const f32x4 bs = *(const f32x4*)(base + off + bj * HALF + n * 16), a = acc[ai][bj][m][n], ag = a * gv[bj][n];
                        s0 += (a[0] * a[0] + a[1] * a[1]) + (a[2] * a[2] + a[3] * a[3]); s1 += (bs[0] * bs[0] + bs[1] * bs[1]) + (bs[2] * bs[2] + bs[3] * bs[3]);
                        s2 += (bs[0] * ag[0] + bs[1] * ag[1]) + (bs[2] * ag[2] + bs[3] * ag[3]); s3 += (ag[0] * ag[0] + ag[1] * ag[1]) + (ag[2] * ag[2] + ag[3] * ag[3]); }
                s0 += __shfl_xor(s0, 16); s0 += __shfl_xor(s0, 32); s1 += __shfl_xor(s1, 16); s1 += __shfl_xor(s1, 32);
                s2 += __shfl_xor(s2, 16); s2 += __shfl_xor(s2, 32); s3 += __shfl_xor(s3, 16); s3 += __shfl_xor(s3, 32);
                if (fq == 0) P[r * 4 + wc] = (f32x4){s0, s1, s2, s3};
                if (m & 1) asm volatile("" ::: "memory"); }
        asm volatile("s_waitcnt lgkmcnt(0)" ::: "memory"); __builtin_amdgcn_s_barrier(); asm volatile("" ::: "memory");
        const int row = wid * 32 + (lane & 31);
        if (lane < 32) {
            const f32x4 t = (P[row * 4 + 0] + P[row * 4 + 1]) + (P[row * 4 + 2] + P[row * 4 + 3]);
            float* slot = xbuf + ((size_t)(u.pm * BM + row) * 4 + u.pn);
#pragma unroll
            for (int c = 0; c < 4; ++c) __hip_atomic_store(slot + (size_t)c * 16384 * 4, t[c], __ATOMIC_RELAXED, __HIP_MEMORY_SCOPE_AGENT);
        }
        asm volatile("s_waitcnt vmcnt(0)" ::: "memory");
        if (lane == 0) __hip_atomic_fetch_add(cnt + 64 * u.pm, 1u, __ATOMIC_RELAXED, __HIP_MEMORY_SCOPE_AGENT);
        if (wid == 0) {
            unsigned spins = 0;
            for (;;) {
                if ((unsigned)__builtin_amdgcn_readfirstlane(__hip_atomic_load(cnt + 64 * u.pm, __ATOMIC_RELAXED, __HIP_MEMORY_SCOPE_AGENT)) >= 32u) break;
                if (++spins > (1u << 24)) break;
                __builtin_amdgcn_s_sleep(1);
            }
            __builtin_amdgcn_fence(__ATOMIC_ACQUIRE, "agent");
        }
        asm volatile("s_waitcnt vmcnt(0) lgkmcnt(0)" ::: "memory"); __builtin_amdgcn_s_barrier(); asm volatile("" ::: "memory");
        if (lane < 32) {
            const float* slot = xbuf + (size_t)(u.pm * BM + row) * 4; float q[4];
#pragma unroll
            for (int c = 0; c < 4; ++c) { float v = 0.f;
#pragma unroll
                for (int t = 0; t < 4; ++t) v += __hip_atomic_load(slot + (size_t)c * 16384 * 4 + t, __ATOMIC_RELAXED, __HIP_MEMORY_SCOPE_AGENT);
                q[c] = v; }
            const float r1 = 1.0f / sqrtf(q[0] * (1.0f / 1024.0f) + eps);
            const float ss2 = q[1] + 2.0f * r1 * q[2] + r1 * r1 * q[3];
            S[row] = (f32x2v){r1, 1.0f / sqrtf(fmaxf(ss2, 0.f) * (1.0f / 1024.0f) + eps)};
        }
        asm volatile("s_waitcnt lgkmcnt(0)" ::: "memory"); __builtin_amdgcn_s_barrier(); asm volatile("" ::: "memory");
        f32x4 g2v[2][2];
#pragma unroll
        for (int bj = 0; bj < 2; ++bj)
#pragma unroll
            for (int n = 0; n < 2; ++n) g2v[bj][n] = *(const f32x4*)(g2 + col0 + bj * HALF + n * 16);
#pragma unroll
        for (int ai = 0; ai < 2; ++ai)
#pragma unroll
            for (int m = 0; m < 4; ++m) { const int r = ai * HALF + wr * 64 + m * 16 + fr; const f32x2v sr = S[r]; const size_t off = (size_t)(u.pm * BM + r) * 1024 + col0;
#pragma unroll
                for (int bj = 0; bj < 2; ++bj)
#pragma unroll
                    for (int n = 0; n < 2; ++n) { const f32x4 bs = *(const f32x4*)(base + off + bj * HALF + n * 16); const f32x4 x1 = bs + acc[ai][bj][m][n] * sr.x * gv[bj][n];
                        const f32x4 o = x1 * sr.y * g2v[bj][n]; u32x2 w; w.x = cvt_pk_bf16(o[0], o[1]); w.y = cvt_pk_bf16(o[2], o[3]);
                        if (!dry || x1[0] == 1.2345e38f) { *(f32x4*)(out + off + bj * HALF + n * 16) = x1; *(u32x2*)(xn + off + bj * HALF + n * 16) = w; } }
                if (m & 1) asm volatile("" ::: "memory"); }
    }
};

struct EpiNull {
    static constexpr bool PERM = false, AFTER_DRAIN = true;
    float* sink;
    __device__ __forceinline__ void fused(f32x4 (&acc)[2][2][4][2], const Unit& u, int wr, int wc, int fr, int fq, PG8_LAS unsigned char* lds, int wid, int lane) const {
        float t = 0.f;
#pragma unroll
        for (int ai = 0; ai < 2; ++ai)
#pragma unroll
            for (int bj = 0; bj < 2; ++bj)
#pragma unroll
                for (int m = 0; m < 4; ++m)
#pragma unroll
                    for (int n = 0; n < 2; ++n) t += (acc[ai][bj][m][n][0] + acc[ai][bj][m][n][1]) + (acc[ai][bj][m][n][2] + acc[ai][bj][m][n][3]);
        if (t == 1.2345e38f) sink[0] = t;
    }
};
template <class Epi, class Sched, bool ALIGN_EPI = false, bool SP2 = false>
__device__ __forceinline__ void gemm_phase(PG8_LAS unsigned char* lds, const Gemm g, const Sched& S, const Epi& E) {
    int tid_ = threadIdx.x; asm volatile("" : "+v"(tid_)); const int tid = tid_, wid = __builtin_amdgcn_readfirstlane(tid >> 6), lane = tid & 63, wr = wid >> 2, wc = wid & 3, fr = lane & 15, fq = lane >> 4;
    const int K = g.K, nt = K / BK;
    unsigned voffA[2], voffB[2];
#pragma unroll
    for (int i = 0; i < 2; ++i) { int R, C; stage_rc(tid * 16 + i * 8192, R, C); const int Rb = Epi::PERM ? ((R & ~31) + perm32(R & 31)) : R;
        voffA[i] = (unsigned)(R * K + C) * 2u; voffB[i] = (unsigned)(Rb * K + C) * 2u; }
    const size_t kstep = (size_t)(BK * 2);
    const size_t hstep = (size_t)HALF * K * 2;
    const size_t tstep = 2 * hstep;
    const unsigned ldsw = (unsigned)wid * 1024u;
    const int aoff = lds_byte(wr * 64 + fr, fq * 8), boff = lds_byte(wc * 32 + fr, fq * 8);
#define PG8_SA(b, h) (((b) * 2 + (h)) * HTB)
#define PG8_SB(b, h) ((4 + (b) * 2 + (h)) * HTB)
#define PG8_STAGE(bufoff, gbase, voff) do { _Pragma("unroll") for (int _i = 0; _i < 2; ++_i) \
        __builtin_amdgcn_global_load_lds((const unsigned*)((const char*)(gbase) + (voff)[_i]), (PG8_LAS unsigned*)(lds + (bufoff) + ldsw + _i * 8192), 16, 0, 0); } while (0)
#define PG8_LDA(dst, b, h) do { _Pragma("unroll") for (int m = 0; m < 4; ++m) _Pragma("unroll") for (int k = 0; k < 2; ++k) dst[m][k] = *(const PG8_LAS bf16x8*)(lds + PG8_SA(b, h) + aoff + m * 2048 + k * 1024); } while (0)
#define PG8_LDB(dst, b, h) do { _Pragma("unroll") for (int n = 0; n < 2; ++n) _Pragma("unroll") for (int k = 0; k < 2; ++k) dst[n][k] = *(const PG8_LAS bf16x8*)(lds + PG8_SB(b, h) + boff + n * 2048 + k * 1024); } while (0)
#define PG8_MMA(ai, bj, At, Bt) do { __builtin_amdgcn_s_setprio(1); _Pragma("unroll") for (int m = 0; m < 4; ++m) _Pragma("unroll") for (int n = 0; n < 2; ++n) _Pragma("unroll") for (int k = 0; k < 2; ++k) \
        acc[ai][bj][m][n] = __builtin_amdgcn_mfma_f32_16x16x32_bf16(Bt[n][k], At[m][k], acc[ai][bj][m][n], 0, 0, 0); __builtin_amdgcn_s_setprio(0); } while (0)
#define PG8_WAIT_V(n) asm volatile("s_waitcnt vmcnt(" #n ")" ::: "memory")
#define PG8_WAIT_L(n) asm volatile("s_waitcnt lgkmcnt(" #n ")" ::: "memory")
#define PG8_BAR __builtin_amdgcn_s_barrier()
#define PG8_SCHED __builtin_amdgcn_sched_barrier(0)
    Unit cur, nxt; int ui = 0;
    if (!S.next(0, cur)) return;
    f32x4 acc[2][2][4][2];
#pragma unroll
    for (int a = 0; a < 2; ++a)
#pragma unroll
        for (int b = 0; b < 2; ++b)
#pragma unroll
            for (int m = 0; m < 4; ++m)
#pragma unroll
                for (int n = 0; n < 2; ++n) acc[a][b][m][n] = (f32x4){0.f, 0.f, 0.f, 0.f};
    bf16x8 At[4][2], B0[2][2], B1[2][2];
    const char* cA = (const char*)g.A + (size_t)cur.pm * tstep; const char* cB = (const char*)g.Bt + (size_t)cur.pn * tstep;
    S.a_ready(cur);
    if constexpr (SP2) {
        PG8_STAGE(PG8_SB(0, 0), cB, voffB); PG8_STAGE(PG8_SB(0, 1), cB + hstep, voffB); PG8_STAGE(PG8_SA(0, 0), cA, voffA); PG8_STAGE(PG8_SA(0, 1), cA + hstep, voffA);
        if (wr == 1) PG8_BAR;
        PG8_WAIT_V(2); PG8_BAR;
        PG8_STAGE(PG8_SB(1, 0), cB + kstep, voffB); PG8_STAGE(PG8_SA(1, 0), cA + kstep, voffA); PG8_STAGE(PG8_SB(1, 1), cB + hstep + kstep, voffB);
        PG8_WAIT_V(6); PG8_BAR;
    } else {
        PG8_STAGE(PG8_SB(0, 0), cB, voffB); PG8_STAGE(PG8_SA(0, 0), cA, voffA); PG8_STAGE(PG8_SB(0, 1), cB + hstep, voffB); PG8_STAGE(PG8_SA(0, 1), cA + hstep, voffA);
        if (wr == 1) PG8_BAR;
        PG8_WAIT_V(4); PG8_BAR;
        PG8_STAGE(PG8_SB(1, 0), cB + kstep, voffB); PG8_STAGE(PG8_SA(1, 0), cA + kstep, voffA); PG8_STAGE(PG8_SB(1, 1), cB + hstep + kstep, voffB);
        PG8_WAIT_V(6); PG8_BAR;
    }
    for (;;) {
        const bool has_next = S.next(ui + 1, nxt);
        const char* nA = has_next ? (const char*)g.A + (size_t)nxt.pm * tstep : cA; const char* nB = has_next ? (const char*)g.Bt + (size_t)nxt.pn * tstep : cB;
        for (int t = 0; t < nt; t += 2) {
            const bool last = (t == nt - 2);
            const char* a1 = cA + (size_t)(t + 1) * kstep;
            const char* a2 = last ? nA : cA + (size_t)(t + 2) * kstep; const char* b2 = last ? nB : cB + (size_t)(t + 2) * kstep;
            const char* a3 = a2 + kstep; const char* b3 = b2 + kstep;
            if (last && has_next) S.a_ready(nxt);
            if constexpr (SP2) {
            PG8_LDB(B0, 0, 0); PG8_LDB(B1, 0, 1); PG8_SCHED; PG8_LDA(At, 0, 0); PG8_STAGE(PG8_SA(1, 1), a1 + hstep, voffA);
            PG8_WAIT_V(8); PG8_WAIT_L(0); PG8_BAR; PG8_MMA(0, 0, At, B0); PG8_MMA(0, 1, At, B1); PG8_BAR; PG8_SCHED;
            PG8_LDA(At, 0, 1); PG8_STAGE(PG8_SB(0, 0), b2, voffB); PG8_STAGE(PG8_SB(0, 1), b2 + hstep, voffB); PG8_STAGE(PG8_SA(0, 0), a2, voffA);
            PG8_WAIT_V(8); PG8_WAIT_L(0); PG8_BAR; PG8_MMA(1, 0, At, B0); PG8_MMA(1, 1, At, B1); PG8_BAR; PG8_SCHED;
            PG8_LDB(B0, 1, 0); PG8_LDB(B1, 1, 1); PG8_SCHED; PG8_LDA(At, 1, 0); PG8_STAGE(PG8_SA(0, 1), a2 + hstep, voffA);
            PG8_WAIT_V(8); PG8_WAIT_L(0); PG8_BAR; PG8_MMA(0, 0, At, B0); PG8_MMA(0, 1, At, B1); PG8_BAR; PG8_SCHED;
            PG8_LDA(At, 1, 1); PG8_STAGE(PG8_SB(1, 0), b3, voffB); PG8_STAGE(PG8_SB(1, 1), b3 + hstep, voffB); PG8_STAGE(PG8_SA(1, 0), a3, voffA);
            PG8_WAIT_V(8); PG8_WAIT_L(0); PG8_BAR; PG8_MMA(1, 0, At, B0); PG8_MMA(1, 1, At, B1); PG8_BAR; PG8_SCHED;
            } else {
            PG8_LDB(B0, 0, 0); PG8_SCHED; PG8_LDA(At, 0, 0); PG8_STAGE(PG8_SA(1, 1), a1 + hstep, voffA);
            PG8_WAIT_L(8); PG8_BAR; PG8_WAIT_L(0); PG8_MMA(0, 0, At, B0); PG8_BAR; PG8_SCHED;
            PG8_LDB(B1, 0, 1); PG8_STAGE(PG8_SB(0, 0), b2, voffB);
            PG8_BAR; PG8_WAIT_L(0); PG8_MMA(0, 1, At, B1); PG8_BAR;
            PG8_LDA(At, 0, 1); PG8_STAGE(PG8_SA(0, 0), a2, voffA);
            PG8_BAR; PG8_WAIT_L(0); PG8_MMA(1, 0, At, B0); PG8_BAR; PG8_SCHED;
            PG8_STAGE(PG8_SB(0, 1), b2 + hstep, voffB);
            PG8_WAIT_V(6); PG8_BAR; PG8_MMA(1, 1, At, B1); PG8_BAR;
            PG8_LDB(B0, 1, 0); PG8_SCHED; PG8_LDA(At, 1, 0); PG8_STAGE(PG8_SA(0, 1), a2 + hstep, voffA);
            PG8_WAIT_L(8); PG8_BAR; PG8_WAIT_L(0); PG8_MMA(0, 0, At, B0); PG8_BAR; PG8_SCHED;
            PG8_LDB(B1, 1, 1); PG8_STAGE(PG8_SB(1, 0), b3, voffB);
            PG8_BAR; PG8_WAIT_L(0); PG8_MMA(0, 1, At, B1); PG8_BAR;
            PG8_LDA(At, 1, 1); PG8_STAGE(PG8_SA(1, 0), a3, voffA);
            PG8_BAR; PG8_WAIT_L(0); PG8_MMA(1, 0, At, B0); PG8_BAR; PG8_SCHED;
            PG8_STAGE(PG8_SB(1, 1), b3 + hstep, voffB);
            PG8_WAIT_V(6); PG8_BAR; PG8_MMA(1, 1, At, B1); PG8_BAR;
            }
        }
        if constexpr (ALIGN_EPI) { if (wr == 0) PG8_BAR; }
        if constexpr (!Epi::AFTER_DRAIN) { E(acc, cur, wr, wc, fr, fq); S.done(cur); }
        if (!has_next) break;
#pragma unroll
        for (int a = 0; a < 2; ++a)
#pragma unroll
            for (int b = 0; b < 2; ++b)
#pragma unroll
                for (int m = 0; m < 4; ++m)
#pragma unroll
                    for (int n = 0; n < 2; ++n) acc[a][b][m][n] = (f32x4){0.f, 0.f, 0.f, 0.f};
        cur = nxt; cA = nA; cB = nB; ++ui;
        if constexpr (ALIGN_EPI) { if (wr == 1) PG8_BAR; }
    }
    PG8_WAIT_V(0);
    if constexpr (!ALIGN_EPI) { if (wr == 0) PG8_BAR; }
    PG8_BAR;
    if constexpr (Epi::AFTER_DRAIN) { E.fused(acc, cur, wr, wc, fr, fq, lds, wid, lane); S.done(cur); }
#undef PG8_SA
#undef PG8_SB
#undef PG8_STAGE
#undef PG8_LDA
#undef PG8_LDB
#undef PG8_MMA
#undef PG8_WAIT_V
#undef PG8_WAIT_L
#undef PG8_BAR
#undef PG8_SCHED
}
}
#ifndef R2_SKIP
#define R2_SKIP 0
#endif
#ifndef PROBE_DUP
#define PROBE_DUP 0
#endif

#define LAS __attribute__((address_space(3)))
typedef unsigned short bf16;
typedef unsigned v4u __attribute__((ext_vector_type(4)));
typedef float f32x4 __attribute__((ext_vector_type(4)));
using pg8::bf2f; using pg8::f2bf1;
constexpr int NWAVES = 8, NTHR = 512, GRID = 256;
constexpr int SEQ = 8192, D = 1024, M = 2 * SEQ, FF = 2816, DEPTH = 4;
constexpr int RET_IN = 6144, DIFF_IN = 3072;
constexpr float RMS_EPS = 1e-6f;
constexpr float LOG2E = 1.4426950408889634f;
constexpr size_t MiB = 1u << 20;
constexpr size_t WS_CTL = 0, CTL_ZERO_BYTES = 1 * MiB;
constexpr size_t WS_TAB = 640 * 1024;
constexpr size_t WS_X = 1 * MiB;
constexpr size_t WS_WIN = 2 * MiB, WS_WOUT = 14 * MiB, WS_WGU = 18 * MiB, WS_WDN = 29 * MiB;
constexpr size_t WS_Q = 35 * MiB, WS_K = 67 * MiB, WS_VT = 99 * MiB, WS_G = 163 * MiB, WS_ST = 227 * MiB, WS_END = 291 * MiB;
constexpr size_t WS_XN = WS_ST, WS_ACT = WS_K;
constexpr int CW_BAR = 131072;
constexpr int CW_CNT = 1024;
constexpr int LDS_BYTES = 147456;
#ifndef MFMA_SCAN
#define MFMA_SCAN 1
#endif
#ifndef MFMA_ROUT
#define MFMA_ROUT 1
#endif
#ifndef MFMA_ATTN
#define MFMA_ATTN 1
#endif
#ifndef PER_PHASE_LAUNCH
#define PER_PHASE_LAUNCH 1
#endif
#ifndef NAIVE_MIXERS
#define NAIVE_MIXERS 0
#endif

struct Args { const float* in[12]; float* out; unsigned char* ws; };

__device__ __forceinline__ unsigned pk2(float lo, float hi) { return (unsigned)f2bf1(lo) | ((unsigned)f2bf1(hi) << 16); }
__device__ __forceinline__ float wave_sum(float v) {
#pragma unroll
    for (int o = 1; o < 64; o <<= 1) v += __shfl_xor(v, o);
    return v;
}
__device__ __forceinline__ float dot8(v4u a, v4u b) {
    float s = 0.f;
#pragma unroll
    for (int i = 0; i < 4; ++i) { s += __uint_as_float(a[i] << 16) * __uint_as_float(b[i] << 16); s += __uint_as_float(a[i] & 0xffff0000u) * __uint_as_float(b[i] & 0xffff0000u); }
    return s;
}
struct TrItem { const float* W; int Nsrc, K, k0, c0, r0; };
__device__ __forceinline__ void tr_load(float (&v)[32], const TrItem& t, int lane) {
#pragma unroll
    for (int i = 0; i < 32; ++i) { const int kk = 2 * i + (lane >> 5); v[i] = t.W[(size_t)(t.k0 + kk) * t.Nsrc + t.c0 + (lane & 31)]; }
}
__device__ __forceinline__ void tr_finish(const float (&v)[32], const TrItem& t, bf16* WT, LAS float* scr, int lane) {
#pragma unroll
    for (int i = 0; i < 32; ++i) { const int kk = 2 * i + (lane >> 5); scr[kk * 33 + (lane & 31)] = v[i]; }
    asm volatile("s_waitcnt lgkmcnt(0)" ::: "memory");
    const int c = lane & 7;
#pragma unroll
    for (int j = 0; j < 4; ++j) { const int n = (lane >> 3) + 8 * j; const LAS float* s = scr + (8 * c) * 33 + n;
        v4u o; o.x = pk2(s[0 * 33], s[1 * 33]); o.y = pk2(s[2 * 33], s[3 * 33]); o.z = pk2(s[4 * 33], s[5 * 33]); o.w = pk2(s[6 * 33], s[7 * 33]);
        *(v4u*)(WT + (size_t)(t.r0 + n) * t.K + t.k0 + 8 * c) = o; }
    asm volatile("s_waitcnt lgkmcnt(0)" ::: "memory");
}
__device__ __forceinline__ TrItem item_plain(const float* W, int K, int N, int it) { const int nblk = N / 32, kb = it / nblk, nb = it % nblk; return TrItem{W, N, K, 64 * kb, 32 * nb, 32 * nb}; }
__device__ __forceinline__ TrItem item_gu(const float* Wg, const float* Wu, int it) { const int nblk = FF / 32, nit = (D / 64) * nblk, which = it >= nit, r = which ? it - nit : it, kb = r / nblk, nb = r % nblk, c0 = 32 * nb;
    return TrItem{which ? Wu : Wg, FF, D, 64 * kb, c0, 256 * (c0 >> 7) + 128 * which + (c0 & 127)}; }
#define CONV_LOOP(NIT, ITEM, WT) do { const int nit_ = (NIT); float va_[32], vb_[32]; int it_ = gw; \
        if (it_ < nit_) { const TrItem ta_ = ITEM(it_); tr_load(va_, ta_, lane); } \
        while (it_ < nit_) { \
            { const TrItem ta_ = ITEM(it_); const int nx_ = it_ + ngw; if (nx_ < nit_) { const TrItem tb_ = ITEM(nx_); tr_load(vb_, tb_, lane); } tr_finish(va_, ta_, (WT), scr, lane); it_ = nx_; } \
            if (it_ >= nit_) break; \
            { const TrItem tb_ = ITEM(it_); const int nx_ = it_ + ngw; if (nx_ < nit_) { const TrItem ta_ = ITEM(nx_); tr_load(va_, ta_, lane); } tr_finish(vb_, tb_, (WT), scr, lane); it_ = nx_; } \
        } } while (0)
__device__ __forceinline__ void conv_plain(const float* W, int K, int N, bf16* WT, LAS float* scr, int gw, int ngw, int lane) {
#define ITEM_(i) item_plain(W, K, N, (i))
    for (int rep_ = 0; rep_ < ((PROBE_DUP & 256) ? 2 : 1); ++rep_) CONV_LOOP((K / 64) * (N / 32), ITEM_, WT);
#undef ITEM_
}
__device__ __forceinline__ void conv_gu(const float* Wg, const float* Wu, bf16* WT, LAS float* scr, int gw, int ngw, int lane) {
#define ITEM_(i) item_gu(Wg, Wu, (i))
    for (int rep_ = 0; rep_ < ((PROBE_DUP & 256) ? 2 : 1); ++rep_) CONV_LOOP(2 * (D / 64) * (FF / 32), ITEM_, WT);
#undef ITEM_
}
__device__ __forceinline__ void rms_row_to_bf16(const float* xrow, const float* g, bf16* orow, int lane) {
    const f32x4* xr = (const f32x4*)xrow + lane; const f32x4* gr = (const f32x4*)g + lane;
    f32x4 v[4]; float s2 = 0.f;
#pragma unroll
    for (int j = 0; j < 4; ++j) { v[j] = xr[64 * j]; s2 += (v[j].x * v[j].x + v[j].y * v[j].y) + (v[j].z * v[j].z + v[j].w * v[j].w); }
    const float rstd = 1.f / sqrtf(wave_sum(s2) * (1.f / D) + RMS_EPS);
    unsigned long long* o8 = (unsigned long long*)orow + lane;
#pragma unroll
    for (int j = 0; j < 4; ++j) { const f32x4 gg = gr[64 * j]; o8[64 * j] = (unsigned long long)pk2(v[j].x * rstd * gg.x, v[j].y * rstd * gg.y) | ((unsigned long long)pk2(v[j].z * rstd * gg.z, v[j].w * rstd * gg.w) << 32); }
}

__device__ __forceinline__ float head_log2_gamma(int h) { return __builtin_log2f(1.0f - __builtin_exp2f(-5.0f - (float)h)); }
__device__ __forceinline__ void ret_scan_naive(const bf16* K, const bf16* VT, bf16* ST) {
    const int gid = blockIdx.x * NTHR + threadIdx.x;
    const int bh = gid >> 14, rem = gid & 16383, e = rem >> 5, d0 = (rem & 31) * 8;
    const float lg2 = head_log2_gamma(bh & 3), cd = __builtin_exp2f(256.f * lg2);
    float st[8];
#pragma unroll
    for (int j = 0; j < 8; ++j) st[j] = 0.f;
    const bf16* vt = VT + ((size_t)(bh * 512 + e)) * SEQ; const bf16* kp = K + (size_t)bh * SEQ * 256 + d0;
    for (int c2 = 0; c2 < 32; ++c2) {
        v4u o; o.x = pk2(st[0], st[1]); o.y = pk2(st[2], st[3]); o.z = pk2(st[4], st[5]); o.w = pk2(st[6], st[7]);
        *(v4u*)(ST + (((size_t)(bh * 32 + c2)) * 512 + e) * 256 + d0) = o;
#pragma unroll
        for (int j = 0; j < 8; ++j) st[j] *= cd;
        for (int m = 0; m < 256; ++m) { const int t = c2 * 256 + m; const float v = bf2f(vt[t]) * __builtin_exp2f((float)(255 - m) * lg2);
            const v4u kk = *(const v4u*)(kp + (size_t)t * 256);
#pragma unroll
            for (int i = 0; i < 4; ++i) { st[2 * i] += v * __uint_as_float(kk[i] << 16); st[2 * i + 1] += v * __uint_as_float(kk[i] & 0xffff0000u); } }
    }
}
__device__ __forceinline__ void ret_out_naive(LAS unsigned char* lds, const bf16* Q, const bf16* K, const bf16* VT, bf16* GY, const bf16* ST) {
    LAS bf16* Qs = (LAS bf16*)lds; LAS bf16* In = (LAS bf16*)(lds + 128 * 264 * 2); LAS float* ss = (LAS float*)(lds + 2 * 128 * 264 * 2);
    const int tid = threadIdx.x;
    for (int task = blockIdx.x; task < 512; task += gridDim.x) {
        const int bh = task >> 6, c = task & 63, h = bh & 3, odd = c & 1, nk = odd ? 256 : 128, sh = odd ? 8 : 7, tk0 = (c & ~1) * 128, tq0 = c * 128;
        const float lg2 = head_log2_gamma(h);
        __syncthreads();
#pragma unroll
        for (int i = 0; i < 8; ++i) { const int ch = tid + NTHR * i, r = ch >> 5, cc = ch & 31; *(LAS v4u*)(Qs + r * 264 + cc * 8) = *(const v4u*)(Q + ((size_t)(bh * SEQ + tq0 + r)) * 256 + cc * 8); }
        __syncthreads();
        for (int idx = tid; idx < 128 * nk; idx += NTHR) { const int n = idx >> sh, m = idx & (nk - 1), dist = (tq0 + n) - (tk0 + m); float val = 0.f;
            if (dist >= 0) { const bf16* kp = K + ((size_t)(bh * SEQ + tk0 + m)) * 256; float dot = 0.f;
                for (int d8 = 0; d8 < 32; ++d8) dot += dot8(*(const v4u*)(kp + d8 * 8), *(const LAS v4u*)(Qs + n * 264 + d8 * 8));
                val = dot * __builtin_exp2f((float)dist * lg2); }
            In[n * 264 + m] = f2bf1(val); }
        __syncthreads();
        const int n = tid & 127, eq = tid >> 7; const float qdec = __builtin_exp2f((float)(n + 1 + odd * 128) * lg2); float ssq = 0.f;
        const size_t grow = ((size_t)((bh >> 2) * SEQ + tq0 + n)) * 2048 + h * 512;
        for (int ee = 0; ee < 128; ++ee) { const int e = eq * 128 + ee;
            const bf16* vt = VT + ((size_t)(bh * 512 + e)) * SEQ + tk0; float a = 0.f;
            for (int m8 = 0; m8 < nk / 8; ++m8) a += dot8(*(const v4u*)(vt + m8 * 8), *(const LAS v4u*)(In + n * 264 + m8 * 8));
            const bf16* sp = ST + (((size_t)(bh * 32 + (c >> 1))) * 512 + e) * 256; float cr = 0.f;
            for (int d8 = 0; d8 < 32; ++d8) cr += dot8(*(const v4u*)(sp + d8 * 8), *(const LAS v4u*)(Qs + n * 264 + d8 * 8));
            a += qdec * cr; ssq += a * a;
            GY[grow + e] = f2bf1(a * bf2f(GY[grow + e])); }
        ss[eq * 128 + n] = ssq;
        __syncthreads();
        const float rstd = 1.0f / sqrtf(((ss[n] + ss[128 + n]) + (ss[256 + n] + ss[384 + n])) * (1.0f / 512.0f) + RMS_EPS);
        for (int ee = 0; ee < 128; ++ee) { const int e = eq * 128 + ee; GY[grow + e] = f2bf1(bf2f(GY[grow + e]) * rstd); }
    }
}
__device__ __forceinline__ void attn_naive(LAS unsigned char* lds, const bf16* Qd, const bf16* Kd, const bf16* VTd, bf16* Od, const float* lut, float lam, const float* subln, float outscale) {
    LAS float* ss = (LAS float*)lds; LAS bf16* Qs = (LAS bf16*)(lds + 2048);
    const int tid = threadIdx.x, lane = tid & 63, eg = tid >> 6;
    const int w = blockIdx.x, bh = w & 15, g = w >> 4, b = bh >> 3, h = bh & 7;
    for (int ui = 0; ui < 8; ++ui) {
        const int pr = ui >> 1, qb = (ui & 1) ? (32 * pr + 31 - g) : (32 * pr + g);
        const int q = qb * 64 + lane; const size_t qrow = (size_t)(b * SEQ + q);
        __syncthreads();
        if (eg == 0) {
#pragma unroll
            for (int i = 0; i < 16; ++i) *(LAS v4u*)(Qs + lane * 136 + i * 8) = *(const v4u*)(Qd + qrow * 1024 + h * 128 + i * 8);
        }
        __syncthreads();
        const LAS bf16* qv = Qs + lane * 136;
        float o1[16], o2[16], m1 = -1e30f, m2 = -1e30f, l1 = 0.f, l2 = 0.f;
#pragma unroll
        for (int j = 0; j < 16; ++j) { o1[j] = 0.f; o2[j] = 0.f; }
        const int kend = qb * 64 + 64;
        for (int k0 = 0; k0 < kend; k0 += 8) {
            float s1[8], s2[8];
#pragma unroll
            for (int kk = 0; kk < 8; ++kk) { const int key = k0 + kk; const bf16* kp = Kd + ((size_t)(b * SEQ + key)) * 1024 + h * 128; float d1 = 0.f, d2 = 0.f;
#pragma unroll
                for (int i = 0; i < 8; ++i) { d1 += dot8(*(const LAS v4u*)(qv + i * 8), *(const v4u*)(kp + i * 8)); d2 += dot8(*(const LAS v4u*)(qv + 64 + i * 8), *(const v4u*)(kp + 64 + i * 8)); }
                const int rel = q - key; const int idx = rel < 0 ? 0 : (rel > 127 ? 127 : rel); const float bias = lut[h * 128 + idx];
                s1[kk] = rel >= 0 ? d1 + bias : -1e30f; s2[kk] = rel >= 0 ? d2 + bias : -1e30f; asm volatile("" ::: "memory"); }
            float mx1 = m1, mx2 = m2;
#pragma unroll
            for (int kk = 0; kk < 8; ++kk) { mx1 = fmaxf(mx1, s1[kk]); mx2 = fmaxf(mx2, s2[kk]); }
            const float f1 = __builtin_amdgcn_exp2f(m1 - mx1), f2 = __builtin_amdgcn_exp2f(m2 - mx2); m1 = mx1; m2 = mx2; l1 *= f1; l2 *= f2;
#pragma unroll
            for (int j = 0; j < 16; ++j) { o1[j] *= f1; o2[j] *= f2; }
#pragma unroll
            for (int kk = 0; kk < 8; ++kk) { s1[kk] = __builtin_amdgcn_exp2f(s1[kk] - mx1); s2[kk] = __builtin_amdgcn_exp2f(s2[kk] - mx2); l1 += s1[kk]; l2 += s2[kk]; }
#pragma unroll
            for (int j = 0; j < 16; ++j) { const v4u vv = *(const v4u*)(VTd + ((size_t)(bh * 128 + eg * 16 + j)) * SEQ + k0);
#pragma unroll
                for (int i = 0; i < 4; ++i) { const float vl = __uint_as_float(vv[i] << 16), vh = __uint_as_float(vv[i] & 0xffff0000u);
                    o1[j] += s1[2 * i] * vl + s1[2 * i + 1] * vh; o2[j] += s2[2 * i] * vl + s2[2 * i + 1] * vh; } }
        }
        float ssq = 0.f; const float r1 = 1.0f / l1, r2 = lam / l2;
#pragma unroll
        for (int j = 0; j < 16; ++j) { o1[j] = o1[j] * r1 - o2[j] * r2; ssq += o1[j] * o1[j]; }
        __syncthreads();
        ss[eg * 64 + lane] = ssq;
        __syncthreads();
        float sst = 0.f;
#pragma unroll
        for (int i = 0; i < 8; ++i) sst += ss[i * 64 + lane];
        const float rstd = outscale / sqrtf(sst * (1.0f / 128.0f) + RMS_EPS);
#pragma unroll
        for (int j = 0; j < 16; ++j) Od[qrow * 1024 + h * 128 + eg * 16 + j] = f2bf1(o1[j] * rstd * subln[eg * 16 + j]);
    }
}

typedef short bf16x8_t __attribute__((ext_vector_type(8)));
typedef float f32x16 __attribute__((ext_vector_type(16)));
typedef unsigned v2u __attribute__((ext_vector_type(2)));
typedef float f32x2 __attribute__((ext_vector_type(2)));
#define MFMA32(a, b, c) __builtin_amdgcn_mfma_f32_32x32x16_bf16((a), (b), (c), 0, 0, 0)
__device__ __forceinline__ int crow(int i, int hh) { return (i & 3) + 8 * (i >> 2) + 4 * hh; }
__device__ __forceinline__ float xhalf_max(float v) { const auto rr = __builtin_amdgcn_permlane32_swap(__float_as_uint(v), __float_as_uint(v), false, false); return fmaxf(__uint_as_float(rr[0]), __uint_as_float(rr[1])); }
__device__ __forceinline__ float xhalf_sum(float v) { const auto rr = __builtin_amdgcn_permlane32_swap(__float_as_uint(v), __float_as_uint(v), false, false); return __uint_as_float(rr[0]) + __uint_as_float(rr[1]); }
__device__ __forceinline__ float max3f(float a, float b, float c) { float r; asm("v_max3_f32 %0, %1, %2, %3" : "=v"(r) : "v"(a), "v"(b), "v"(c)); return r; }
__device__ __forceinline__ unsigned cvtpk(float lo, float hi) { return pg8::cvt_pk_bf16(lo, hi); }
__device__ __forceinline__ bf16x8_t pack_frag(const f32x16& p, int s) {
    v4u w; w.x = cvtpk(p[8 * s + 0], p[8 * s + 1]); w.y = cvtpk(p[8 * s + 2], p[8 * s + 3]); w.z = cvtpk(p[8 * s + 4], p[8 * s + 5]); w.w = cvtpk(p[8 * s + 6], p[8 * s + 7]);
    return __builtin_bit_cast(bf16x8_t, w);
}
constexpr int AT_KSTR = 136, AT_VSTR = 68, AT_KBUF = 64 * AT_KSTR * 2, AT_VBUF = 128 * AT_VSTR * 2;
constexpr int AT_VOFF = 2 * AT_KBUF, AT_LUT = AT_VOFF + 2 * AT_VBUF;
template <int AMODE = 0> __device__ __forceinline__ void attn_mfma(const int tid, const int bid, LAS unsigned char* lds, const bf16* Qd, const bf16* Kd, const bf16* VTd, bf16* Od, const float* lutg, const float* rel_tab, float lam, const float* subln, float outscale) {
    const int lane = tid & 63, r = lane & 31, hh = lane >> 5;
    const int wave = __builtin_amdgcn_readfirstlane(tid >> 6), mi = wave & 1, g = wave >> 1;
    const int w = bid, bh = w & 15, g16 = w >> 4, b = bh >> 3, h = bh & 7;
    LAS float* lut = (LAS float*)(lds + AT_LUT); LAS float* ex = (LAS float*)lds;
    const float NEG = -1e30f;
    __syncthreads();
    if (tid < 128) lut[tid] = lutg[h * 128 + tid] - rel_tab[31 * 8 + h] * LOG2E;
    const bf16* kg = Kd + ((size_t)(b * SEQ)) * 1024 + h * 128 + (size_t)(tid >> 4) * 1024 + (tid & 15) * 8;
    const bf16* vg = VTd + ((size_t)(bh * 128 + (tid >> 3))) * SEQ + (tid & 7) * 8;
    const int kso = ((tid >> 4) * AT_KSTR + (tid & 15) * 8) * 2, vso = AT_VOFF + ((tid >> 3) * AT_VSTR + (tid & 7) * 8) * 2;
    for (int ui = 0; ui < 4; ++ui) {
        const int qb = ui == 0 ? g16 : (ui == 1 ? 31 - g16 : (ui == 2 ? 32 + g16 : 63 - g16));
        const int qw = qb * 128 + 32 * g, NT = 2 * qb + 2, qabs = qw + r;
        const bf16* qp = Qd + ((size_t)(b * SEQ + qabs)) * 1024 + h * 128 + 64 * mi + 8 * hh;
        bf16x8_t qf[4];
#pragma unroll
        for (int ds = 0; ds < 4; ++ds) qf[ds] = *(const bf16x8_t*)(qp + 16 * ds);
        f32x16 o[4];
#pragma unroll
        for (int dt = 0; dt < 4; ++dt)
#pragma unroll
            for (int i = 0; i < 16; ++i) o[dt][i] = 0.f;
        float mref = 0.f, l = 0.f; bool first = true;
        v4u kr0, kr1, vr0, vr1;
        const int NTw = (qw + 31) / 64 + 1 < NT ? (qw + 31) / 64 + 1 : NT;
        const bool isY = wave >= 4;
#define AT_LOADK(t) do { kr0 = *(const v4u*)(kg + (size_t)(t) * 64 * 1024); kr1 = *(const v4u*)(kg + (size_t)(t) * 64 * 1024 + 32 * 1024); } while (0)
#define AT_LOADV(t) do { vr0 = *(const v4u*)(vg + (t) * 64); vr1 = *(const v4u*)(vg + (size_t)64 * SEQ + (t) * 64); } while (0)
#define AT_STOREK(bf) do { *(LAS v4u*)(lds + (bf) * AT_KBUF + kso) = kr0; *(LAS v4u*)(lds + (bf) * AT_KBUF + kso + 32 * AT_KSTR * 2) = kr1; } while (0)
#define AT_STOREV(bf) do { *(LAS v2u*)(lds + (bf) * AT_VBUF + vso) = (v2u){vr0.x, vr0.y}; *(LAS v2u*)(lds + (bf) * AT_VBUF + vso + 8) = (v2u){vr0.z, vr0.w}; \
        *(LAS v2u*)(lds + (bf) * AT_VBUF + vso + 64 * AT_VSTR * 2) = (v2u){vr1.x, vr1.y}; *(LAS v2u*)(lds + (bf) * AT_VBUF + vso + 64 * AT_VSTR * 2 + 8) = (v2u){vr1.z, vr1.w}; } while (0)
#define AT_SB __builtin_amdgcn_sched_barrier(0)
#define AT_PVB(bv) do { const LAS unsigned char* vb_ = lds + AT_VOFF + (bv) * AT_VBUF + (r * AT_VSTR + 4 * hh) * 2; v4u fa0, fb0, fa1, fb1, fa2, fb2; { const LAS unsigned char* a_ = vb_ + 0 * 32 * AT_VSTR * 2 + 0 * 32; const v2u l0 = *(const LAS v2u*)a_, h0 = *(const LAS v2u*)(a_ + 16), l1 = *(const LAS v2u*)(a_ + 32 * AT_VSTR * 2), h1 = *(const LAS v2u*)(a_ + 32 * AT_VSTR * 2 + 16); fa0 = (v4u){l0.x, l0.y, h0.x, h0.y}; fb0 = (v4u){l1.x, l1.y, h1.x, h1.y}; } AT_SB; { const LAS unsigned char* a_ = vb_ + 2 * 32 * AT_VSTR * 2 + 0 * 32; const v2u l0 = *(const LAS v2u*)a_, h0 = *(const LAS v2u*)(a_ + 16), l1 = *(const LAS v2u*)(a_ + 32 * AT_VSTR * 2), h1 = *(const LAS v2u*)(a_ + 32 * AT_VSTR * 2 + 16); fa1 = (v4u){l0.x, l0.y, h0.x, h0.y}; fb1 = (v4u){l1.x, l1.y, h1.x, h1.y}; } AT_SB; { const LAS unsigned char* a_ = vb_ + 0 * 32 * AT_VSTR * 2 + 1 * 32; const v2u l0 = *(const LAS v2u*)a_, h0 = *(const LAS v2u*)(a_ + 16), l1 = *(const LAS v2u*)(a_ + 32 * AT_VSTR * 2), h1 = *(const LAS v2u*)(a_ + 32 * AT_VSTR * 2 + 16); fa2 = (v4u){l0.x, l0.y, h0.x, h0.y}; fb2 = (v4u){l1.x, l1.y, h1.x, h1.y}; } AT_SB; { __builtin_amdgcn_s_setprio(1); o[0] = MFMA32(__builtin_bit_cast(bf16x8_t, fa0), pb0, o[0]); o[1] = MFMA32(__builtin_bit_cast(bf16x8_t, fb0), pb0, o[1]); __builtin_amdgcn_s_setprio(0); } AT_SB; { const LAS unsigned char* a_ = vb_ + 2 * 32 * AT_VSTR * 2 + 1 * 32; const v2u l0 = *(const LAS v2u*)a_, h0 = *(const LAS v2u*)(a_ + 16), l1 = *(const LAS v2u*)(a_ + 32 * AT_VSTR * 2), h1 = *(const LAS v2u*)(a_ + 32 * AT_VSTR * 2 + 16); fa0 = (v4u){l0.x, l0.y, h0.x, h0.y}; fb0 = (v4u){l1.x, l1.y, h1.x, h1.y}; } AT_SB; { __builtin_amdgcn_s_setprio(1); o[2] = MFMA32(__builtin_bit_cast(bf16x8_t, fa1), pb0, o[2]); o[3] = MFMA32(__builtin_bit_cast(bf16x8_t, fb1), pb0, o[3]); __builtin_amdgcn_s_setprio(0); } AT_SB; { const LAS unsigned char* a_ = vb_ + 0 * 32 * AT_VSTR * 2 + 2 * 32; const v2u l0 = *(const LAS v2u*)a_, h0 = *(const LAS v2u*)(a_ + 16), l1 = *(const LAS v2u*)(a_ + 32 * AT_VSTR * 2), h1 = *(const LAS v2u*)(a_ + 32 * AT_VSTR * 2 + 16); fa1 = (v4u){l0.x, l0.y, h0.x, h0.y}; fb1 = (v4u){l1.x, l1.y, h1.x, h1.y}; } AT_SB; { __builtin_amdgcn_s_setprio(1); o[0] = MFMA32(__builtin_bit_cast(bf16x8_t, fa2), pb1, o[0]); o[1] = MFMA32(__builtin_bit_cast(bf16x8_t, fb2), pb1, o[1]); __builtin_amdgcn_s_setprio(0); } AT_SB; { const LAS unsigned char* a_ = vb_ + 2 * 32 * AT_VSTR * 2 + 2 * 32; const v2u l0 = *(const LAS v2u*)a_, h0 = *(const LAS v2u*)(a_ + 16), l1 = *(const LAS v2u*)(a_ + 32 * AT_VSTR * 2), h1 = *(const LAS v2u*)(a_ + 32 * AT_VSTR * 2 + 16); fa2 = (v4u){l0.x, l0.y, h0.x, h0.y}; fb2 = (v4u){l1.x, l1.y, h1.x, h1.y}; } AT_SB; { __builtin_amdgcn_s_setprio(1); o[2] = MFMA32(__builtin_bit_cast(bf16x8_t, fa0), pb1, o[2]); o[3] = MFMA32(__builtin_bit_cast(bf16x8_t, fb0), pb1, o[3]); __builtin_amdgcn_s_setprio(0); } AT_SB; { const LAS unsigned char* a_ = vb_ + 0 * 32 * AT_VSTR * 2 + 3 * 32; const v2u l0 = *(const LAS v2u*)a_, h0 = *(const LAS v2u*)(a_ + 16), l1 = *(const LAS v2u*)(a_ + 32 * AT_VSTR * 2), h1 = *(const LAS v2u*)(a_ + 32 * AT_VSTR * 2 + 16); fa0 = (v4u){l0.x, l0.y, h0.x, h0.y}; fb0 = (v4u){l1.x, l1.y, h1.x, h1.y}; } AT_SB; { __builtin_amdgcn_s_setprio(1); o[0] = MFMA32(__builtin_bit_cast(bf16x8_t, fa1), pb2, o[0]); o[1] = MFMA32(__builtin_bit_cast(bf16x8_t, fb1), pb2, o[1]); __builtin_amdgcn_s_setprio(0); } AT_SB; { const LAS unsigned char* a_ = vb_ + 2 * 32 * AT_VSTR * 2 + 3 * 32; const v2u l0 = *(const LAS v2u*)a_, h0 = *(const LAS v2u*)(a_ + 16), l1 = *(const LAS v2u*)(a_ + 32 * AT_VSTR * 2), h1 = *(const LAS v2u*)(a_ + 32 * AT_VSTR * 2 + 16); fa1 = (v4u){l0.x, l0.y, h0.x, h0.y}; fb1 = (v4u){l1.x, l1.y, h1.x, h1.y}; } AT_SB; { __builtin_amdgcn_s_setprio(1); o[2] = MFMA32(__builtin_bit_cast(bf16x8_t, fa2), pb2, o[2]); o[3] = MFMA32(__builtin_bit_cast(bf16x8_t, fb2), pb2, o[3]); __builtin_amdgcn_s_setprio(0); } AT_SB; { __builtin_amdgcn_s_setprio(1); o[0] = MFMA32(__builtin_bit_cast(bf16x8_t, fa0), pb3, o[0]); o[1] = MFMA32(__builtin_bit_cast(bf16x8_t, fb0), pb3, o[1]); __builtin_amdgcn_s_setprio(0); } AT_SB; { __builtin_amdgcn_s_setprio(1); o[2] = MFMA32(__builtin_bit_cast(bf16x8_t, fa1), pb3, o[2]); o[3] = MFMA32(__builtin_bit_cast(bf16x8_t, fb1), pb3, o[3]); __builtin_amdgcn_s_setprio(0); } AT_SB; } while (0)
#define AT_QKB(bk) do { const LAS unsigned char* kb_ = lds + (bk) * AT_KBUF + (r * AT_KSTR + 64 * mi + 8 * hh) * 2; v4u fa0, fb0, fa1, fb1, fa2, fb2; { fa0 = *(const LAS v4u*)(kb_ + 0 * 32); fb0 = *(const LAS v4u*)(kb_ + 32 * AT_KSTR * 2 + 0 * 32); } AT_SB; { fa1 = *(const LAS v4u*)(kb_ + 1 * 32); fb1 = *(const LAS v4u*)(kb_ + 32 * AT_KSTR * 2 + 1 * 32); } AT_SB; { fa2 = *(const LAS v4u*)(kb_ + 2 * 32); fb2 = *(const LAS v4u*)(kb_ + 32 * AT_KSTR * 2 + 2 * 32); } AT_SB; { __builtin_amdgcn_s_setprio(1); p0 = MFMA32(__builtin_bit_cast(bf16x8_t, fa0), qf[0], p0); p1 = MFMA32(__builtin_bit_cast(bf16x8_t, fb0), qf[0], p1); __builtin_amdgcn_s_setprio(0); } AT_SB; { fa0 = *(const LAS v4u*)(kb_ + 3 * 32); fb0 = *(const LAS v4u*)(kb_ + 32 * AT_KSTR * 2 + 3 * 32); } AT_SB; { __builtin_amdgcn_s_setprio(1); p0 = MFMA32(__builtin_bit_cast(bf16x8_t, fa1), qf[1], p0); p1 = MFMA32(__builtin_bit_cast(bf16x8_t, fb1), qf[1], p1); __builtin_amdgcn_s_setprio(0); } AT_SB; { __builtin_amdgcn_s_setprio(1); p0 = MFMA32(__builtin_bit_cast(bf16x8_t, fa2), qf[2], p0); p1 = MFMA32(__builtin_bit_cast(bf16x8_t, fb2), qf[2], p1); __builtin_amdgcn_s_setprio(0); } AT_SB; { __builtin_amdgcn_s_setprio(1); p0 = MFMA32(__builtin_bit_cast(bf16x8_t, fa0), qf[3], p0); p1 = MFMA32(__builtin_bit_cast(bf16x8_t, fb0), qf[3], p1); __builtin_amdgcn_s_setprio(0); } AT_SB; } while (0)
#define AT_SOFTMAX(t) do { const int k0 = (t) * 64; \
        if (qw - k0 - 63 < 113) { \
            _Pragma("unroll") for (int i = 0; i < 16; ++i) { const int rel0 = qabs - (k0 + crow(i, hh)), rel1 = rel0 - 32; \
                p0[i] = rel0 < 0 ? NEG : p0[i] + lut[rel0 > 127 ? 127 : rel0]; p1[i] = rel1 < 0 ? NEG : p1[i] + lut[rel1 > 127 ? 127 : rel1]; } } \
        float mt = max3f(p0[0], p0[1], p1[0]), mu = max3f(p0[2], p0[3], p1[1]); mt = max3f(mt, p1[2], p1[3]); \
        _Pragma("unroll") for (int i = 4; i < 16; i += 4) { mt = max3f(mt, p0[i], p0[i + 1]); mu = max3f(mu, p0[i + 2], p0[i + 3]); mt = max3f(mt, p1[i], p1[i + 1]); mu = max3f(mu, p1[i + 2], p1[i + 3]); } \
        mt = xhalf_max(fmaxf(mt, mu)) - mref; \
        if (__any(first ? 1 : (mt > 6.0f))) { \
            const float dl = first ? mt : fmaxf(mt, 0.f), alpha = first ? 1.0f : __builtin_amdgcn_exp2f(-dl); mref += dl; l *= alpha; \
            _Pragma("unroll") for (int dt = 0; dt < 4; ++dt) _Pragma("unroll") for (int i = 0; i < 16; ++i) o[dt][i] *= alpha; \
            first = false; } \
        { f32x2 ls2 = {0.f, 0.f}; const f32x2 nm = {-mref, -mref}; \
          _Pragma("unroll") for (int i = 0; i < 16; i += 2) { f32x2 a = (f32x2){p0[i], p0[i + 1]} + nm, b = (f32x2){p1[i], p1[i + 1]} + nm; \
              a.x = __builtin_amdgcn_exp2f(a.x); a.y = __builtin_amdgcn_exp2f(a.y); b.x = __builtin_amdgcn_exp2f(b.x); b.y = __builtin_amdgcn_exp2f(b.y); \
              p0[i] = a.x; p0[i + 1] = a.y; p1[i] = b.x; p1[i + 1] = b.y; ls2 += a; ls2 += b; } \
          l += ls2.x + ls2.y; } \
        pb0 = pack_frag(p0, 0); pb1 = pack_frag(p0, 1); pb2 = pack_frag(p1, 0); pb3 = pack_frag(p1, 1); } while (0)
        __syncthreads();
        AT_LOADK(0); AT_LOADV(0); AT_STOREK(0); AT_STOREV(0); AT_LOADK(1); AT_STOREK(1);
        __syncthreads();
        if (isY) __syncthreads();
        for (int t = 0; t < NT; ++t) {
            f32x16 p0, p1; bf16x8_t pb0, pb1, pb2, pb3;
#pragma unroll
            for (int i = 0; i < 16; ++i) { p0[i] = 0.f; p1[i] = 0.f; }
            if (t < NTw) AT_QKB(t & 1);
            if (!(AMODE & 4) && t >= 1) { if (t + 1 < NT) AT_STOREK((t + 1) & 1); if (t < NT) AT_STOREV(t & 1); }
            __syncthreads();
            if (!(AMODE & 4)) { if (t + 2 < NT) AT_LOADK(t + 2); if (t + 1 < NT) AT_LOADV(t + 1); }
            if (t < NTw) {
                AT_SOFTMAX(t);
                __syncthreads();
                AT_PVB(t & 1);
            } else __syncthreads();
        }
        __syncthreads();
        if (!isY) __syncthreads();
#undef AT_LOADK
#undef AT_LOADV
#undef AT_STOREK
#undef AT_STOREV
#undef AT_SB
#undef AT_PVB
#undef AT_QKB
#undef AT_SOFTMAX
        l = xhalf_sum(l);
        const float linv = 1.0f / l;
        if (mi == 1) { const float sc = lam * linv;
#pragma unroll
            for (int dt = 0; dt < 4; ++dt)
#pragma unroll
                for (int i = 0; i < 16; ++i) ex[g * 4096 + (32 * dt + crow(i, hh)) * 32 + r] = o[dt][i] * sc; }
        __syncthreads();
        if (mi == 0) { float ssq = 0.f;
#pragma unroll
            for (int dt = 0; dt < 4; ++dt)
#pragma unroll
                for (int i = 0; i < 16; ++i) { const float v = o[dt][i] * linv - ex[g * 4096 + (32 * dt + crow(i, hh)) * 32 + r]; o[dt][i] = v; ssq += v * v; }
            ssq += __shfl_xor(ssq, 32);
            const float rstd = outscale / sqrtf(ssq * (1.0f / 128.0f) + RMS_EPS);
            bf16* op = Od + ((size_t)(b * SEQ + qabs)) * 1024 + h * 128 + 4 * hh;
#pragma unroll
            for (int dt = 0; dt < 4; ++dt)
#pragma unroll
                for (int i4 = 0; i4 < 4; ++i4) { const int dv = 32 * dt + 8 * i4; const f32x4 sg = *(const f32x4*)(subln + dv + 4 * hh);
                    v2u wv; wv.x = cvtpk(o[dt][4 * i4] * rstd * sg[0], o[dt][4 * i4 + 1] * rstd * sg[1]); wv.y = cvtpk(o[dt][4 * i4 + 2] * rstd * sg[2], o[dt][4 * i4 + 3] * rstd * sg[3]);
                    *(v2u*)(op + dv) = wv; }
        }
    }
}

constexpr int R1_STR = 264;
constexpr int R1_TILE = 64 * R1_STR * 2;
__device__ __forceinline__ void ret_scan_mfma(const int tid, const int bid, LAS unsigned char* lds, const bf16* K, const bf16* VT, bf16* ST) {
    const int lane = tid & 63, r = lane & 31, hh = lane >> 5, wave = __builtin_amdgcn_readfirstlane(tid >> 6);
    const int w = bid, bh = w & 7, eb = w >> 5, db = (w >> 3) & 3, h = bh & 3;
    const float lg2 = head_log2_gamma(h), cd = __builtin_exp2f(256.f * lg2);
    const bf16* vg = VT + ((size_t)(bh * 512 + eb * 64 + (tid >> 5))) * SEQ + (tid & 31) * 8;
    const bf16* kg = K + ((size_t)(bh * SEQ + (tid >> 3))) * 256 + db * 64 + (tid & 7) * 8;
    v4u vrA[4], krA[4], vrB[4], krB[4];
#define R1_LOAD(vr, kr, c2) do { _Pragma("unroll") for (int i = 0; i < 4; ++i) { vr[i] = *(const v4u*)(vg + (size_t)(16 * i) * SEQ + (c2) * 256); kr[i] = *(const v4u*)(kg + (size_t)((c2) * 256 + 64 * i) * 256); } } while (0)
#define R1_STORE(vr, kr, bf) do { _Pragma("unroll") for (int i = 0; i < 4; ++i) { \
        *(LAS v4u*)(lds + (bf) * R1_TILE + (((tid >> 5) + 16 * i) * R1_STR + (tid & 31) * 8) * 2) = vr[i]; \
        const int m_ = (tid >> 3) + 64 * i; const float kd_ = __builtin_amdgcn_exp2f((float)(255 - m_) * lg2); \
        LAS bf16* kt_ = (LAS bf16*)(lds + (2 + (bf)) * R1_TILE) + ((tid & 7) * 8) * R1_STR + ((((m_ >> 3) ^ (tid & 7)) << 3) | (m_ & 7)); \
        _Pragma("unroll") for (int q_ = 0; q_ < 4; ++q_) { kt_[(2 * q_) * R1_STR] = f2bf1(__uint_as_float(kr[i][q_] << 16) * kd_); kt_[(2 * q_ + 1) * R1_STR] = f2bf1(__uint_as_float(kr[i][q_] & 0xffff0000u) * kd_); } } } while (0)
    f32x16 acc;
#pragma unroll
    for (int i = 0; i < 16; ++i) acc[i] = 0.f;
    const int et2 = wave & 1, dt2 = (wave >> 1) & 1;
#define R1_COMPUTE(c2) do { if (wave < 4) { \
            bf16* sp = ST + (((size_t)(bh * 32 + (c2))) * 512 + eb * 64 + 32 * et2) * 256 + db * 64 + 32 * dt2 + r; \
            _Pragma("unroll") for (int i = 0; i < 16; ++i) { sp[(size_t)crow(i, hh) * 256] = f2bf1(acc[i]); acc[i] *= cd; } \
            const LAS unsigned char* ab = lds + ((c2) & 1) * R1_TILE + ((32 * et2 + r) * R1_STR + 8 * hh) * 2; \
            const LAS unsigned char* bb = lds + (2 + ((c2) & 1)) * R1_TILE + ((32 * dt2 + r) * R1_STR) * 2; const int bsw = ((r >> 3) + 4 * dt2) & 7; \
            bf16x8_t fa[16], fb[16]; \
            _Pragma("unroll") for (int ks = 0; ks < 16; ++ks) { fa[ks] = *(const LAS bf16x8_t*)(ab + ks * 32); fb[ks] = *(const LAS bf16x8_t*)(bb + (((2 * ks + hh) ^ bsw) * 16)); } \
            _Pragma("unroll") for (int ks = 0; ks < 16; ++ks) acc = MFMA32(fa[ks], fb[ks], acc); } } while (0)
    __syncthreads();
    R1_LOAD(vrA, krA, 0); R1_LOAD(vrB, krB, 1); R1_STORE(vrA, krA, 0);
    __syncthreads();
    for (int c2 = 0; c2 < 32; c2 += 2) {
        if (c2 + 2 < 32) R1_LOAD(vrA, krA, c2 + 2);
        R1_COMPUTE(c2);
        R1_STORE(vrB, krB, 1);
        __syncthreads();
        if (c2 + 3 < 32) R1_LOAD(vrB, krB, c2 + 3);
        R1_COMPUTE(c2 + 1);
        if (c2 + 2 < 32) R1_STORE(vrA, krA, 0);
        __syncthreads();
    }
#undef R1_COMPUTE
#undef R1_LOAD
#undef R1_STORE
}
constexpr int R2_STR = 264, R2_PB = 128 * R2_STR * 2, R2_SOFF = R2_PB, R2_SBUF = 512 * 64, R2_SS = R2_SOFF + 2 * R2_SBUF;
__device__ __forceinline__ void ret_out_mfma(const int tid, const int bid, LAS unsigned char* lds, const bf16* Q, const bf16* K, const bf16* VT, bf16* GY, const bf16* ST, const int dry = 0) {
    const int wave = __builtin_amdgcn_readfirstlane(tid >> 6), nt = wave & 3, eh = wave >> 2;
    LAS float* ssp = (LAS float*)(lds + R2_SS);
#define R2_IDS int t_ = tid; asm volatile("" : "+v"(t_)); const int lane = t_ & 63, r = lane & 31, hh = lane >> 5; \
    const int srow = t_ >> 2, sc4 = t_ & 3, sso = R2_SOFF + srow * 64 + ((sc4 ^ ((srow >> 2) & 3)) * 16), fsw = (r >> 2) & 3, fro = R2_SOFF + (256 * eh + r) * 64; \
    (void)lane; (void)srow; (void)sc4; (void)sso; (void)fsw; (void)fro; (void)hh;
    for (int task = bid; task < 512; task += gridDim.x) {
        const int bh = task >> 6, c = (task & 63) ^ (task >> 8), h = bh & 3, odd = c & 1, tk0 = (c & ~1) * 128, tq0 = c * 128;
        const float lg2 = head_log2_gamma(h);
        f32x16 acc[8];
#pragma unroll
        for (int et = 0; et < 8; ++et)
#pragma unroll
            for (int i = 0; i < 16; ++i) acc[et][i] = 0.f;
        v4u sr[4];
#define R2_QG (Q + ((size_t)(bh * SEQ + tq0 + 32 * nt + r)) * 256 + 8 * hh)
#define R2_LOADS(src, rstride, sl) do { _Pragma("unroll") for (int i = 0; i < 4; ++i) sr[i] = *(const v4u*)((src) + (size_t)(srow + 128 * i) * (rstride) + 32 * (sl) + 8 * sc4); } while (0)
#define R2_STORES(bf) do { _Pragma("unroll") for (int i = 0; i < 4; ++i) *(LAS v4u*)(lds + (bf) * R2_SBUF + sso + 128 * i * 64) = sr[i]; } while (0)
#define R2_AFRAG(bf, et, ksl) (*(const LAS bf16x8_t*)(lds + (bf) * R2_SBUF + fro + (et) * 32 * 64 + (((2 * (ksl) + hh) ^ fsw) * 16)))
#define R2_SB __builtin_amdgcn_sched_barrier(0)
#define R2_SLICE(bf, b0, b1) do { const int bf_ = (bf); const bf16x8_t b0_ = (b0), b1_ = (b1); bf16x8_t fa0, fb0, fa1, fb1, fa2, fb2; { fa0 = R2_AFRAG(bf_, 0, 0); fb0 = R2_AFRAG(bf_, 0, 1); } R2_SB; { fa1 = R2_AFRAG(bf_, 1, 0); fb1 = R2_AFRAG(bf_, 1, 1); } R2_SB; { fa2 = R2_AFRAG(bf_, 2, 0); fb2 = R2_AFRAG(bf_, 2, 1); } R2_SB; { acc[0] = MFMA32(fa0, b0_, acc[0]); acc[0] = MFMA32(fb0, b1_, acc[0]); } R2_SB; { fa0 = R2_AFRAG(bf_, 3, 0); fb0 = R2_AFRAG(bf_, 3, 1); } R2_SB; { acc[1] = MFMA32(fa1, b0_, acc[1]); acc[1] = MFMA32(fb1, b1_, acc[1]); } R2_SB; { fa1 = R2_AFRAG(bf_, 4, 0); fb1 = R2_AFRAG(bf_, 4, 1); } R2_SB; { acc[2] = MFMA32(fa2, b0_, acc[2]); acc[2] = MFMA32(fb2, b1_, acc[2]); } R2_SB; { fa2 = R2_AFRAG(bf_, 5, 0); fb2 = R2_AFRAG(bf_, 5, 1); } R2_SB; { acc[3] = MFMA32(fa0, b0_, acc[3]); acc[3] = MFMA32(fb0, b1_, acc[3]); } R2_SB; { fa0 = R2_AFRAG(bf_, 6, 0); fb0 = R2_AFRAG(bf_, 6, 1); } R2_SB; { acc[4] = MFMA32(fa1, b0_, acc[4]); acc[4] = MFMA32(fb1, b1_, acc[4]); } R2_SB; { fa1 = R2_AFRAG(bf_, 7, 0); fb1 = R2_AFRAG(bf_, 7, 1); } R2_SB; { acc[5] = MFMA32(fa2, b0_, acc[5]); acc[5] = MFMA32(fb2, b1_, acc[5]); } R2_SB; { acc[6] = MFMA32(fa0, b0_, acc[6]); acc[6] = MFMA32(fb0, b1_, acc[6]); } R2_SB; { acc[7] = MFMA32(fa1, b0_, acc[7]); acc[7] = MFMA32(fb1, b1_, acc[7]); } R2_SB; } while (0)
        if (!(dry && (R2_SKIP & 1))) { R2_IDS const bf16* qg = R2_QG; const bf16* src = ST + (((size_t)(bh * 32 + (c >> 1))) * 512) * 256;
          __syncthreads();
          R2_LOADS(src, 256, 0); R2_STORES(0);
          __syncthreads();
          for (int sl = 0; sl < 8; ++sl) {
              if (sl + 1 < 8) R2_LOADS(src, 256, sl + 1);
              const bf16x8_t bq0 = *(const bf16x8_t*)(qg + 32 * sl), bq1 = *(const bf16x8_t*)(qg + 32 * sl + 16);
              R2_SLICE(sl & 1, bq0, bq1);
              if (sl + 1 < 8) R2_STORES((sl + 1) & 1);
              __syncthreads();
          } }
        { R2_IDS const float qdec = __builtin_amdgcn_exp2f((float)(32 * nt + r + 1 + odd * 128) * lg2);
#pragma unroll
          for (int et = 0; et < 8; ++et)
#pragma unroll
              for (int i = 0; i < 16; ++i) acc[et][i] *= qdec; }
        const int nmt = odd ? 4 + nt + 1 : nt + 1;
        if (!(dry && (R2_SKIP & 2))) { R2_IDS
#pragma unroll
            for (int i = 0; i < 8; ++i) { const int ch = t_ + NTHR * i, n = ch >> 5, cc = ch & 31;
                *(LAS v4u*)(lds + R2_SOFF + n * 512 + ((cc ^ (n & 31)) * 16)) = *(const v4u*)(Q + ((size_t)(bh * SEQ + tq0 + n)) * 256 + cc * 8); }
            __syncthreads();
            const LAS unsigned char* qrow = lds + R2_SOFF + (32 * nt + r) * 512;
            for (int mt = eh; mt < nmt; mt += 2) {
                f32x16 p;
#pragma unroll
                for (int i = 0; i < 16; ++i) p[i] = 0.f;
                const bf16* kb = K + ((size_t)(bh * SEQ + tk0 + 32 * mt + r)) * 256 + 8 * hh;
#pragma unroll
                for (int kh = 0; kh < 2; ++kh) { bf16x8_t kf[8];
#pragma unroll
                    for (int jj = 0; jj < 8; ++jj) kf[jj] = *(const bf16x8_t*)(kb + (8 * kh + jj) * 16);
#pragma unroll
                    for (int jj = 0; jj < 8; ++jj) p = MFMA32(kf[jj], *(const LAS bf16x8_t*)(qrow + (((2 * (8 * kh + jj) + hh) ^ r) * 16)), p); }
                const int nq = tq0 + 32 * nt + r, mk = tk0 + 32 * mt + 4 * hh;
#pragma unroll
                for (int i4 = 0; i4 < 4; ++i4) { float v[4];
#pragma unroll
                    for (int k = 0; k < 4; ++k) { const int dist = nq - (mk + 8 * i4 + k); v[k] = dist < 0 ? 0.f : p[4 * i4 + k] * __builtin_amdgcn_exp2f((float)dist * lg2); }
                    v2u wv; wv.x = cvtpk(v[0], v[1]); wv.y = cvtpk(v[2], v[3]);
                    *(LAS v2u*)(lds + ((32 * nt + r) * R2_STR + 32 * mt + 8 * i4 + 4 * hh) * 2) = wv; }
            }
        }
        if (!(dry && (R2_SKIP & 4))) { R2_IDS const bf16* src = VT + ((size_t)(bh * 512)) * SEQ + tk0; const LAS unsigned char* pb = lds + ((32 * nt + r) * R2_STR + 8 * hh) * 2;
          const int nsl = odd ? 8 : 4;
          R2_LOADS(src, SEQ, 0);
          __syncthreads();
          R2_STORES(0);
          __syncthreads();
          for (int sl = 0; sl < nsl; ++sl) {
              if (sl + 1 < nsl) R2_LOADS(src, SEQ, sl + 1);
              if (sl < nmt) {
                  const bf16x8_t bp0 = *(const LAS bf16x8_t*)(pb + sl * 64), bp1 = *(const LAS bf16x8_t*)(pb + sl * 64 + 32);
                  R2_SLICE(sl & 1, bp0, bp1);
              }
              if (sl + 1 < nsl) R2_STORES((sl + 1) & 1);
              __syncthreads();
          } }
#undef R2_LOADS
#undef R2_STORES
#undef R2_AFRAG
#undef R2_SLICE
#undef R2_SB
#undef R2_QG
        { R2_IDS float ssq = 0.f;
#pragma unroll
          for (int et = 0; et < 8; ++et)
#pragma unroll
              for (int i = 0; i < 16; ++i) ssq += acc[et][i] * acc[et][i];
          ssq += __shfl_xor(ssq, 32);
          if (hh == 0) ssp[eh * 128 + 32 * nt + r] = ssq; }
        __syncthreads();
        { R2_IDS const float rstd = 1.0f / sqrtf((ssp[32 * nt + r] + ssp[128 + 32 * nt + r]) * (1.0f / 512.0f) + RMS_EPS);
          bf16* gp = GY + ((size_t)((bh >> 2) * SEQ + tq0 + 32 * nt + r)) * 2048 + h * 512 + 256 * eh + 4 * hh;
#pragma unroll
          for (int et = 0; et < 8; ++et)
#pragma unroll
              for (int i4 = 0; i4 < 4; ++i4) { bf16* p4 = gp + 32 * et + 8 * i4; const v2u gg = *(const v2u*)p4;
                  v2u wv; wv.x = cvtpk(acc[et][4 * i4] * rstd * __uint_as_float(gg.x << 16), acc[et][4 * i4 + 1] * rstd * __uint_as_float(gg.x & 0xffff0000u));
                  wv.y = cvtpk(acc[et][4 * i4 + 2] * rstd * __uint_as_float(gg.y << 16), acc[et][4 * i4 + 3] * rstd * __uint_as_float(gg.y & 0xffff0000u));
                  if (!dry || rstd == 1.2345e38f) *(v2u*)p4 = wv; if (i4 == 3 && (et & 1)) asm volatile("" ::: "memory"); } }
    }
}

__device__ __forceinline__ void ret_out_mfma_d(const int dry, const int tid, const int bid, LAS unsigned char* lds, const bf16* Q, const bf16* K, const bf16* VT, bf16* GY, const bf16* ST) { ret_out_mfma(tid, bid, lds, Q, K, VT, GY, ST, dry); }
#define XB_TMO      128
#define XB_XCNT(j)  (256  + 64 * (j))
#define XB_XSUB(j)  (1280 + 64 * (j))
#define XB_XGEN(j)  (2304 + 64 * (j))
#define XB_TOP      3328
#define XB_TOPGEN   3392
#define XCD_BAR_WORDS 3456
#define XB_SPIN_CAP (1u << 18)

__device__ __forceinline__ unsigned xb_ld(unsigned* p)              { return __hip_atomic_load(p, __ATOMIC_RELAXED, __HIP_MEMORY_SCOPE_AGENT); }
__device__ __forceinline__ unsigned xb_add(unsigned* p, unsigned v) { return __hip_atomic_fetch_add(p, v, __ATOMIC_RELAXED, __HIP_MEMORY_SCOPE_AGENT); }
__device__ __forceinline__ unsigned xb_xcc_id() { return (unsigned)__builtin_amdgcn_s_getreg((3 << 11) | 20) & 0xFu; }
#define XB_SPIN(cond, bar) do { unsigned _sp = 0; while (cond) { __builtin_amdgcn_s_sleep(1); \
    if ((++_sp & 255u) == 0u) { if (xb_ld(&(bar)[XB_TMO])) break; if (_sp > XB_SPIN_CAP) { atomicAdd(&(bar)[XB_TMO], 1u); break; } } } } while (0)

struct XcdBarrier {
    unsigned* bar; unsigned x;
    volatile LAS unsigned* st;
};

__device__ __forceinline__ XcdBarrier xcd_barrier_post(unsigned* bar, volatile LAS unsigned* st) {
    XcdBarrier b; b.bar = bar; b.x = xb_xcc_id(); b.st = st;
    if (threadIdx.x == 0) (void)xb_add(&bar[XB_XCNT(b.x)], 1u);
    return b;
}
__device__ __forceinline__ void xcd_barrier_complete(unsigned* bar, unsigned x, unsigned& nloc, unsigned& nx) {
    const unsigned G = gridDim.x * gridDim.y * gridDim.z;
    unsigned sum, cnt, mine, sp = 0u;
    for (;;) {
        sum = 0u; cnt = 0u; mine = 0u;
#pragma unroll
        for (unsigned j = 0; j < 16; ++j) { const unsigned c = xb_ld(&bar[XB_XCNT(j)]); sum += c; cnt += (c > 0u) ? 1u : 0u; mine = (j == x) ? c : mine; }
        if (sum == G) break;
        __builtin_amdgcn_s_sleep(1);
        if ((++sp & 255u) == 0u) { if (xb_ld(&bar[XB_TMO])) break; if (sp > XB_SPIN_CAP) { atomicAdd(&bar[XB_TMO], 1u); break; } }
    }
    nloc = mine > 0u ? mine : 1u; nx = cnt > 0u ? cnt : 1u;
}

__device__ __forceinline__ void xcd_barrier(const XcdBarrier& b) {
    asm volatile("s_waitcnt vmcnt(0)" ::: "memory");
    __syncthreads();
    if (threadIdx.x == 0) {
        unsigned* bar = b.bar;
        __builtin_amdgcn_s_waitcnt(0);
        unsigned nloc = b.st[0], nx = b.st[1];
        if (nloc == 0u) { xcd_barrier_complete(bar, b.x, nloc, nx); b.st[0] = nloc; b.st[1] = nx; }
        const unsigned old = xb_add(&bar[XB_XSUB(b.x)], 1u);
        const unsigned gen = old / nloc;
        if (old + 1u == (gen + 1u) * nloc) {
            __builtin_amdgcn_fence(__ATOMIC_RELEASE, "agent");
            asm volatile("s_waitcnt vmcnt(0)" ::: "memory");
            const unsigned og = xb_add(&bar[XB_TOP], 1u);
            const unsigned tg = og / nx;
            if (og + 1u == (tg + 1u) * nx) xb_add(&bar[XB_TOPGEN], 1u);
            else XB_SPIN(xb_ld(&bar[XB_TOPGEN]) == tg, bar);
            __builtin_amdgcn_fence(__ATOMIC_ACQUIRE, "agent");
            xb_add(&bar[XB_XGEN(b.x)], 1u);
            asm volatile("s_waitcnt vmcnt(0)" ::: "memory");
        } else {
            XB_SPIN(xb_ld(&bar[XB_XGEN(b.x)]) == gen, bar);
            __builtin_amdgcn_fence(__ATOMIC_ACQUIRE, "agent");
            asm volatile("s_waitcnt vmcnt(0)" ::: "memory");
        }
    }
    __syncthreads();
}


#if NAIVE_MIXERS
#define MIXER_RET_A
#define MIXER_RET_B
#define MIXER_DIFF
#else
#define MIXER_RET_A for (int rep_ = 0; rep_ < ((PROBE_DUP & 2) ? 2 : 1); ++rep_) if (IN(pb + 1)) { PH_BEGIN ret_scan_mfma(tid, bid, lds, (const bf16*)(ws + WS_K), (const bf16*)(ws + WS_VT), (bf16*)(ws + WS_ST)); }
#define MIXER_RET_B for (int rep_ = ((PROBE_DUP & 128) ? 1 : 0); rep_ >= 0; --rep_) if (IN(pb + 2)) { PH_BEGIN ret_out_mfma_d(rep_, tid, bid, lds, (const bf16*)(ws + WS_Q), (const bf16*)(ws + WS_K), (const bf16*)(ws + WS_VT), (bf16*)(ws + WS_G), (const bf16*)(ws + WS_ST)); }
#ifndef PROBE_AMODE
#define PROBE_AMODE 0
#endif
#define MIXER_DIFF for (int rep_ = 0; rep_ < ((PROBE_DUP & 1) ? 2 : 1); ++rep_) if (IN(pb + 2)) { PH_BEGIN const float* tab_ = (const float*)(ws + WS_TAB); \
    if (PROBE_AMODE != 0 && rep_ == 0) attn_mfma<PROBE_AMODE>(tid, bid, lds, (const bf16*)(ws + WS_Q), (const bf16*)(ws + WS_K), (const bf16*)(ws + WS_VT), (bf16*)(ws + WS_G), tab_, ka_in(ka, 8), tab_[1024 + j], ka_in(ka, 7) + j * 128, tab_[1024 + 2 + j]); else \
    attn_mfma(tid, bid, lds, (const bf16*)(ws + WS_Q), (const bf16*)(ws + WS_K), (const bf16*)(ws + WS_VT), (bf16*)(ws + WS_G), tab_, ka_in(ka, 8), tab_[1024 + j], ka_in(ka, 7) + j * 128, tab_[1024 + 2 + j]); }
#endif
#if NAIVE_MIXERS
__global__ void __launch_bounds__(NTHR) k_scan_naive(const bf16* K, const bf16* VT, bf16* ST) { ret_scan_naive(K, VT, ST); }
__global__ void __launch_bounds__(NTHR) k_rout_naive(const bf16* Q, const bf16* K, const bf16* VT, bf16* GY, const bf16* ST) {
    extern __shared__ __attribute__((aligned(16))) unsigned char lds_raw[]; ret_out_naive((LAS unsigned char*)lds_raw, Q, K, VT, GY, ST); }
__global__ void __launch_bounds__(NTHR, 2) k_scan_mfma(const bf16* K, const bf16* VT, bf16* ST) {
    extern __shared__ __attribute__((aligned(16))) unsigned char lds_raw[]; ret_scan_mfma(threadIdx.x, blockIdx.x, (LAS unsigned char*)lds_raw, K, VT, ST); }
__global__ void __launch_bounds__(NTHR, 2) k_rout_mfma(const bf16* Q, const bf16* K, const bf16* VT, bf16* GY, const bf16* ST) {
    extern __shared__ __attribute__((aligned(16))) unsigned char lds_raw[]; ret_out_mfma(threadIdx.x, blockIdx.x, (LAS unsigned char*)lds_raw, Q, K, VT, GY, ST); }
__global__ void __launch_bounds__(NTHR, 2) k_attn_mfma(const bf16* Qd, const bf16* Kd, const bf16* VTd, bf16* Od, const float* tab, int j, const float* subln, const float* rel_tab) {
    extern __shared__ __attribute__((aligned(16))) unsigned char lds_raw[]; attn_mfma(threadIdx.x, blockIdx.x, (LAS unsigned char*)lds_raw, Qd, Kd, VTd, Od, tab, rel_tab, tab[1024 + j], subln + j * 128, tab[1024 + 2 + j]); }
__global__ void __launch_bounds__(NTHR) k_attn_naive(const bf16* Qd, const bf16* Kd, const bf16* VTd, bf16* Od, const float* tab, int j, const float* subln) {
    extern __shared__ __attribute__((aligned(16))) unsigned char lds_raw[]; attn_naive((LAS unsigned char*)lds_raw, Qd, Kd, VTd, Od, tab, tab[1024 + j], subln + j * 128, tab[1024 + 2 + j]); }

#endif
typedef const unsigned char __attribute__((address_space(4)))* kaptr;
__device__ __forceinline__ kaptr ka_get() { kaptr p = (kaptr)__builtin_amdgcn_kernarg_segment_ptr(); asm volatile("" : "+s"(p)); return p; }
__device__ __forceinline__ const float* ka_in(kaptr p, int i) { return *(const float* const __attribute__((address_space(4)))*)(p + 8 * i); }
__device__ __forceinline__ float* ka_out(kaptr p) { return *(float* const __attribute__((address_space(4)))*)(p + 96); }
__device__ __forceinline__ unsigned char* ka_ws(kaptr p) { return *(unsigned char* const __attribute__((address_space(4)))*)(p + 104); }
__device__ __forceinline__ int tid_get() { int t = threadIdx.x; asm volatile("" : "+v"(t)); return t; }
__device__ __forceinline__ int bid_get() { int t = blockIdx.x; asm volatile("" : "+s"(t)); return t; }
#define PH_BEGIN const kaptr ka = ka_get(); unsigned char* const ws = ka_ws(ka); const int tid = tid_get(), lane = tid & 63, wave = __builtin_amdgcn_readfirstlane(tid >> 6); \
    const int bid = bid_get(); const int G = gridDim.x, gw = bid * NWAVES + wave, ngw = G * NWAVES; (void)bid; LAS float* const scr = (LAS float*)(lds + wave * 16384); (void)lane; (void)gw; (void)ngw; (void)scr; (void)ws;

__global__ void __launch_bounds__(NTHR, 2) fwd_mega(Args args_unused, int ph_lo, int ph_hi) {
    extern __shared__ __attribute__((aligned(16))) unsigned char lds_raw[];
    cg::grid_group grid = cg::this_grid();
    LAS unsigned char* lds = (LAS unsigned char*)lds_raw;
    volatile LAS unsigned* xst = (volatile LAS unsigned*)(lds + LDS_BYTES - 64);
    if (threadIdx.x < 2) xst[threadIdx.x] = 0u;
    __syncthreads();
    const XcdBarrier xbar = xcd_barrier_post((unsigned*)(ka_ws(ka_get()) + WS_CTL) + CW_BAR, xst);

#define IN(k) (ph_lo <= (k) && (k) < ph_hi)
#define SEAM(k) do { if (IN(k) && IN((k) + 1)) { if (ph_hi < 0) grid.sync(); else xcd_barrier(xbar); } } while (0)
    if (IN(0)) {
        PH_BEGIN
        conv_plain(ka_in(ka, 2), D, RET_IN, (bf16*)(ws + WS_WIN), scr, gw, ngw, lane);
        conv_plain(ka_in(ka, 3), 2048, D, (bf16*)(ws + WS_WOUT), scr, gw, ngw, lane);
        conv_gu(ka_in(ka, 9), ka_in(ka, 10), (bf16*)(ws + WS_WGU), scr, gw, ngw, lane);
        conv_plain(ka_in(ka, 11), FF, D, (bf16*)(ws + WS_WDN), scr, gw, ngw, lane);
        { const float* x = ka_in(ka, 0); const float* gains = ka_in(ka, 1); bf16* XN = (bf16*)(ws + WS_XN);
          for (int m = gw; m < M; m += ngw) rms_row_to_bf16(x + (size_t)m * D, gains, XN + (size_t)m * D, lane); }
        { unsigned* ctl = (unsigned*)(ws + WS_CTL); for (int i = bid * NTHR + tid; i < 16 * 64 * 64; i += G * NTHR) ctl[CW_CNT + i] = 0u; }
        if (bid == 0) {
            const float* rel_tab = ka_in(ka, 8); const float* diff_lambda = ka_in(ka, 6); float* lut = (float*)(ws + WS_TAB); float* lamtab = (float*)(ws + WS_TAB + 4096);
            for (int t = tid; t < 1024; t += NTHR) { const int h = t >> 7, n = t & 127; int bk;
                if (n < 16) bk = n; else { bk = 16 + (int)(__builtin_logf((float)n * (1.0f / 16.0f)) / 2.0794415416798357f * 16.0f); if (bk > 31) bk = 31; }
                lut[t] = rel_tab[bk * 8 + h] * LOG2E; }
            if (tid < 2) { const float* lm = diff_lambda + tid * 256; float a = 0.f, b2 = 0.f; for (int i = 0; i < 64; ++i) { a += lm[i] * lm[64 + i]; b2 += lm[128 + i] * lm[192 + i]; }
                const int li = 2 * tid + 1; const float linit = 0.8f - 0.6f * __builtin_expf(-0.3f * (float)li); lamtab[tid] = __builtin_expf(a) - __builtin_expf(b2) + linit; lamtab[2 + tid] = 1.0f - linit; }
        }
    }
    SEAM(0);

    for (int L = 0; L < DEPTH; ++L) {
        asm volatile("" : "+s"(L));
        const int j = L >> 1; const bool isRet = (L & 1) == 0; const int pb = 1 + 6 * L; (void)j;
        if (L > 0 && IN(pb)) { PH_BEGIN conv_plain(ka_in(ka, 11) + (size_t)L * FF * D, FF, D, (bf16*)(ws + WS_WDN), scr, gw, ngw, lane); __syncthreads(); }
        if (isRet) {
            for (int rep_ = 0; rep_ < ((PROBE_DUP & 4) ? 2 : 1); ++rep_) if (IN(pb)) { PH_BEGIN
              pg8::Gemm g{(const bf16*)(ws + WS_XN), (const bf16*)(ws + WS_WIN), M, RET_IN, D}; pg8::StaticOrder S; S.init(M, RET_IN, G, bid);
              pg8::EpiRetIn E{(bf16*)(ws + WS_Q), (bf16*)(ws + WS_K), (bf16*)(ws + WS_VT), (bf16*)(ws + WS_G)};
              pg8::gemm_phase<pg8::EpiRetIn, pg8::StaticOrder, true, true>(lds, g, S, E); }
            SEAM(pb);
            MIXER_RET_A
            SEAM(pb + 1);
            MIXER_RET_B
            SEAM(pb + 2);
        } else {
            if (IN(pb)) { PH_BEGIN
              pg8::Gemm g{(const bf16*)(ws + WS_XN), (const bf16*)(ws + WS_WIN), M, DIFF_IN, D}; pg8::StaticOrder S; S.init(M, DIFF_IN, G, bid);
              pg8::EpiDiffIn E{(bf16*)(ws + WS_Q), (bf16*)(ws + WS_K), (bf16*)(ws + WS_VT), 0.125f * LOG2E};
              pg8::gemm_phase<pg8::EpiDiffIn, pg8::StaticOrder, true, true>(lds, g, S, E); }
            SEAM(pb);
            SEAM(pb + 1);
            MIXER_DIFF
            SEAM(pb + 2);
        }
        if (IN(pb + 3)) { PH_BEGIN
          const float* gL = ka_in(ka, 1) + (size_t)L * 4 * D; float* out = ka_out(ka); unsigned* ctl = (unsigned*)(ws + WS_CTL);
          pg8::Gemm g{(const bf16*)(ws + WS_G), (const bf16*)(ws + WS_WOUT), M, D, isRet ? 2048 : 1024}; pg8::StaticOrder S; S.init(M, D, G, bid);
          pg8::EpiNormResNorm E{L == 0 ? ka_in(ka, 0) : (const float*)out, out, (bf16*)(ws + WS_XN), gL + D, gL + 2 * D, (float*)(ws + WS_X), ctl + CW_CNT + (L * 4 + 0) * 64 * 64, RMS_EPS, 0};
          pg8::gemm_phase<pg8::EpiNormResNorm, pg8::StaticOrder, false, true>(lds, g, S, E); }
        SEAM(pb + 3);
        for (int rep_ = 0; rep_ < ((PROBE_DUP & 8) ? 2 : 1); ++rep_) if (IN(pb + 4)) { PH_BEGIN
          pg8::Gemm g{(const bf16*)(ws + WS_XN), (const bf16*)(ws + WS_WGU), M, 2 * FF, D}; pg8::StaticOrder S; S.init(M, 2 * FF, G, bid);
          pg8::EpiSwiGLU E{(bf16*)(ws + WS_ACT)};
          pg8::gemm_phase<pg8::EpiSwiGLU, pg8::StaticOrder, true, true>(lds, g, S, E); }
        SEAM(pb + 4);
        if (L + 1 < DEPTH && IN(pb + 5)) { PH_BEGIN
            const int nj = (L + 1) >> 1;
            if ((L + 1) & 1) { conv_plain(ka_in(ka, 4) + (size_t)nj * D * DIFF_IN, D, DIFF_IN, (bf16*)(ws + WS_WIN), scr, gw, ngw, lane); conv_plain(ka_in(ka, 5) + (size_t)nj * D * D, D, D, (bf16*)(ws + WS_WOUT), scr, gw, ngw, lane); }
            else { conv_plain(ka_in(ka, 2) + (size_t)nj * D * RET_IN, D, RET_IN, (bf16*)(ws + WS_WIN), scr, gw, ngw, lane); conv_plain(ka_in(ka, 3) + (size_t)nj * 2048 * D, 2048, D, (bf16*)(ws + WS_WOUT), scr, gw, ngw, lane); }
            conv_gu(ka_in(ka, 9) + (size_t)(L + 1) * D * FF, ka_in(ka, 10) + (size_t)(L + 1) * D * FF, (bf16*)(ws + WS_WGU), scr, gw, ngw, lane);
            __syncthreads();
        }
#if (PROBE_DUP & 32)
        if (IN(pb + 5)) { PH_BEGIN
          pg8::Gemm g{(const bf16*)(ws + WS_ACT), (const bf16*)(ws + WS_WDN), M, D, FF}; pg8::StaticOrder S; S.init(M, D, G, bid);
          pg8::EpiNull E{(float*)(ws + WS_TAB + 8192)};
          pg8::gemm_phase<pg8::EpiNull, pg8::StaticOrder, false, true>(lds, g, S, E); }
#endif
        if (IN(pb + 5)) { PH_BEGIN
          const float* gains = ka_in(ka, 1); const float* gL = gains + (size_t)L * 4 * D; float* out = ka_out(ka); unsigned* ctl = (unsigned*)(ws + WS_CTL);
          pg8::Gemm g{(const bf16*)(ws + WS_ACT), (const bf16*)(ws + WS_WDN), M, D, FF}; pg8::StaticOrder S; S.init(M, D, G, bid);
          const float* gnext = (L + 1 < DEPTH) ? gains + (size_t)(L + 1) * 4 * D : gL;
          pg8::EpiNormResNorm E{(const float*)out, out, (bf16*)(ws + WS_XN), gL + 3 * D, gnext, (float*)(ws + WS_X), ctl + CW_CNT + (L * 4 + 2) * 64 * 64, RMS_EPS, 0};
          pg8::gemm_phase<pg8::EpiNormResNorm, pg8::StaticOrder, false, true>(lds, g, S, E); }
        SEAM(pb + 5);
    }
}

extern "C" void kernel_launch(void* const* d_in, const int* in_sizes, int n_in, void* d_out, int out_size, void* d_ws, size_t ws_size, hipStream_t stream) {
    static int ready = 0;
    if (ready == 0) {
        ready = 1;
        if (n_in != 12 || out_size != M * D || ws_size < WS_END) { fprintf(stderr, "kernel_launch: unexpected problem (n_in %d, out %d, ws %zu)\n", n_in, out_size, ws_size); ready = -1; }
        else if (hipFuncSetAttribute((const void*)fwd_mega, hipFuncAttributeMaxDynamicSharedMemorySize, LDS_BYTES) != hipSuccess) { fprintf(stderr, "kernel_launch: hipFuncSetAttribute failed\n"); ready = -1; }
        else {
            int dev = 0, cus = 0, per_cu = 0; (void)hipGetDevice(&dev); (void)hipDeviceGetAttribute(&cus, hipDeviceAttributeMultiprocessorCount, dev);
            (void)hipOccupancyMaxActiveBlocksPerMultiprocessor(&per_cu, (const void*)fwd_mega, NTHR, LDS_BYTES);
            if (cus * per_cu < GRID) { fprintf(stderr, "kernel_launch: %d CUs x %d blocks may not hold the %d-workgroup cooperative grid (advisory; the cooperative launch itself decides)\n", cus, per_cu, GRID); }
            (void)hipGetLastError();
        }
    }
    if (ready < 0) return;
    (void)hipMemsetAsync((char*)d_ws + WS_CTL, 0, CTL_ZERO_BYTES, stream);
    Args a{};
    for (int i = 0; i < 12; ++i) a.in[i] = (const float*)d_in[i];
    a.out = (float*)d_out; a.ws = (unsigned char*)d_ws;
    unsigned char* ws = (unsigned char*)d_ws;
    auto mega = [&](int lo, int hi) {
        int plo = lo, phi = hi; void* kargs[] = {&a, &plo, &phi};
        const hipError_t e = hipLaunchCooperativeKernel((const void*)fwd_mega, dim3(GRID), dim3(NTHR), kargs, LDS_BYTES, stream);
        if (e != hipSuccess) fprintf(stderr, "kernel_launch: cooperative launch failed: %s\n", hipGetErrorString(e));
    };
#if NAIVE_MIXERS
    int lo = 0;
    for (int L = 0; L < DEPTH; ++L) {
        const int pb = 1 + 6 * L;
#if PER_PHASE_LAUNCH
        for (int k = lo; k < pb + 1; ++k) mega(k, k + 1);
#else
        mega(lo, pb + 1);
#endif
        if ((L & 1) == 0) {
#if MFMA_SCAN
            hipLaunchKernelGGL(k_scan_mfma, dim3(GRID), dim3(NTHR), 140000, stream, (const bf16*)(ws + WS_K), (const bf16*)(ws + WS_VT), (bf16*)(ws + WS_ST));
#else
            hipLaunchKernelGGL(k_scan_naive, dim3(GRID), dim3(NTHR), 0, stream, (const bf16*)(ws + WS_K), (const bf16*)(ws + WS_VT), (bf16*)(ws + WS_ST));
#endif
            hipLaunchKernelGGL(MFMA_ROUT ? k_rout_mfma : k_rout_naive, dim3(GRID), dim3(NTHR), 140000, stream, (const bf16*)(ws + WS_Q), (const bf16*)(ws + WS_K), (const bf16*)(ws + WS_VT), (bf16*)(ws + WS_G), (const bf16*)(ws + WS_ST));
        } else {
#if MFMA_ATTN
            hipLaunchKernelGGL(k_attn_mfma, dim3(GRID), dim3(NTHR), 73728, stream, (const bf16*)(ws + WS_Q), (const bf16*)(ws + WS_K), (const bf16*)(ws + WS_VT), (bf16*)(ws + WS_G), (const float*)(ws + WS_TAB), L >> 1, (const float*)d_in[7], (const float*)d_in[8]);
#else
            hipLaunchKernelGGL(k_attn_naive, dim3(GRID), dim3(NTHR), 32768, stream, (const bf16*)(ws + WS_Q), (const bf16*)(ws + WS_K), (const bf16*)(ws + WS_VT), (bf16*)(ws + WS_G), (const float*)(ws + WS_TAB), L >> 1, (const float*)d_in[7]);
#endif
        }
        lo = pb + 3;
#ifdef TRUNC_PHASE
        if (TRUNC_PHASE < pb + 6 + 1) { for (int k = lo; k <= TRUNC_PHASE; ++k) mega(k, k + 1); return; }
#endif
    }
#if PER_PHASE_LAUNCH
    for (int k = lo; k < 1 + 6 * DEPTH; ++k) mega(k, k + 1);
#else
    mega(lo, 1 + 6 * DEPTH);
#endif
#else
    mega(0, 1 + 6 * DEPTH);
#endif
}
```
